# Optimizing an MI355X kernel written in HIP

```python
import math
import jax, jax.numpy as jnp
from jax import lax
import numpy as np

D_MODEL = 2048
BATCH = 4
SEQ = 8192
DEPTH = 4

N_MIXERS = 2
D_FF = 5632
ROPE_THETA = 10000.0
Q_BLOCK = 128
NORM_EPS = 1e-6
N_ADA = 9
A_HEAD_DIM = 128
A_HEADS = D_MODEL // (2 * A_HEAD_DIM)
A_IN = A_HEADS * (2 * A_HEAD_DIM) * 3
B_HEAD_DIM = 128
B_HEADS = D_MODEL // B_HEAD_DIM
IDX_HEADS = 16
IDX_HEAD_DIM = 128
IDX_ROPE_DIM = 64
TOPK_MAX = 256
B_IN = B_HEADS * B_HEAD_DIM + 2 * B_HEAD_DIM + IDX_HEADS * IDX_HEAD_DIM + IDX_HEAD_DIM + IDX_HEADS
N_A_LAYERS = (DEPTH + 1) // 2
N_B_LAYERS = DEPTH // 2

kernel_name = "hybrid_diffattn_dsa_macaron_adaln"


def rms_norm(x, eps=NORM_EPS):
    xf = x.astype(jnp.float32)
    return (xf * lax.rsqrt(jnp.mean(xf * xf, axis=-1, keepdims=True) + eps)).astype(x.dtype)


def layer_norm(x, g, b, eps=NORM_EPS):
    xf = x.astype(jnp.float32)
    mu = jnp.mean(xf, axis=-1, keepdims=True)
    var = jnp.mean(jnp.square(xf - mu), axis=-1, keepdims=True)
    return ((xf - mu) * lax.rsqrt(var + eps)).astype(x.dtype) * g + b


def rope_tables(seq, dim):
    pos = jnp.arange(seq, dtype=jnp.float32)
    inv = 1.0 / (ROPE_THETA ** (jnp.arange(0, dim, 2, dtype=jnp.float32) / dim))
    ang = pos[:, None] * inv[None, :]
    return jnp.cos(ang), jnp.sin(ang)


def rope(x, cos, sin):
    half = x.shape[-1] // 2
    shape = (1, x.shape[1]) + (1,) * (x.ndim - 3) + (half,)
    c = cos.reshape(shape).astype(x.dtype)
    s = sin.reshape(shape).astype(x.dtype)
    x1, x2 = x[..., :half], x[..., half:]
    return jnp.concatenate([x1 * c - x2 * s, x2 * c + x1 * s], axis=-1)


def partial_rope(x, cos, sin):
    return jnp.concatenate([rope(x[..., :IDX_ROPE_DIM], cos, sin), x[..., IDX_ROPE_DIM:]], axis=-1)


def to_blocks(t):
    b, s = t.shape[:2]
    t = t.reshape((b, s // Q_BLOCK, Q_BLOCK) + t.shape[2:])
    return jnp.moveaxis(t, 1, 0)


def from_blocks(t):
    t = jnp.moveaxis(t, 0, 1)
    return t.reshape((t.shape[0], t.shape[1] * t.shape[2]) + t.shape[3:])


def swiglu(h, w_gate, w_up, w_down):
    return (jax.nn.silu(h @ w_gate) * (h @ w_up)) @ w_down


def modulate(x, shift, scale):
    return rms_norm(x) * (1 + scale) + shift


def diff_attention(h, w_in, w_out, q_gain, k_gain, lq1, lk1, lq2, lk2, subln_gain, cos, sin, lam_init):
    b, s, _ = h.shape
    hd = A_HEAD_DIM
    qk_w = A_HEADS * 2 * hd
    proj = h @ w_in
    q = proj[..., :qk_w].reshape(b, s, A_HEADS, 2, hd)
    k = proj[..., qk_w:2 * qk_w].reshape(b, s, A_HEADS, 2, hd)
    v = proj[..., 2 * qk_w:].reshape(b, s, A_HEADS, 2 * hd)
    q = rope(rms_norm(q) * q_gain, cos, sin)
    k = rope(rms_norm(k) * k_gain, cos, sin)
    f32 = jnp.float32
    lam = (jnp.exp(jnp.sum(lq1.astype(f32) * lk1.astype(f32)))
           - jnp.exp(jnp.sum(lq2.astype(f32) * lk2.astype(f32))) + lam_init)
    key_pos = jnp.arange(s)
    scale = hd ** -0.5

    def block(args):
        q_b, start = args
        qpos = start + jnp.arange(Q_BLOCK)
        sc = jnp.einsum('bqhcd,bkhcd->bhcqk', q_b, k).astype(f32) * scale
        mask = key_pos[None, :] <= qpos[:, None]
        p = jax.nn.softmax(jnp.where(mask, sc, -jnp.inf), axis=-1)
        a = p[:, :, 0] - lam * p[:, :, 1]
        return jnp.einsum('bhqk,bkhe->bqhe', a.astype(v.dtype), v)

    starts = jnp.arange(s // Q_BLOCK) * Q_BLOCK
    o = from_blocks(lax.map(block, (to_blocks(q), starts)))
    o = rms_norm(o) * subln_gain * (1.0 - lam_init)
    return o.reshape(b, s, A_HEADS * 2 * hd) @ w_out


def dsa_attention(h, w_in, w_out, q_gain, k_gain, kidx_gain, kidx_bias, cos, sin, cos_i, sin_i):
    b, s, _ = h.shape
    dh = B_HEAD_DIM
    q_w = B_HEADS * dh
    qi_w = IDX_HEADS * IDX_HEAD_DIM
    cuts = [q_w, q_w + dh, q_w + 2 * dh, q_w + 2 * dh + qi_w, q_w + 2 * dh + qi_w + IDX_HEAD_DIM]
    proj = h @ w_in
    q, k, v, qi, ki, wi = jnp.split(proj, cuts, axis=-1)
    q = rope(rms_norm(q.reshape(b, s, B_HEADS, dh)) * q_gain, cos, sin)
    k = rope(rms_norm(k) * k_gain, cos, sin)
    kv = jnp.concatenate([k, v], axis=-1)
    qi = partial_rope(qi.reshape(b, s, IDX_HEADS, IDX_HEAD_DIM), cos_i, sin_i)
    ki = partial_rope(layer_norm(ki, kidx_gain, kidx_bias), cos_i, sin_i)
    wi = wi.astype(jnp.float32) * (IDX_HEADS ** -0.5) * (IDX_HEAD_DIM ** -0.5)
    topk = min(TOPK_MAX, s // 4)
    key_pos = jnp.arange(s)
    scale = dh ** -0.5
    gather = jax.vmap(lambda t, i: t[i])

    def block(args):
        q_b, qi_b, wi_b, start = args
        qpos = start + jnp.arange(Q_BLOCK)
        rel = jax.nn.relu(jnp.einsum('bqhd,bkd->bqhk', qi_b, ki)).astype(jnp.float32)
        score = jnp.einsum('bqh,bqhk->bqk', wi_b, rel)
        score = jnp.where((key_pos[None, :] <= qpos[:, None])[None], score, -jnp.inf)
        _, idx = lax.top_k(score, topk)
        valid = idx <= qpos[None, :, None]
        kvg = gather(kv, idx)
        kg, vg = kvg[..., :dh], kvg[..., dh:]
        sc = jnp.einsum('bqhd,bqjd->bqhj', q_b, kg).astype(jnp.float32) * scale
        p = jax.nn.softmax(jnp.where(valid[:, :, None, :], sc, -jnp.inf), axis=-1)
        return jnp.einsum('bqhj,bqjd->bqhd', p.astype(vg.dtype), vg)

    starts = jnp.arange(s // Q_BLOCK) * Q_BLOCK
    o = from_blocks(lax.map(block, (to_blocks(q), to_blocks(qi), to_blocks(wi), starts)))
    return o.reshape(b, s, B_HEADS * dh) @ w_out


def setup_inputs(seed: int = 0) -> dict:
    key = jax.random.key(seed)
    ks = jax.random.split(key, 22)
    D = D_MODEL
    std = D ** -0.5
    nrm = jax.random.normal
    return {
        "x": nrm(ks[0], (BATCH, SEQ, D), jnp.float32),
        "c": nrm(ks[1], (BATCH, D), jnp.float32),
        "ada_w": nrm(ks[2], (DEPTH, D, N_ADA * D), jnp.float32) * (0.5 * std),
        "ada_b": 0.02 * nrm(ks[3], (DEPTH, N_ADA * D), jnp.float32),
        "ffn_w_gate": nrm(ks[4], (DEPTH, 2, D, D_FF), jnp.float32) * std,
        "ffn_w_up": nrm(ks[5], (DEPTH, 2, D, D_FF), jnp.float32) * std,
        "ffn_w_down": nrm(ks[6], (DEPTH, 2, D_FF, D), jnp.float32) * (D_FF ** -0.5),
        "a_w_in": nrm(ks[7], (N_A_LAYERS, D, A_IN), jnp.float32) * std,
        "a_w_out": nrm(ks[8], (N_A_LAYERS, A_HEADS * 2 * A_HEAD_DIM, D), jnp.float32) * ((A_HEADS * 2 * A_HEAD_DIM) ** -0.5),
        "a_q_gain": 1.0 + 0.02 * nrm(ks[9], (N_A_LAYERS, A_HEAD_DIM), jnp.float32),
        "a_k_gain": 1.0 + 0.02 * nrm(ks[10], (N_A_LAYERS, A_HEAD_DIM), jnp.float32),
        "a_lambda_q1": 0.1 * nrm(ks[11], (N_A_LAYERS, A_HEAD_DIM), jnp.float32),
        "a_lambda_k1": 0.1 * nrm(ks[12], (N_A_LAYERS, A_HEAD_DIM), jnp.float32),
        "a_lambda_q2": 0.1 * nrm(ks[13], (N_A_LAYERS, A_HEAD_DIM), jnp.float32),
        "a_lambda_k2": 0.1 * nrm(ks[14], (N_A_LAYERS, A_HEAD_DIM), jnp.float32),
        "a_subln_gain": 1.0 + 0.02 * nrm(ks[15], (N_A_LAYERS, 2 * A_HEAD_DIM), jnp.float32),
        "b_w_in": nrm(ks[16], (N_B_LAYERS, D, B_IN), jnp.float32) * std,
        "b_w_out": nrm(ks[17], (N_B_LAYERS, B_HEADS * B_HEAD_DIM, D), jnp.float32) * ((B_HEADS * B_HEAD_DIM) ** -0.5),
        "b_q_gain": 1.0 + 0.02 * nrm(ks[18], (N_B_LAYERS, B_HEAD_DIM), jnp.float32),
        "b_k_gain": 1.0 + 0.02 * nrm(ks[19], (N_B_LAYERS, B_HEAD_DIM), jnp.float32),
        "b_kidx_gain": 1.0 + 0.02 * nrm(ks[20], (N_B_LAYERS, IDX_HEAD_DIM), jnp.float32),
        "b_kidx_bias": 0.02 * nrm(ks[21], (N_B_LAYERS, IDX_HEAD_DIM), jnp.float32),
    }


def reference(x, c, ada_w, ada_b, ffn_w_gate, ffn_w_up, ffn_w_down,
              a_w_in, a_w_out, a_q_gain, a_k_gain, a_lambda_q1, a_lambda_k1,
              a_lambda_q2, a_lambda_k2, a_subln_gain,
              b_w_in, b_w_out, b_q_gain, b_k_gain, b_kidx_gain, b_kidx_bias):
    b, s, d = x.shape
    cos, sin = rope_tables(s, A_HEAD_DIM)
    cos_i, sin_i = rope_tables(s, IDX_ROPE_DIM)
    c_act = jax.nn.silu(c)
    for i in range(DEPTH):
        mod = (c_act @ ada_w[i] + ada_b[i]).reshape(b, N_ADA, 1, d)
        sh1, sc1, g1, sh2, sc2, g2, sh3, sc3, g3 = [mod[:, j] for j in range(N_ADA)]
        x = x + 0.5 * g1 * swiglu(modulate(x, sh1, sc1), ffn_w_gate[i, 0], ffn_w_up[i, 0], ffn_w_down[i, 0])
        h = modulate(x, sh2, sc2)
        j = i // N_MIXERS
        if i % N_MIXERS == 0:
            lam_init = 0.8 - 0.6 * math.exp(-0.3 * i)
            y = diff_attention(h, a_w_in[j], a_w_out[j], a_q_gain[j], a_k_gain[j],
                               a_lambda_q1[j], a_lambda_k1[j], a_lambda_q2[j], a_lambda_k2[j],
                               a_subln_gain[j], cos, sin, lam_init)
        else:
            y = dsa_attention(h, b_w_in[j], b_w_out[j], b_q_gain[j], b_k_gain[j],
                              b_kidx_gain[j], b_kidx_bias[j], cos, sin, cos_i, sin_i)
        x = x + g2 * y
        x = x + 0.5 * g3 * swiglu(modulate(x, sh3, sc3), ffn_w_gate[i, 1], ffn_w_up[i, 1], ffn_w_down[i, 1])
    return x
```

```cpp
#include <hip/hip_runtime.h>
#include <cstdio>
#include <cstdint>

typedef unsigned short u16;
typedef _Float16 h16x8 __attribute__((ext_vector_type(8)));
typedef _Float16 h16x4 __attribute__((ext_vector_type(4)));
typedef _Float16 h16x2 __attribute__((ext_vector_type(2)));

constexpr int DM = 2048, NB = 4, SEQ = 8192, DEPTH = 4, DFF = 5632, MTOK = NB * SEQ;
constexpr int NADA = 9, ADAW = NADA * DM;
constexpr int A_IN = 6144, B_IN = 4496, B_INP = 4608;
constexpr int GU_N = 2 * DFF;
constexpr float NORM_EPS = 1e-6f;

constexpr int TIDTAB_OFF = 131072 + 320 + 128;
__device__ __forceinline__ int hw_wave_slot() { return (int)(__builtin_amdgcn_s_getreg((5 << 11) | 4) & 63u); }
__device__ __forceinline__ int opaque_lane() { int ln; asm volatile("v_mbcnt_lo_u32_b32 %0, -1, 0\n\tv_mbcnt_hi_u32_b32 %0, -1, %0" : "=v"(ln)); return ln; }
__device__ __forceinline__ int opaque_tid() {
    extern __shared__ __attribute__((aligned(16))) unsigned char lds_tid_[];
    const int w = ((volatile __attribute__((address_space(3))) int*)((__attribute__((address_space(3))) unsigned char*)lds_tid_ + TIDTAB_OFF))[hw_wave_slot()];
    int ln; asm volatile("v_mbcnt_lo_u32_b32 %0, -1, 0\n\tv_mbcnt_hi_u32_b32 %0, -1, %0" : "=v"(ln));
    int t = (w << 6) | ln;
    asm volatile("" : "+v"(t)); return t;
}

template <int K> __device__ __forceinline__ float swz_xor(float v) { static_assert(K > 0 && K < 32, "swz_xor"); return __builtin_bit_cast(float, __builtin_amdgcn_ds_swizzle(__builtin_bit_cast(int, v), (K << 10) | 0x1F)); }
__device__ __forceinline__ float add_xor16(float v) { auto r = __builtin_amdgcn_permlane16_swap(__float_as_uint(v), __float_as_uint(v), false, false); return __uint_as_float(r[0]) + __uint_as_float(r[1]); }
__device__ __forceinline__ float add_xor32(float v) { auto r = __builtin_amdgcn_permlane32_swap(__float_as_uint(v), __float_as_uint(v), false, false); return __uint_as_float(r[0]) + __uint_as_float(r[1]); }

namespace pg8 {
#define PG8_LAS __attribute__((address_space(3)))
typedef unsigned short bf16_t;
typedef short bf16x8 __attribute__((ext_vector_type(8)));
typedef float f32x4 __attribute__((ext_vector_type(4)));
typedef unsigned u32x4 __attribute__((ext_vector_type(4)));
typedef int i32x4 __attribute__((ext_vector_type(4)));
constexpr int BM = 256, BK = 64, HALF = 128, HTB = HALF * BK * 2  , STAGE_BYTES = 8 * HTB, NXCD = 8, WGM = 4;

__host__ __device__ __forceinline__ int lds_byte(int r, int c) { const int st = (r >> 4) * 2 + (c >> 5), rr = r & 15, cc = c & 31, ob = rr * 64 + cc * 2; return st * 1024 + (ob ^ (((ob >> 9) & 1) << 5)); }
__host__ __device__ __forceinline__ void stage_rc(int b, int& R, int& C) { const int st = b / 1024, sb = b % 1024, swz = sb ^ (((sb >> 9) & 1) << 5); R = (st >> 1) * 16 + swz / 64; C = (st & 1) * 32 + (swz % 64) / 2; }
__host__ __device__ __forceinline__ int perm32(int rho) { const int n = rho >> 4, i = rho & 15; return 8 * (i >> 2) + 4 * n + (i & 3); }

struct Unit { int pm, pn; };
struct Gemm { const bf16_t* A; const bf16_t* Bt; int M, N, K; };

struct StaticOrder {
    int nM, nN, nwg, G, c;
    __host__ __device__ void init(int M, int N, int G_, int c_) { nM = M / BM; nN = N / BM; nwg = nM * nN; G = G_; c = c_; }
    __host__ __device__ bool next(int i, Unit& u) const {
        const long L = (long)i * G + c; if (L >= nwg) return false;
        int wgid = (int)L; { const int q = nwg / NXCD, r = nwg % NXCD, xcd = wgid % NXCD, off = wgid / NXCD; wgid = (xcd < r ? xcd * (q + 1) : r * (q + 1) + (xcd - r) * q) + off; }
        const int nig = WGM * nN, gid = wgid / nig, fm = gid * WGM, gsz = (nM - fm) < WGM ? (nM - fm) : WGM;
        u.pm = fm + ((wgid % nig) % gsz); u.pn = (wgid % nig) / gsz; return true;
    }
    __device__ __forceinline__ void a_ready(const Unit&) const {}
    __device__ __forceinline__ void done(const Unit&) const {}
};

__device__ __forceinline__ unsigned cvt_pk_h(float lo, float hi) { h16x2 v = {(_Float16)lo, (_Float16)hi}; return __builtin_bit_cast(unsigned, v); }
__device__ __forceinline__ float silu_f(float g) { return g * __builtin_amdgcn_rcpf(1.0f + __builtin_amdgcn_exp2f(g * -1.4426950408889634f)); }

struct RowCol { const float* ssq; const float* bias; int bstride; };
__device__ __forceinline__ float rstd_of(const float* ssq, int row) { return rsqrtf(ssq[row] * (1.0f / DM) + NORM_EPS); }

struct EpiSwiglu {
    static constexpr bool PERM = true, AFTER_DRAIN = false;
    u16* O; int ldc; const float* rf; const float* tq; const float* bias; int bstride;
    __device__ __forceinline__ void operator()(const f32x4 (&acc)[2][2][4][2], const Unit& u, int wr, int wc, int fr, int fq) const {
        const int row0 = u.pm * BM + wr * 64 + fr, col0 = u.pn * HALF + wc * 32 + 8 * fq;
        const float* bp = bias + (size_t)(u.pm >> 5) * bstride + u.pn * BM + wc * 32 + 8 * fq;
        const float* tp = tq + u.pn * BM + wc * 32 + 8 * fq;
        const f32x4 bg0 = *(const f32x4*)bp, bg1 = *(const f32x4*)(bp + 4), bu0 = *(const f32x4*)(bp + HALF), bu1 = *(const f32x4*)(bp + HALF + 4);
        const f32x4 tg0 = *(const f32x4*)tp, tg1 = *(const f32x4*)(tp + 4), tu0 = *(const f32x4*)(tp + HALF), tu1 = *(const f32x4*)(tp + HALF + 4);
#pragma unroll
        for (int ai = 0; ai < 2; ++ai)
#pragma unroll
            for (int m = 0; m < 4; ++m) {
                const int row = row0 + ai * HALF + m * 16; const float rs = rf[row];
                u16* rowp = O + (size_t)row * ldc + col0;
                const f32x4 g0 = (acc[ai][0][m][0] * rs) * tg0 + bg0, g1 = (acc[ai][0][m][1] * rs) * tg1 + bg1, u0 = (acc[ai][1][m][0] * rs) * tu0 + bu0, u1 = (acc[ai][1][m][1] * rs) * tu1 + bu1;
                u32x4 w;
                w.x = cvt_pk_h(silu_f(g0[0]) * u0[0], silu_f(g0[1]) * u0[1]); w.y = cvt_pk_h(silu_f(g0[2]) * u0[2], silu_f(g0[3]) * u0[3]);
                w.z = cvt_pk_h(silu_f(g1[0]) * u1[0], silu_f(g1[1]) * u1[1]); w.w = cvt_pk_h(silu_f(g1[2]) * u1[2], silu_f(g1[3]) * u1[3]);
                *(u32x4*)rowp = w;
            }
    }
};
constexpr float HID_S = 4.0f, F8_MAX = 448.0f, F8_WMAX = 440.0f;
__device__ __forceinline__ unsigned pack4_f8(float a, float b, float c, float d) { int w = __builtin_amdgcn_cvt_pk_fp8_f32(a, b, 0, false); w = __builtin_amdgcn_cvt_pk_fp8_f32(c, d, w, true); return (unsigned)w; }
__device__ __forceinline__ float clamp_f8(float x) { return __builtin_amdgcn_fmed3f(x, -F8_MAX, F8_MAX); }
struct EpiSwiglu8 {
    static constexpr bool PERM = true, AFTER_DRAIN = false;
    unsigned char* O; int ldc; const float* rf; const float* tq; const float* bias; int bstride;
    __device__ __forceinline__ void operator()(const f32x4 (&acc)[2][2][4][2], const Unit& u, int wr, int wc, int fr, int fq) const {
        const int row0 = u.pm * BM + wr * 64 + fr, col0 = u.pn * HALF + wc * 32 + 8 * fq;
        const float* bp = bias + (size_t)(u.pm >> 5) * bstride + u.pn * BM + wc * 32 + 8 * fq;
        const float* tp = tq + u.pn * BM + wc * 32 + 8 * fq;
        const f32x4 bg0 = *(const f32x4*)bp, bg1 = *(const f32x4*)(bp + 4), bu0 = *(const f32x4*)(bp + HALF) * HID_S, bu1 = *(const f32x4*)(bp + HALF + 4) * HID_S;
        const f32x4 tg0 = *(const f32x4*)tp, tg1 = *(const f32x4*)(tp + 4), tu0 = *(const f32x4*)(tp + HALF) * HID_S, tu1 = *(const f32x4*)(tp + HALF + 4) * HID_S;
#pragma unroll
        for (int ai = 0; ai < 2; ++ai)
#pragma unroll
            for (int m = 0; m < 4; ++m) {
                const int row = row0 + ai * HALF + m * 16; const float rs = rf[row];
                unsigned char* rowp = O + (size_t)row * ldc + col0;
                const f32x4 g0 = (acc[ai][0][m][0] * rs) * tg0 + bg0, g1 = (acc[ai][0][m][1] * rs) * tg1 + bg1, u0 = (acc[ai][1][m][0] * rs) * tu0 + bu0, u1 = (acc[ai][1][m][1] * rs) * tu1 + bu1;
                unsigned long long w;
                const unsigned wlo = pack4_f8(clamp_f8(silu_f(g0[0]) * u0[0]), clamp_f8(silu_f(g0[1]) * u0[1]), clamp_f8(silu_f(g0[2]) * u0[2]), clamp_f8(silu_f(g0[3]) * u0[3]));
                const unsigned whi = pack4_f8(clamp_f8(silu_f(g1[0]) * u1[0]), clamp_f8(silu_f(g1[1]) * u1[1]), clamp_f8(silu_f(g1[2]) * u1[2]), clamp_f8(silu_f(g1[3]) * u1[3]));
                w = (unsigned long long)wlo | ((unsigned long long)whi << 32); *(unsigned long long*)rowp = w;
            }
    }
};
struct EpiResid {
    static constexpr bool PERM = true, AFTER_DRAIN = false;
    const u16* xin; u16* xout16; float* xout32; const float* gate; int out32;
    __device__ __forceinline__ void operator()(const f32x4 (&acc)[2][2][4][2], const Unit& u, int wr, int wc, int fr, int fq) const {
        const int row0 = u.pm * BM + wr * 64 + fr, col0 = u.pn * BM + wc * 32 + 8 * fq;
        const float* gp = gate + (size_t)(u.pm >> 5) * ADAW + col0;
        f32x4 gv[2][2];
#pragma unroll
        for (int bj = 0; bj < 2; ++bj)
#pragma unroll
            for (int n = 0; n < 2; ++n) gv[bj][n] = *(const f32x4*)(gp + bj * HALF + n * 4);
#pragma unroll
        for (int ai = 0; ai < 2; ++ai)
#pragma unroll
            for (int m = 0; m < 4; ++m) {
                const int row = row0 + ai * HALF + m * 16;
                const size_t ro = (size_t)row * DM + col0;
#pragma unroll
                for (int bj = 0; bj < 2; ++bj) {
                    const h16x8 xi = *(const h16x8*)(xin + ro + bj * HALF);
                    const f32x4 x0 = (f32x4){(float)xi[0], (float)xi[1], (float)xi[2], (float)xi[3]} + gv[bj][0] * acc[ai][bj][m][0], x1 = (f32x4){(float)xi[4], (float)xi[5], (float)xi[6], (float)xi[7]} + gv[bj][1] * acc[ai][bj][m][1];
                    if (out32) { *(f32x4*)(xout32 + ro + bj * HALF) = x0; *(f32x4*)(xout32 + ro + bj * HALF + 4) = x1; }
                    else { u32x4 w; w.x = cvt_pk_h(x0[0], x0[1]); w.y = cvt_pk_h(x0[2], x0[3]); w.z = cvt_pk_h(x1[0], x1[1]); w.w = cvt_pk_h(x1[2], x1[3]); *(u32x4*)(xout16 + ro + bj * HALF) = w; }
                }
            }
    }
};
struct EpiResidQ {
    static constexpr bool PERM = true, AFTER_DRAIN = false;
    const u16* xin; u16* xout16; float* xout32; const float* gate; const float* rfo; const float* tqo; int out32;
    __device__ __forceinline__ void operator()(const f32x4 (&acc)[2][2][4][2], const Unit& u, int wr, int wc, int fr, int fq) const {
        const int row0 = u.pm * BM + wr * 64 + fr, col0 = u.pn * BM + wc * 32 + 8 * fq;
        const float* gp = gate + (size_t)(u.pm >> 5) * ADAW + col0;
        f32x4 gv[2][2];
#pragma unroll
        for (int bj = 0; bj < 2; ++bj)
#pragma unroll
            for (int n = 0; n < 2; ++n) gv[bj][n] = *(const f32x4*)(gp + bj * HALF + n * 4) * *(const f32x4*)(tqo + col0 + bj * HALF + n * 4);
#pragma unroll
        for (int ai = 0; ai < 2; ++ai)
#pragma unroll
            for (int m = 0; m < 4; ++m) {
                const int row = row0 + ai * HALF + m * 16; const float rs = rfo ? rfo[row] : 1.0f;
                const size_t ro = (size_t)row * DM + col0;
#pragma unroll
                for (int bj = 0; bj < 2; ++bj) {
                    const h16x8 xi = *(const h16x8*)(xin + ro + bj * HALF);
                    const f32x4 x0 = (f32x4){(float)xi[0], (float)xi[1], (float)xi[2], (float)xi[3]} + gv[bj][0] * (acc[ai][bj][m][0] * rs), x1 = (f32x4){(float)xi[4], (float)xi[5], (float)xi[6], (float)xi[7]} + gv[bj][1] * (acc[ai][bj][m][1] * rs);
                    if (out32) { *(f32x4*)(xout32 + ro + bj * HALF) = x0; *(f32x4*)(xout32 + ro + bj * HALF + 4) = x1; }
                    else { u32x4 w; w.x = cvt_pk_h(x0[0], x0[1]); w.y = cvt_pk_h(x0[2], x0[3]); w.z = cvt_pk_h(x1[0], x1[1]); w.w = cvt_pk_h(x1[2], x1[3]); *(u32x4*)(xout16 + ro + bj * HALF) = w; }
                }
            }
    }
};
struct EpiF16 {
    static constexpr bool PERM = true, AFTER_DRAIN = false;
    u16* O; int ldc; RowCol rc;
    __device__ __forceinline__ void operator()(const f32x4 (&acc)[2][2][4][2], const Unit& u, int wr, int wc, int fr, int fq) const {
        const int row0 = u.pm * BM + wr * 64 + fr, col0 = u.pn * BM + wc * 32 + 8 * fq;
        const float* bp = rc.bias + (size_t)(u.pm >> 5) * rc.bstride + col0;
        f32x4 bv[2][2];
#pragma unroll
        for (int bj = 0; bj < 2; ++bj)
#pragma unroll
            for (int n = 0; n < 2; ++n) bv[bj][n] = *(const f32x4*)(bp + bj * HALF + n * 4);
#pragma unroll
        for (int ai = 0; ai < 2; ++ai)
#pragma unroll
            for (int m = 0; m < 4; ++m) {
                const int row = row0 + ai * HALF + m * 16; const float rs = rstd_of(rc.ssq, row);
                u16* rowp = O + (size_t)row * ldc + col0;
#pragma unroll
                for (int bj = 0; bj < 2; ++bj) {
                    const f32x4 v0 = acc[ai][bj][m][0] * rs + bv[bj][0], v1 = acc[ai][bj][m][1] * rs + bv[bj][1];
                    u32x4 w; w.x = cvt_pk_h(v0[0], v0[1]); w.y = cvt_pk_h(v0[2], v0[3]); w.z = cvt_pk_h(v1[0], v1[1]); w.w = cvt_pk_h(v1[2], v1[3]);
                    *(u32x4*)(rowp + bj * HALF) = w;
                }
            }
    }
};

struct EpiQkvA {
    static constexpr bool PERM = true, AFTER_DRAIN = false;
    u16* Qh; u16* Kh; u16* Vh; RowCol rc; const float* tq; const float* qgain; const float* kgain; const float* cost; const float* sint; PG8_LAS float* xch;
    __device__ __forceinline__ void operator()(const f32x4 (&acc)[2][2][4][2], const Unit& u, int wr, int wc, int fr, int fq) const {
        const int row0 = u.pm * BM + wr * 64 + fr, b = u.pm >> 5;
        {
            f32x4 (&a)[2][2][4][2] = const_cast<f32x4 (&)[2][2][4][2]>(acc);
            const float* tp = tq + u.pn * BM + wc * 32 + 8 * fq;
#pragma unroll
            for (int bj = 0; bj < 2; ++bj)
#pragma unroll
                for (int n = 0; n < 2; ++n) { const f32x4 tv = *(const f32x4*)(tp + bj * HALF + n * 4);
#pragma unroll
                    for (int ai = 0; ai < 2; ++ai)
#pragma unroll
                        for (int m = 0; m < 4; ++m) a[ai][bj][m][n] = a[ai][bj][m][n] * tv; }
        }
        const float* bp = rc.bias + (size_t)b * rc.bstride + u.pn * BM + wc * 32 + 8 * fq;
        f32x4 bv[2][2];
#pragma unroll
        for (int bj = 0; bj < 2; ++bj)
#pragma unroll
            for (int n = 0; n < 2; ++n) bv[bj][n] = *(const f32x4*)(bp + bj * HALF + n * 4);
        if (u.pn >= 16) {
#pragma unroll
            for (int ai = 0; ai < 2; ++ai)
#pragma unroll
                for (int m = 0; m < 4; ++m) {
                    const int row = row0 + ai * HALF + m * 16, t = row & (SEQ - 1); const float rs = rc.ssq[row];
#pragma unroll
                    for (int bj = 0; bj < 2; ++bj) {
                        const f32x4 v0 = acc[ai][bj][m][0] * rs + bv[bj][0], v1 = acc[ai][bj][m][1] * rs + bv[bj][1];
                        u32x4 w; w.x = cvt_pk_h(v0[0], v0[1]); w.y = cvt_pk_h(v0[2], v0[3]); w.z = cvt_pk_h(v1[0], v1[1]); w.w = cvt_pk_h(v1[2], v1[3]);
                        *(u32x4*)(Vh + ((size_t)(b * 16 + 2 * (u.pn - 16) + bj) * SEQ + t) * 128 + wc * 32 + 8 * fq) = w;
                    }
                }
            return;
        }
        int frx = fr; asm volatile("" : "+v"(frx));
        const int wid = wr * 4 + wc, dlo = 32 * (wc & 1) + 8 * fq;
        const float* gp = (u.pn < 8 ? qgain : kgain) + dlo;
        f32x4 gn[2][2];
#pragma unroll
        for (int bj = 0; bj < 2; ++bj)
#pragma unroll
            for (int n = 0; n < 2; ++n) gn[bj][n] = *(const f32x4*)(gp + 64 * bj + 4 * n);
#pragma unroll
        for (int ai = 0; ai < 2; ++ai)
#pragma unroll
            for (int m = 0; m < 4; ++m) {
                const int row = row0 + ai * HALF + m * 16; const float rs = rc.ssq[row];
                float ss = 0.f;
#pragma unroll
                for (int bj = 0; bj < 2; ++bj)
#pragma unroll
                    for (int n = 0; n < 2; ++n) { const f32x4 v = acc[ai][bj][m][n] * rs + bv[bj][n]; ss += (v[0] * v[0] + v[1] * v[1]) + (v[2] * v[2] + v[3] * v[3]); }
                ss += swz_xor<16>(ss); ss = add_xor32(ss);
                if (fq == 0) xch[wid * 128 + ai * 64 + m * 16 + frx] = ss;
            }
        asm volatile("s_waitcnt lgkmcnt(0)" ::: "memory"); __builtin_amdgcn_s_barrier(); asm volatile("" ::: "memory");
        u16* dstb = (u.pn < 8 ? Qh : Kh) + ((size_t)(b * 16 + 2 * (u.pn & 7) + (wc >> 1)) * SEQ) * 128 + dlo;
#pragma unroll
        for (int ai = 0; ai < 2; ++ai)
#pragma unroll
            for (int m = 0; m < 4; ++m) {
                const int rl = ai * 64 + m * 16 + frx, row = row0 + ai * HALF + m * 16, t = row & (SEQ - 1);
                const float tot = xch[wid * 128 + rl] + xch[(wid ^ 1) * 128 + rl];
                const float rs = rc.ssq[row], rn = rsqrtf(tot * (1.0f / 128.0f) + NORM_EPS);
                const f32x4 c0 = *(const f32x4*)(cost + t * 64 + dlo), c1 = *(const f32x4*)(cost + t * 64 + dlo + 4), s0 = *(const f32x4*)(sint + t * 64 + dlo), s1 = *(const f32x4*)(sint + t * 64 + dlo + 4);
                const f32x4 a0 = (acc[ai][0][m][0] * rs + bv[0][0]) * rn * gn[0][0], a1 = (acc[ai][0][m][1] * rs + bv[0][1]) * rn * gn[0][1], b0 = (acc[ai][1][m][0] * rs + bv[1][0]) * rn * gn[1][0], b1 = (acc[ai][1][m][1] * rs + bv[1][1]) * rn * gn[1][1];
                const f32x4 lo0 = a0 * c0 - b0 * s0, lo1 = a1 * c1 - b1 * s1, hi0 = b0 * c0 + a0 * s0, hi1 = b1 * c1 + a1 * s1;
                u16* dp = dstb + (size_t)t * 128;
                u32x4 w; w.x = cvt_pk_h(lo0[0], lo0[1]); w.y = cvt_pk_h(lo0[2], lo0[3]); w.z = cvt_pk_h(lo1[0], lo1[1]); w.w = cvt_pk_h(lo1[2], lo1[3]);
                *(u32x4*)dp = w;
                w.x = cvt_pk_h(hi0[0], hi0[1]); w.y = cvt_pk_h(hi0[2], hi0[3]); w.z = cvt_pk_h(hi1[0], hi1[1]); w.w = cvt_pk_h(hi1[2], hi1[3]);
                *(u32x4*)(dp + 64) = w;
            }
        asm volatile("s_waitcnt lgkmcnt(0)" ::: "memory"); __builtin_amdgcn_s_barrier(); asm volatile("" ::: "memory");
    }
};
typedef int i32x8 __attribute__((ext_vector_type(8)));
__device__ __forceinline__ void mfma_f8_tied(f32x4& c, i32x8 a, i32x8 b) { asm volatile("v_mfma_f32_16x16x128_f8f6f4 %0, %1, %2, %0" : "+v"(c) : "v"(a), "v"(b)); }
template <class Epi, class Sched, bool ALIGN_EPI = false, bool SP2 = false, int I8 = 0>
__device__ __forceinline__ void gemm_phase(PG8_LAS unsigned char* lds, const Gemm g, const Sched& S, const Epi& E) {
    const int tid = opaque_tid(), wid = __builtin_amdgcn_readfirstlane(tid >> 6), lane = tid & 63, wr = wid >> 2, wc = wid & 3, fr = lane & 15, fq = lane >> 4;
    const int K = g.K, nt = K / BK;
    unsigned voffA[2], voffB[2];
#pragma unroll
    for (int i = 0; i < 2; ++i) { int R, C; stage_rc(tid * 16 + i * 8192, R, C); const int Rb = Epi::PERM ? ((R & ~31) + perm32(R & 31)) : R;
        voffA[i] = (unsigned)(R * K + C) * 2u; voffB[i] = (unsigned)(Rb * K + C) * 2u; }
    const size_t kstep = (size_t)(BK * 2);
    const size_t hstep = (size_t)HALF * K * 2;
    const size_t tstep = 2 * hstep;
    const unsigned ldsw = (unsigned)wid * 1024u;
    const int aoff = lds_byte(wr * 64 + fr, fq * 8), boff = lds_byte(wc * 32 + fr, fq * 8);
#define PG8_SA(b, h) (((b) * 2 + (h)) * HTB)
#define PG8_SB(b, h) ((4 + (b) * 2 + (h)) * HTB)
#define PG8_STAGE(bufoff, gbase, voff) do { _Pragma("unroll") for (int _i = 0; _i < 2; ++_i) \
        __builtin_amdgcn_global_load_lds((const unsigned*)((const char*)(gbase) + (voff)[_i]), (PG8_LAS unsigned*)(lds + (bufoff) + ldsw + _i * 8192), 16, 0, 0); } while (0)
#define PG8_LDA(dst, b, h) do { _Pragma("unroll") for (int m = 0; m < 4; ++m) _Pragma("unroll") for (int k = 0; k < 2; ++k) dst[m][k] = *(const PG8_LAS bf16x8*)(lds + PG8_SA(b, h) + aoff + m * 2048 + k * 1024); } while (0)
#define PG8_LDB(dst, b, h) do { _Pragma("unroll") for (int n = 0; n < 2; ++n) _Pragma("unroll") for (int k = 0; k < 2; ++k) dst[n][k] = *(const PG8_LAS bf16x8*)(lds + PG8_SB(b, h) + boff + n * 2048 + k * 1024); } while (0)
#define PG8_MMA(ai, bj, At, Bt) do { __builtin_amdgcn_s_setprio(1); _Pragma("unroll") for (int m = 0; m < 4; ++m) _Pragma("unroll") for (int n = 0; n < 2; ++n) _Pragma("unroll") for (int k = 0; k < (I8 == 2 ? 1 : 2); ++k) { \
        if constexpr (I8 == 2) mfma_f8_tied(acc[ai][bj][m][n], __builtin_shufflevector(__builtin_bit_cast(i32x4, Bt[n][0]), __builtin_bit_cast(i32x4, Bt[n][1]), 0, 1, 2, 3, 4, 5, 6, 7), \
                __builtin_shufflevector(__builtin_bit_cast(i32x4, At[m][0]), __builtin_bit_cast(i32x4, At[m][1]), 0, 1, 2, 3, 4, 5, 6, 7)); \
        else if constexpr (I8 == 1) acc[ai][bj][m][n] = __builtin_bit_cast(f32x4, __builtin_amdgcn_mfma_i32_16x16x64_i8(__builtin_bit_cast(i32x4, Bt[n][k]), __builtin_bit_cast(i32x4, At[m][k]), __builtin_bit_cast(i32x4, acc[ai][bj][m][n]), 0, 0, 0)); \
        else acc[ai][bj][m][n] = __builtin_amdgcn_mfma_f32_16x16x32_f16(__builtin_bit_cast(h16x8, Bt[n][k]), __builtin_bit_cast(h16x8, At[m][k]), acc[ai][bj][m][n], 0, 0, 0); } __builtin_amdgcn_s_setprio(0); } while (0)
#define PG8_WAIT_V(n) asm volatile("s_waitcnt vmcnt(" #n ")" ::: "memory")
#define PG8_WAIT_L(n) asm volatile("s_waitcnt lgkmcnt(" #n ")" ::: "memory")
#define PG8_BAR __builtin_amdgcn_s_barrier()
#define PG8_SCHED __builtin_amdgcn_sched_barrier(0)
    Unit cur, nxt; int ui = 0;
    if (!S.next(0, cur)) return;
    f32x4 acc[2][2][4][2];
#pragma unroll
    for (int a = 0; a < 2; ++a)
#pragma unroll
        for (int b = 0; b < 2; ++b)
#pragma unroll
            for (int m = 0; m < 4; ++m)
#pragma unroll
                for (int n = 0; n < 2; ++n) acc[a][b][m][n] = (f32x4){0.f, 0.f, 0.f, 0.f};
    bf16x8 At[4][2], B0[2][2], B1[2][2];
    const char* cA = (const char*)g.A + (size_t)cur.pm * tstep; const char* cB = (const char*)g.Bt + (size_t)cur.pn * tstep;
    S.a_ready(cur);
    if constexpr (SP2) {
        PG8_STAGE(PG8_SB(0, 0), cB, voffB); PG8_STAGE(PG8_SB(0, 1), cB + hstep, voffB); PG8_STAGE(PG8_SA(0, 0), cA, voffA); PG8_STAGE(PG8_SA(0, 1), cA + hstep, voffA);
        if (wr == 1) PG8_BAR;
        PG8_WAIT_V(2); PG8_BAR;
        PG8_STAGE(PG8_SB(1, 0), cB + kstep, voffB); PG8_STAGE(PG8_SA(1, 0), cA + kstep, voffA); PG8_STAGE(PG8_SB(1, 1), cB + hstep + kstep, voffB);
        PG8_WAIT_V(6); PG8_BAR;
    } else {
        PG8_STAGE(PG8_SB(0, 0), cB, voffB); PG8_STAGE(PG8_SA(0, 0), cA, voffA); PG8_STAGE(PG8_SB(0, 1), cB + hstep, voffB); PG8_STAGE(PG8_SA(0, 1), cA + hstep, voffA);
        if (wr == 1) PG8_BAR;
        PG8_WAIT_V(4); PG8_BAR;
        PG8_STAGE(PG8_SB(1, 0), cB + kstep, voffB); PG8_STAGE(PG8_SA(1, 0), cA + kstep, voffA); PG8_STAGE(PG8_SB(1, 1), cB + hstep + kstep, voffB);
        PG8_WAIT_V(6); PG8_BAR;
    }
    for (;;) {
        const bool has_next = S.next(ui + 1, nxt);
        const char* nA = has_next ? (const char*)g.A + (size_t)nxt.pm * tstep : cA; const char* nB = has_next ? (const char*)g.Bt + (size_t)nxt.pn * tstep : cB;
        for (int t = 0; t < nt; t += 2) {
            const bool last = (t == nt - 2);
            const char* a1 = cA + (size_t)(t + 1) * kstep;
            const char* a2 = last ? nA : cA + (size_t)(t + 2) * kstep; const char* b2 = last ? nB : cB + (size_t)(t + 2) * kstep;
            const char* a3 = a2 + kstep; const char* b3 = b2 + kstep;
            if (last && has_next) S.a_ready(nxt);
            if constexpr (SP2) {
            PG8_LDB(B0, 0, 0); PG8_LDB(B1, 0, 1); PG8_SCHED; PG8_LDA(At, 0, 0); PG8_STAGE(PG8_SA(1, 1), a1 + hstep, voffA);
            PG8_WAIT_V(8); PG8_WAIT_L(0); PG8_BAR; PG8_MMA(0, 0, At, B0); PG8_MMA(0, 1, At, B1); PG8_BAR; PG8_SCHED;
            PG8_LDA(At, 0, 1); PG8_STAGE(PG8_SB(0, 0), b2, voffB); PG8_STAGE(PG8_SB(0, 1), b2 + hstep, voffB); PG8_STAGE(PG8_SA(0, 0), a2, voffA);
            PG8_WAIT_V(8); PG8_WAIT_L(0); PG8_BAR; PG8_MMA(1, 0, At, B0); PG8_MMA(1, 1, At, B1); PG8_BAR; PG8_SCHED;
            PG8_LDB(B0, 1, 0); PG8_LDB(B1, 1, 1); PG8_SCHED; PG8_LDA(At, 1, 0); PG8_STAGE(PG8_SA(0, 1), a2 + hstep, voffA);
            PG8_WAIT_V(8); PG8_WAIT_L(0); PG8_BAR; PG8_MMA(0, 0, At, B0); PG8_MMA(0, 1, At, B1); PG8_BAR; PG8_SCHED;
            PG8_LDA(At, 1, 1); PG8_STAGE(PG8_SB(1, 0), b3, voffB); PG8_STAGE(PG8_SB(1, 1), b3 + hstep, voffB); PG8_STAGE(PG8_SA(1, 0), a3, voffA);
            PG8_WAIT_V(8); PG8_WAIT_L(0); PG8_BAR; PG8_MMA(1, 0, At, B0); PG8_MMA(1, 1, At, B1); PG8_BAR; PG8_SCHED;
            } else {
            PG8_LDB(B0, 0, 0); PG8_SCHED; PG8_LDA(At, 0, 0); PG8_STAGE(PG8_SA(1, 1), a1 + hstep, voffA);
            PG8_WAIT_L(8); PG8_BAR; PG8_WAIT_L(0); PG8_MMA(0, 0, At, B0); PG8_BAR; PG8_SCHED;
            PG8_LDB(B1, 0, 1); PG8_STAGE(PG8_SB(0, 0), b2, voffB);
            PG8_BAR; PG8_WAIT_L(0); PG8_MMA(0, 1, At, B1); PG8_BAR;
            PG8_LDA(At, 0, 1); PG8_STAGE(PG8_SA(0, 0), a2, voffA);
            PG8_BAR; PG8_WAIT_L(0); PG8_MMA(1, 0, At, B0); PG8_BAR; PG8_SCHED;
            PG8_STAGE(PG8_SB(0, 1), b2 + hstep, voffB);
            PG8_WAIT_V(6); PG8_BAR; PG8_MMA(1, 1, At, B1); PG8_BAR;
            PG8_LDB(B0, 1, 0); PG8_SCHED; PG8_LDA(At, 1, 0); PG8_STAGE(PG8_SA(0, 1), a2 + hstep, voffA);
            PG8_WAIT_L(8); PG8_BAR; PG8_WAIT_L(0); PG8_MMA(0, 0, At, B0); PG8_BAR; PG8_SCHED;
            PG8_LDB(B1, 1, 1); PG8_STAGE(PG8_SB(1, 0), b3, voffB);
            PG8_BAR; PG8_WAIT_L(0); PG8_MMA(0, 1, At, B1); PG8_BAR;
            PG8_LDA(At, 1, 1); PG8_STAGE(PG8_SA(1, 0), a3, voffA);
            PG8_BAR; PG8_WAIT_L(0); PG8_MMA(1, 0, At, B0); PG8_BAR; PG8_SCHED;
            PG8_STAGE(PG8_SB(1, 1), b3 + hstep, voffB);
            PG8_WAIT_V(6); PG8_BAR; PG8_MMA(1, 1, At, B1); PG8_BAR;
            }
        }
        if constexpr (ALIGN_EPI) { if (wr == 0) PG8_BAR; }
        if constexpr (I8 == 2) asm volatile("s_nop 15\n\ts_nop 15" ::: "memory");
        if constexpr (I8 == 1) {
#pragma unroll
            for (int a = 0; a < 2; ++a)
#pragma unroll
                for (int b = 0; b < 2; ++b)
#pragma unroll
                    for (int m = 0; m < 4; ++m)
#pragma unroll
                        for (int n = 0; n < 2; ++n) { const i32x4 iv = __builtin_bit_cast(i32x4, acc[a][b][m][n]); acc[a][b][m][n] = (f32x4){(float)iv[0], (float)iv[1], (float)iv[2], (float)iv[3]}; }
        }
        if constexpr (!Epi::AFTER_DRAIN) { E(acc, cur, wr, wc, fr, fq); S.done(cur); }
        if (!has_next) break;
#pragma unroll
        for (int a = 0; a < 2; ++a)
#pragma unroll
            for (int b = 0; b < 2; ++b)
#pragma unroll
                for (int m = 0; m < 4; ++m)
#pragma unroll
                    for (int n = 0; n < 2; ++n) acc[a][b][m][n] = (f32x4){0.f, 0.f, 0.f, 0.f};
        cur = nxt; cA = nA; cB = nB; ++ui;
        if constexpr (ALIGN_EPI) { if (wr == 1) PG8_BAR; }
    }
    PG8_WAIT_V(0);
    if constexpr (!ALIGN_EPI) { if (wr == 0) PG8_BAR; }
    PG8_BAR;
    if constexpr (Epi::AFTER_DRAIN) { E.fused(acc, cur, wr, wc, fr, fq, lds, wid, lane); S.done(cur); }
#undef PG8_SA
#undef PG8_SB
#undef PG8_STAGE
#undef PG8_LDA
#undef PG8_LDB
#undef PG8_MMA
#undef PG8_WAIT_V
#undef PG8_WAIT_L
#undef PG8_BAR
#undef PG8_SCHED
}
}

namespace att {
typedef short bf16x8 __attribute__((ext_vector_type(8)));
typedef short s16x4 __attribute__((ext_vector_type(4)));
typedef float f32x16 __attribute__((ext_vector_type(16)));
typedef float f32x4 __attribute__((ext_vector_type(4)));
typedef unsigned u32x4 __attribute__((ext_vector_type(4)));
template <class A, class Bt> struct same_t { static constexpr bool v = false; };
template <class A> struct same_t<A, A> { static constexpr bool v = true; };
constexpr int D = 128;
constexpr float THR = 8.f;
constexpr bool WSKIP = false;
constexpr float SCALE = 0.08838834764831845f;
constexpr int NW = 8, QBLK = 32, KVBLK = 64, QB = NW * QBLK;
constexpr int SHM_V = KVBLK * D * 2, SHM_K = KVBLK * D * 2;
constexpr int LDS_BYTES = 2 * SHM_V + 2 * SHM_K + NW * 64 * 4;
__device__ __forceinline__ f32x16 mfma32h(bf16x8 a, bf16x8 b, f32x16 c, int, int, int) {
    return __builtin_amdgcn_mfma_f32_32x32x16_f16(__builtin_bit_cast(h16x8, a), __builtin_bit_cast(h16x8, b), c, 0, 0, 0);
}
#define KSWZ(row, colB) ((row) * 256 + ((colB) ^ (((row) & 7) << 4)))
#define SBAR() __builtin_amdgcn_sched_barrier(0)
__device__ __forceinline__ int v_st(int k, int c) { const int kk = (k & ~0xC) | ((k & 4) << 1) | ((k & 8) >> 1); return ((kk >> 3) * 4 + (c >> 5)) * 512 + ((kk & 7) * 32 + (c & 31)) * 2; }
__device__ __forceinline__ int v_rd_base(int lane) { return ((lane & 3) << 3) | (((lane >> 2) & 3) << 6) | (((lane >> 4) & 1) << 5) | (((lane >> 5) & 1) << 8); }
constexpr int v_rd_off(int d0, int ks, int half) { return d0 * 512 + ks * 4096 + half * 2048; }
__device__ __forceinline__ int crow(int r, int hi) { return (r & 3) + 8 * (r >> 2) + 4 * hi; }
__device__ __forceinline__ unsigned cvtpk(float lo, float hi) {
    unsigned r; asm volatile("v_cvt_pk_f16_f32 %0, %1, %2" : "=v"(r) : "v"(lo), "v"(hi)); return r;
}
__device__ __forceinline__ bf16x8 pack8(f32x4 a, f32x4 b) {
    u32x4 w = {cvtpk(a[0], a[1]), cvtpk(a[2], a[3]), cvtpk(b[0], b[1]), cvtpk(b[2], b[3])};
    return *reinterpret_cast<bf16x8*>(&w);
}
template <class T> __device__ __forceinline__ bf16x8 load8(const T* p) {
    if constexpr (same_t<T, float>::v) { return pack8(*(const f32x4*)p, *(const f32x4*)(p + 4)); }
    else { return *reinterpret_cast<const bf16x8*>(p); }
}
__device__ __forceinline__ void mask_tile(f32x16& p0, f32x16& p1, int dq, unsigned W) {
    const float NEG = -__builtin_inff();
#pragma unroll
    for (int r = 0; r < 16; ++r) {
        const int c = (r & 3) + 8 * (r >> 2);
        if ((unsigned)(dq - c) >= W) p0[r] = NEG;
        if ((unsigned)(dq - c - 32) >= W) p1[r] = NEG;
    }
}
__device__ __forceinline__ void partialSM(f32x16& p0, f32x16& p1, float& m_reg, float& mn, float& alpha) {
    float pmax = p0[0]; for (int r = 1; r < 16; ++r) pmax = fmaxf(pmax, p0[r]); for (int r = 0; r < 16; ++r) pmax = fmaxf(pmax, p1[r]);
    { auto rr = __builtin_amdgcn_permlane32_swap(__float_as_uint(pmax), __float_as_uint(pmax), false, false);
      pmax = fmaxf(__uint_as_float(rr[0]), __uint_as_float(rr[1])); }
    constexpr float C2 = 1.4426950408889634f * SCALE;
    if (__builtin_expect(__all((pmax - m_reg) * SCALE <= THR), 1)) { mn = m_reg; alpha = 1.f; }
    else { mn = fmaxf(m_reg, pmax); alpha = __builtin_amdgcn_exp2f((m_reg - mn) * C2); m_reg = mn; }
    const float mnL = -mn * C2;
    for (int r = 0; r < 16; ++r) p0[r] = fmaf(p0[r], C2, mnL); for (int r = 0; r < 16; ++r) p1[r] = fmaf(p1[r], C2, mnL);
    for (int r = 0; r < 16; ++r) p0[r] = __builtin_amdgcn_exp2f(p0[r]);
}
__device__ __forceinline__ void finishSM(f32x16& p0, f32x16& p1, float alpha, float& l_reg, bf16x8& pa0, bf16x8& pa1, bf16x8& pa2, bf16x8& pa3) {
    for (int r = 0; r < 16; ++r) p1[r] = __builtin_amdgcn_exp2f(p1[r]);
    float ps = 0; for (int r = 0; r < 16; ++r) ps += p0[r]; for (int r = 0; r < 16; ++r) ps += p1[r];
    { auto rr = __builtin_amdgcn_permlane32_swap(__float_as_uint(ps), __float_as_uint(ps), false, false);
      ps = __uint_as_float(rr[0]) + __uint_as_float(rr[1]); }
    l_reg = l_reg * alpha + ps;
#define PK4(P, B_, OUT) do { unsigned a0 = cvtpk(P[B_+0], P[B_+1]), a1 = cvtpk(P[B_+2], P[B_+3]);                          \
        unsigned b0 = cvtpk(P[B_+4], P[B_+5]), b1 = cvtpk(P[B_+6], P[B_+7]);                                             \
        auto r0 = __builtin_amdgcn_permlane32_swap(a0, b0, false, false); auto r1 = __builtin_amdgcn_permlane32_swap(a1, b1, false, false); \
        u32x4 w = {r0[0], r1[0], r0[1], r1[1]}; OUT = *reinterpret_cast<bf16x8*>(&w); } while (0)
    PK4(p0, 0, pa0); PK4(p0, 8, pa1); PK4(p1, 0, pa2); PK4(p1, 8, pa3);
#undef PK4
}
template <int KB, bool SK>
__device__ __forceinline__ void qkt(f32x16& p0, f32x16& p1, const char* K_lds, int r32, int hi, const bf16x8* qr, bool act) {
    if (SK && !act) { const float NEG = -__builtin_inff();
#pragma unroll
        for (int r = 0; r < 16; ++r) { p0[r] = NEG; p1[r] = NEG; } return; }
    p0 = f32x16{}; p1 = f32x16{};
    const char* kb[4];
#pragma unroll
    for (int dd = 0; dd < 4; ++dd) kb[dd] = K_lds + KB * SHM_K + KSWZ(r32, (dd * 16 + hi * 8) * 2);
#pragma unroll
    for (int d0 = 0; d0 < 8; ++d0) { const char* a = kb[d0 & 3] + (d0 >> 2) * 128;
        bf16x8 b0 = *reinterpret_cast<const bf16x8*>(a);
        bf16x8 b1 = *reinterpret_cast<const bf16x8*>(a + 32 * 256);
        p0 = mfma32h(b0, qr[d0], p0, 0, 0, 0);
        p1 = mfma32h(b1, qr[d0], p1, 0, 0, 0); }
}
template <int VB, bool SK>
__device__ __forceinline__ void pv_tile(f32x16* o, int vb0, bf16x8 pa0, bf16x8 pa1, bf16x8 pa2, bf16x8 pa3, bool act) {
    if (SK && !act) return;
#define TRRD(dst, off) asm volatile("ds_read_b64_tr_b16 %0, %1 offset:%2" : "=&v"(dst) : "v"(vb0), "i"(off) : "memory")
#define PV_D0(d0) do { s16x4 l0, l1, l2, l3, h0, h1, h2, h3; constexpr int b_ = VB * SHM_V + v_rd_off(d0, 0, 0);     \
        TRRD(l0, b_); TRRD(h0, b_ + 2048); TRRD(l1, b_ + 4096); TRRD(h1, b_ + 6144); TRRD(l2, b_ + 8192); TRRD(h2, b_ + 10240); TRRD(l3, b_ + 12288); TRRD(h3, b_ + 14336); \
        asm volatile("s_waitcnt lgkmcnt(0)" ::: "memory"); SBAR();                 \
        o[d0] = mfma32h(pa0, (bf16x8){l0[0], l0[1], l0[2], l0[3], h0[0], h0[1], h0[2], h0[3]}, o[d0], 0, 0, 0);   \
        o[d0] = mfma32h(pa1, (bf16x8){l1[0], l1[1], l1[2], l1[3], h1[0], h1[1], h1[2], h1[3]}, o[d0], 0, 0, 0);   \
        o[d0] = mfma32h(pa2, (bf16x8){l2[0], l2[1], l2[2], l2[3], h2[0], h2[1], h2[2], h2[3]}, o[d0], 0, 0, 0);   \
        o[d0] = mfma32h(pa3, (bf16x8){l3[0], l3[1], l3[2], l3[3], h3[0], h3[1], h3[2], h3[3]}, o[d0], 0, 0, 0); } while (0)
    PV_D0(0); PV_D0(1); PV_D0(2); PV_D0(3);
#undef PV_D0
#undef TRRD
}

template <class TIn, class TOut> struct BlockRef { const TIn* Q; const TIn* K; const TIn* V; TOut* O; int P0; };
template <class TIn> struct Seam {
    bf16x8 qr[8];
    bf16x8 st_v0, st_v1, st_k0, st_k1; f32x4 sf0, sf1, sf2, sf3;
    f32x4 tq[16];
};
__device__ __forceinline__ int swa_jlo(int P0, int W) { const int lowk = P0 - W + 1; return lowk > 0 ? lowk / KVBLK : 0; }
#define ROW(p, k0, rr) ((p) + (size_t)((k0) + (rr)) * D + sc)
#define VMW() asm volatile("s_waitcnt vmcnt(0)" ::: "memory")
#define VMWN(n) asm volatile("s_waitcnt vmcnt(%0)" :: "i"(n) : "memory")
#define SLOAD_H(Kp, Vp, k0) do { S.st_v0 = load8<TIn>(ROW(Vp, k0, sr)); S.st_v1 = load8<TIn>(ROW(Vp, k0, 32 + sr));              \
                         S.st_k0 = load8<TIn>(ROW(Kp, k0, sr)); S.st_k1 = load8<TIn>(ROW(Kp, k0, 32 + sr)); } while (0)
#define SWRITE_HK(bf) do { *(bf16x8*)(K_lds + (bf) * SHM_K + kws) = S.st_k0; *(bf16x8*)(K_lds + (bf) * SHM_K + kws + 32 * 256) = S.st_k1; } while (0)
#define SWRITE_HV(bf) do { *(bf16x8*)(V_lds + (bf) * SHM_V + vst0) = S.st_v0; *(bf16x8*)(V_lds + (bf) * SHM_V + vst1) = S.st_v1; } while (0)
#define SWRITE_H(bf) do { SWRITE_HV(bf); SWRITE_HK(bf); } while (0)
#define SLOAD_F(p, k0) do { S.sf0 = *(const f32x4*)ROW(p, k0, sr); S.sf1 = *(const f32x4*)(ROW(p, k0, sr) + 4);                \
                            S.sf2 = *(const f32x4*)ROW(p, k0, 32 + sr); S.sf3 = *(const f32x4*)(ROW(p, k0, 32 + sr) + 4); } while (0)
#define SWRITE_KF(bf) do { *(bf16x8*)(K_lds + (bf) * SHM_K + kws) = pack8(S.sf0, S.sf1); *(bf16x8*)(K_lds + (bf) * SHM_K + kws + 32 * 256) = pack8(S.sf2, S.sf3); } while (0)
#define SWRITE_VF(bf) do { *(bf16x8*)(V_lds + (bf) * SHM_V + vst0) = pack8(S.sf0, S.sf1); *(bf16x8*)(V_lds + (bf) * SHM_V + vst1) = pack8(S.sf2, S.sf3); } while (0)
template <class TIn, class TOut>
__device__ __forceinline__ void causal_swa_prime(const BlockRef<TIn, TOut>& cur, int W, char* lds, Seam<TIn>& S) {
    constexpr bool F32 = same_t<TIn, float>::v;
    const int tid = opaque_tid(), wid = __builtin_amdgcn_readfirstlane(tid >> 6), lane = tid & 63, r32 = lane & 31, hi = lane >> 5;
    const int sr = tid >> 4, sc = (tid & 15) * 8, kws = KSWZ(sr, sc * 2); char* K_lds = lds + 2 * SHM_V;
    const int kb0 = swa_jlo(cur.P0, W) * KVBLK;
    for (int d0 = 0; d0 < 8; ++d0) S.qr[d0] = load8<TIn>(cur.Q + (size_t)(wid * QBLK + r32) * D + d0 * 16 + hi * 8);
    if constexpr (F32) { SLOAD_F((const float*)cur.K, kb0); VMW(); SWRITE_KF(0); SBAR(); SLOAD_F((const float*)cur.V, kb0); }
    else { SLOAD_H(cur.K, cur.V, kb0); VMW(); SWRITE_HK(0); }
    __syncthreads();
}
template <class TIn, class TOut>
__device__ __forceinline__ void causal_swa_block(const BlockRef<TIn, TOut>& cur, const BlockRef<TIn, TOut>& nxt, int skv, int W, char* lds, Seam<TIn>& S) {
    constexpr bool F32 = same_t<TIn, float>::v;
    const int tid = opaque_tid(), wid = __builtin_amdgcn_readfirstlane(tid >> 6), lane = tid & 63, r32 = lane & 31, hi = lane >> 5;
    const int j_lo = swa_jlo(cur.P0, W);
    int j_hi = (cur.P0 + QB - 1) / KVBLK + 1; if (j_hi > skv / KVBLK) j_hi = skv / KVBLK;
    const int NT = j_hi - j_lo;
    const int kbn = swa_jlo(nxt.P0, W) * KVBLK;
    const int qlo = cur.P0 + wid * QBLK, qm = qlo + r32 - 4 * hi;
    char* V_lds = lds; char* K_lds = lds + 2 * SHM_V;
    float* ws = (float*)(lds + 2 * SHM_V + 2 * SHM_K) + wid * 64; float* li_l = ws, * al_l = ws + 32;
    float m_reg = -1e30f, l_reg = 0; f32x16 o[4] = {};
    const int sr = tid >> 4, sc = (tid & 15) * 8, vst0 = v_st(sr, sc), vst1 = v_st(32 + sr, sc), kws = KSWZ(sr, sc * 2);
    const int vb0 = (int)(uintptr_t)V_lds + v_rd_base(lane);
    const TIn* Kh = cur.K; const TIn* Vh = cur.V;
#define RESC(a) do { if (__any((a) < 1.f)) { if (hi == 0) al_l[r32] = (a); asm volatile("s_waitcnt lgkmcnt(0)" ::: "memory");              \
                     for (int d_ = 0; d_ < 4; ++d_) for (int r = 0; r < 16; ++r) o[d_][r] *= al_l[crow(r, hi)]; } } while (0)
#define KBASE(t) ((j_lo + (t)) * KVBLK)
#define ACT(t) (KBASE(t) <= qlo + QBLK - 1 && KBASE(t) + KVBLK - 1 >= qlo - W + 1)
#define MASKT(P0_, P1_, t) do { const int kb_ = KBASE(t); if ((!SK || ACT(t)) && (kb_ + KVBLK - 1 > qlo || kb_ <= qlo + QBLK - 1 - W)) mask_tile(P0_, P1_, qm - kb_, (unsigned)W); } while (0)
    constexpr int NQL = F32 ? 16 : 8;
    constexpr bool SK = WSKIP && !F32;
#define SEAM_K0() do { VMWN(NQL); if constexpr (F32) { SWRITE_KF(0); SBAR(); SLOAD_F((const float*)nxt.V, kbn); } else { SWRITE_HK(0); } SBAR(); } while (0)
    f32x16 pA0, pA1, pB0, pB1; float mnA, mnB, alA, alB; bf16x8 pa0, pa1, pa2, pa3;
    if constexpr (F32) { VMW(); SWRITE_VF(0); SBAR(); } else { SWRITE_HV(0); SBAR(); }
    if (NT > 1) { if constexpr (F32) SLOAD_F((const float*)Kh, KBASE(1)); else SLOAD_H(Kh, Vh, KBASE(1)); }
    SBAR(); qkt<0, SK>(pA0, pA1, K_lds, r32, hi, S.qr, ACT(0));
    if constexpr (F32) { if (NT > 1) { VMW(); SWRITE_KF(1); SBAR(); SLOAD_F((const float*)Vh, KBASE(1)); } }
    MASKT(pA0, pA1, 0); partialSM(pA0, pA1, m_reg, mnA, alA);
    if (NT > 1) { VMW(); if constexpr (F32) { SWRITE_VF(1); SBAR(); if (NT > 2) SLOAD_F((const float*)Kh, KBASE(2)); } else SWRITE_H(1); }
    __syncthreads();
#define HALF_STEP(PX0, PX1, mnX, alX, PY0, PY1, alY, t, KB, VB, SB) do {                                                      \
        SBAR(); qkt<KB, SK>(PX0, PX1, K_lds, r32, hi, S.qr, ACT(t));                                             \
        finishSM(PY0, PY1, alY, l_reg, pa0, pa1, pa2, pa3); SBAR();                                                           \
        if ((t) + 1 < NT) { if constexpr (F32) { VMW(); SWRITE_KF(SB); SBAR(); SLOAD_F((const float*)Vh, KBASE((t) + 1)); }  \
                            else { SLOAD_H(Kh, Vh, KBASE((t) + 1)); } SBAR(); }                                               \
        pv_tile<VB, SK>(o, vb0, pa0, pa1, pa2, pa3, ACT((t) - 1)); MASKT(PX0, PX1, (t)); partialSM(PX0, PX1, m_reg, mnX, alX);                                        \
        __syncthreads();                                                                                                      \
        if ((t) + 1 < NT) { VMW(); if constexpr (F32) { SWRITE_VF(SB); SBAR(); if ((t) + 2 < NT) SLOAD_F((const float*)Kh, KBASE((t) + 2)); } \
                            else { SWRITE_H(SB); } }                                                                          \
        RESC(alX); __syncthreads(); } while (0)
    for (int t = 1; t + 1 < NT; t += 2) {
        HALF_STEP(pB0, pB1, mnB, alB, pA0, pA1, alA, t, 1, 0, 0);
        HALF_STEP(pA0, pA1, mnA, alA, pB0, pB1, alB, t + 1, 0, 1, 1);
    }
    const bool even = (NT & 1) == 0;
    if (even) { SBAR(); qkt<1, SK>(pB0, pB1, K_lds, r32, hi, S.qr, ACT(NT - 1)); SBAR(); }
#define QROW(e) (nxt.Q + (size_t)(wid * QBLK + r32) * D + ((e) >> 1) * 16 + hi * 8 + ((e) & 1) * 4)
    if constexpr (F32) { SLOAD_F((const float*)nxt.K, kbn); SBAR();
#pragma unroll
        for (int e = 0; e < 8; ++e) S.tq[e] = *(const f32x4*)QROW(e); }
    else { SLOAD_H(nxt.K, nxt.V, kbn); SBAR();
#pragma unroll
        for (int d0 = 0; d0 < 8; ++d0) S.qr[d0] = load8<TIn>(nxt.Q + (size_t)(wid * QBLK + r32) * D + d0 * 16 + hi * 8); }
    SBAR();
    finishSM(pA0, pA1, alA, l_reg, pa0, pa1, pa2, pa3); SBAR();
    if constexpr (F32) {
#pragma unroll
        for (int e = 8; e < 16; ++e) S.tq[e] = *(const f32x4*)QROW(e); SBAR(); }
#undef QROW
    pv_tile<0, SK>(o, vb0, pa0, pa1, pa2, pa3, ACT(even ? NT - 2 : NT - 1));
    if (even) { MASKT(pB0, pB1, NT - 1); partialSM(pB0, pB1, m_reg, mnB, alB); __syncthreads(); RESC(alB);
        finishSM(pB0, pB1, alB, l_reg, pa0, pa1, pa2, pa3); SBAR(); pv_tile<1, SK>(o, vb0, pa0, pa1, pa2, pa3, ACT(NT - 1)); }
    SBAR(); SEAM_K0();
    if (hi == 0) li_l[r32] = l_reg; asm volatile("s_waitcnt lgkmcnt(0)" ::: "memory");
    float rli[16];
#pragma unroll
    for (int r = 0; r < 16; ++r) rli[r] = __builtin_amdgcn_rcpf(li_l[crow(r, hi)]);
    TOut* Ow = cur.O + (size_t)(wid * QBLK) * D;
#pragma unroll
    for (int r = 0; r < 16; ++r) { const int orow = crow(r, hi);
#pragma unroll
        for (int d0 = 0; d0 < 4; ++d0) { const float v = o[d0][r] * rli[r];
            if constexpr (same_t<TOut, float>::v) { Ow[(size_t)orow * D + d0 * 32 + r32] = v; }
            else { const float vn = swz_xor<1>(v);
                   if ((r32 & 1) == 0) *(unsigned*)(Ow + (size_t)orow * D + d0 * 32 + r32) = cvtpk(v, vn); } } }
    if constexpr (F32) {
#pragma unroll
        for (int d0 = 0; d0 < 8; ++d0) S.qr[d0] = pack8(S.tq[2 * d0], S.tq[2 * d0 + 1]); }
    __syncthreads();
#undef RESC
#undef KBASE
#undef ACT
#undef MASKT
#undef SEAM_K0
#undef HALF_STEP
}
#undef ROW
#undef VMW
#undef VMWN
#undef SLOAD_H
#undef SWRITE_HK
#undef SWRITE_HV
#undef SWRITE_H
#undef SLOAD_F
#undef SWRITE_KF
#undef SWRITE_VF

}

constexpr size_t MiB = 1u << 20;
constexpr size_t WS_CTL = 0, CTL_ZERO_BYTES = 64 * 1024;
constexpr size_t WS_MODP = 2 * MiB;
constexpr size_t WS_MOD = 12 * MiB;
constexpr size_t WS_SSQ = 13 * MiB + 256 * 1024;
constexpr size_t WS_BIAS = 20 * MiB;
constexpr size_t WS_COS = 14 * MiB, WS_SIN = 16 * MiB;
constexpr size_t WS_COSI = 18 * MiB, WS_SINI = 19 * MiB;
constexpr size_t WS_WGU = 32 * MiB;
constexpr size_t WS_WDN = WS_WGU + 8 * 44 * MiB;
constexpr size_t WS_WAIN = WS_WDN + 8 * 22 * MiB;
constexpr size_t WS_WAOUT = WS_WAIN + 2 * 24 * MiB;
constexpr size_t WS_WBIN = WS_WAOUT + 2 * 8 * MiB;
constexpr size_t WS_WBOUT = WS_WBIN + 2 * 18 * MiB;
constexpr size_t WS_XN = WS_WBOUT + 2 * 8 * MiB;
constexpr size_t WS_AO = WS_XN + 128 * MiB;
constexpr size_t WS_BIG = WS_AO + 128 * MiB;
constexpr size_t WS_Q = WS_BIG + 384 * MiB, WS_K = WS_Q + 128 * MiB, WS_V = WS_K + 128 * MiB;
constexpr size_t WS_O = WS_V + 128 * MiB;
constexpr size_t WS_WQ = WS_O + 256 * MiB;
constexpr size_t WS_XQ = WS_WQ + 8 * 22 * MiB;
constexpr size_t WS_WOQ = WS_XQ + 64 * MiB;
constexpr size_t WS_WQA = WS_WOQ + 16 * MiB;
constexpr size_t WS_END = WS_WQA + 24 * MiB;
constexpr size_t WS_XH = WS_WGU;
constexpr size_t WS_TQ = 24 * MiB;
constexpr size_t WS_WQD = WS_WGU + 128 * MiB;
constexpr size_t WS_HQ = WS_Q;
constexpr size_t WS_TQD = 29 * MiB;
constexpr size_t WS_RFH = 30 * MiB;
constexpr unsigned DN_I8_MASK = 0xFFFu;
constexpr size_t WS_TQA = 28 * MiB;
constexpr size_t WS_TQO = 26 * MiB;
constexpr size_t WS_RFO = 27 * MiB;
constexpr size_t WS_RF = 25 * MiB;
static_assert(WS_XN == 676 * MiB && WS_WQ == 1956 * MiB && WS_END == 2236 * MiB, "d_ws map");
constexpr int CW_BAR = 4096;

constexpr int RING_BYTES = 131072;
constexpr int RING_BYTES_P0W = 131072;
constexpr int MISC_OFF = RING_BYTES + 320;
static_assert(TIDTAB_OFF == MISC_OFF + 128, "LDS map");
constexpr int LDS_BYTES = 155648;
constexpr int NWAVES = 8;

#define GAS __attribute__((address_space(1)))
#define LAS __attribute__((address_space(3)))
typedef unsigned v4u __attribute__((ext_vector_type(4)));
typedef float f32x4 __attribute__((ext_vector_type(4)));
typedef float f32x2 __attribute__((ext_vector_type(2)));
#define LDS_WAIT() asm volatile("s_waitcnt lgkmcnt(0)" ::: "memory")
#define VM_WAIT() asm volatile("s_waitcnt vmcnt(0)" ::: "memory")
__device__ __forceinline__ unsigned pkh(float lo, float hi) { h16x2 v = {(_Float16)lo, (_Float16)hi}; return __builtin_bit_cast(unsigned, v); }
__device__ __forceinline__ float wave_sum(float v) {
    v += swz_xor<1>(v); v += swz_xor<2>(v); v += swz_xor<4>(v); v += swz_xor<8>(v); v = add_xor16(v);
    return add_xor32(v);
}

#define XB_TMO      128
#define XB_XCNT(j)  (256  + 64 * (j))
#define XB_XSUB(j)  (1280 + 64 * (j))
#define XB_XGEN(j)  (2304 + 64 * (j))
#define XB_TOP      3328
#define XB_TOPGEN   3392
#define XCD_BAR_WORDS 3456
#define XB_SPIN_CAP (1u << 21)

__device__ __forceinline__ unsigned xb_ld(unsigned* p)              { return __hip_atomic_load(p, __ATOMIC_RELAXED, __HIP_MEMORY_SCOPE_AGENT); }
__device__ __forceinline__ unsigned xb_add(unsigned* p, unsigned v) { return __hip_atomic_fetch_add(p, v, __ATOMIC_RELAXED, __HIP_MEMORY_SCOPE_AGENT); }
__device__ __forceinline__ unsigned xb_xcc_id() { return (unsigned)__builtin_amdgcn_s_getreg((3 << 11) | 20) & 0xFu; }
#define XB_SPIN(cond, bar) do { unsigned _sp = 0; while (cond) { __builtin_amdgcn_s_sleep(1); \
    if ((++_sp & 255u) == 0u) { if (xb_ld(&(bar)[XB_TMO])) break; if (_sp > XB_SPIN_CAP) { atomicAdd(&(bar)[XB_TMO], 1u); break; } } } } while (0)

struct XcdBarrier { unsigned* bar; unsigned x; volatile LAS unsigned* st; };

__device__ __forceinline__ XcdBarrier xcd_barrier_post(unsigned* bar, volatile LAS unsigned* st) {
    XcdBarrier b; b.bar = bar; b.x = xb_xcc_id(); b.st = st;
    if (opaque_tid() == 0) (void)xb_add(&bar[XB_XCNT(b.x)], 1u);
    return b;
}
__device__ __forceinline__ void xcd_barrier_complete(unsigned* bar, unsigned x, unsigned& nloc, unsigned& nx) {
    const unsigned G = gridDim.x * gridDim.y * gridDim.z;
    unsigned sum, cnt, mine, sp = 0u;
    for (;;) {
        sum = 0u; cnt = 0u; mine = 0u;
#pragma unroll
        for (unsigned j = 0; j < 16; ++j) { const unsigned c = xb_ld(&bar[XB_XCNT(j)]); sum += c; cnt += (c > 0u) ? 1u : 0u; mine = (j == x) ? c : mine; }
        if (sum == G) break;
        __builtin_amdgcn_s_sleep(1);
        if ((++sp & 255u) == 0u) { if (xb_ld(&bar[XB_TMO])) break; if (sp > XB_SPIN_CAP) { atomicAdd(&bar[XB_TMO], 1u); break; } }
    }
    nloc = mine > 0u ? mine : 1u; nx = cnt > 0u ? cnt : 1u;
}
__device__ __forceinline__ void xcd_barrier(const XcdBarrier& b) {
    asm volatile("s_waitcnt vmcnt(0)" ::: "memory");
    __syncthreads();
    if (opaque_tid() == 0) {
        unsigned* bar = b.bar;
        __builtin_amdgcn_s_waitcnt(0);
        unsigned nloc = b.st[0], nx = b.st[1];
        if (nloc == 0u) { xcd_barrier_complete(bar, b.x, nloc, nx); b.st[0] = nloc; b.st[1] = nx; }
        const unsigned old = xb_add(&bar[XB_XSUB(b.x)], 1u);
        const unsigned gen = old / nloc;
        if (old + 1u == (gen + 1u) * nloc) {
            __builtin_amdgcn_fence(__ATOMIC_RELEASE, "agent");
            asm volatile("s_waitcnt vmcnt(0)" ::: "memory");
            const unsigned og = xb_add(&bar[XB_TOP], 1u);
            const unsigned tg = og / nx;
            if (og + 1u == (tg + 1u) * nx) xb_add(&bar[XB_TOPGEN], 1u);
            else XB_SPIN(xb_ld(&bar[XB_TOPGEN]) == tg, bar);
            __builtin_amdgcn_fence(__ATOMIC_ACQUIRE, "agent");
            xb_add(&bar[XB_XGEN(b.x)], 1u);
            asm volatile("s_waitcnt vmcnt(0)" ::: "memory");
        } else {
            XB_SPIN(xb_ld(&bar[XB_XGEN(b.x)]) == gen, bar);
            __builtin_amdgcn_fence(__ATOMIC_ACQUIRE, "agent");
            asm volatile("s_waitcnt vmcnt(0)" ::: "memory");
        }
    }
    __syncthreads();
}

__device__ __forceinline__ void p0_transpose_item(const float* W, int K, int N, u16* WT, int dest_row, int k0, int n0, LAS float* scr, int lane) {
    {
        const int c4 = lane & 7, kr = lane >> 3; const bool ok = n0 + 4 * c4 + 3 < N;
        const float* wp = W + (size_t)(k0 + kr) * N + n0 + 4 * c4;
        f32x4 v[8];
#pragma unroll
        for (int i = 0; i < 8; ++i) v[i] = ok ? *(const f32x4*)(wp + (size_t)(8 * i) * N) : (f32x4){0.f, 0.f, 0.f, 0.f};
#pragma unroll
        for (int i = 0; i < 8; ++i) { LAS float* d = scr + (kr + 8 * i) * 33 + 4 * c4; d[0] = v[i].x; d[1] = v[i].y; d[2] = v[i].z; d[3] = v[i].w; }
    }
    LDS_WAIT(); asm volatile("" ::: "memory");
    const int c = lane & 7;
#pragma unroll
    for (int j = 0; j < 4; ++j) { const int n = (lane >> 3) + 8 * j; const LAS float* s = scr + (8 * c) * 33 + n;
        v4u o; o.x = pkh(s[0 * 33], s[1 * 33]); o.y = pkh(s[2 * 33], s[3 * 33]); o.z = pkh(s[4 * 33], s[5 * 33]); o.w = pkh(s[6 * 33], s[7 * 33]);
        *(GAS v4u*)(WT + (size_t)(dest_row + n) * K + k0 + 8 * c) = o; }
    LDS_WAIT(); asm volatile("" ::: "memory");
}
__device__ __forceinline__ void p0_ada_item(const float* c, const float* ada_w, float* part, int item, LAS float* scr, int lane) {
    const int kc = item & 7, cc = (item >> 3) % 72, layer = item / (8 * 72);
#pragma unroll
    for (int i = 0; i < 4; ++i) { const int k = lane + 64 * i;
#pragma unroll
        for (int b = 0; b < NB; ++b) { const float v = c[b * DM + kc * 256 + k]; scr[k * 4 + b] = v / (1.0f + __expf(-v)); } }
    LDS_WAIT(); asm volatile("" ::: "memory");
    f32x4 a0 = {0.f, 0.f, 0.f, 0.f}, a1 = a0, a2 = a0, a3 = a0;
    const float* wp = ada_w + ((size_t)layer * DM + kc * 256) * ADAW + cc * 256 + lane * 4;
#pragma unroll 8
    for (int k = 0; k < 256; ++k) {
        const f32x4 w = *(const f32x4*)(wp + (size_t)k * ADAW); const f32x4 cb = *(const LAS f32x4*)(scr + k * 4);
        a0 += w * cb[0]; a1 += w * cb[1]; a2 += w * cb[2]; a3 += w * cb[3];
    }
    float* pp = part + ((size_t)(kc * DEPTH + layer) * NB) * ADAW + cc * 256 + lane * 4;
    *(f32x4*)(pp) = a0; *(f32x4*)(pp + ADAW) = a1; *(f32x4*)(pp + 2 * ADAW) = a2; *(f32x4*)(pp + 3 * ADAW) = a3;
    LDS_WAIT(); asm volatile("" ::: "memory");
}
__device__ __forceinline__ void sincos_d(double ang, float& co, float& si) {
    const double k = __builtin_rint(ang * 0.6366197723675814);
    double r = __builtin_fma(-k, 1.5707963267948966, ang); r = __builtin_fma(-k, 6.123233995736766e-17, r);
    const double r2 = r * r;
    double s = -7.6471637318198164759e-13; s = s * r2 + 1.6059043836821614599e-10; s = s * r2 - 2.5052108385441718775e-08; s = s * r2 + 2.7557319223985890653e-06;
    s = s * r2 - 1.9841269841269841270e-04; s = s * r2 + 8.3333333333333333333e-03; s = s * r2 - 1.6666666666666666667e-01; s = s * r2 * r + r;
    double c = 4.7794773323873852974e-14; c = c * r2 - 1.1470745597729724714e-11; c = c * r2 + 2.0876756987868098979e-09; c = c * r2 - 2.7557319223985890653e-07;
    c = c * r2 + 2.4801587301587301587e-05; c = c * r2 - 1.3888888888888888889e-03; c = c * r2 + 4.1666666666666666667e-02; c = c * r2 - 0.5; c = c * r2 + 1.0;
    const int q = ((int)k) & 3;
    const double cc = (q == 0) ? c : (q == 1) ? -s : (q == 2) ? -c : s;
    const double ss = (q == 0) ? s : (q == 1) ? c : (q == 2) ? -s : -c;
    co = (float)cc; si = (float)ss;
}
__device__ __forceinline__ double powi_d(double base, int e) { double r = 1.0, bb = base;
#pragma unroll
    for (int i = 0; i < 6; ++i) { if (e & (1 << i)) r *= bb; bb *= bb; }
    return r; }

__device__ __forceinline__ void unpack8(const h16x8 h, float (&v)[8]) {
#pragma unroll
    for (int e = 0; e < 8; ++e) v[e] = (float)h[e];
}
__device__ __forceinline__ v4u pack8h(const float (&o)[8]) { v4u w; w.x = pkh(o[0], o[1]); w.y = pkh(o[2], o[3]); w.z = pkh(o[4], o[5]); w.w = pkh(o[6], o[7]); return w; }
__device__ __forceinline__ float sum16(float s) { s += swz_xor<1>(s); s += swz_xor<2>(s); s += swz_xor<4>(s); s += swz_xor<8>(s); return s; }

__device__ __forceinline__ float max_xor16(float v) { auto r = __builtin_amdgcn_permlane16_swap(__float_as_uint(v), __float_as_uint(v), false, false); return fmaxf(__uint_as_float(r[0]), __uint_as_float(r[1])); }
__device__ __forceinline__ float max_xor32(float v) { auto r = __builtin_amdgcn_permlane32_swap(__float_as_uint(v), __float_as_uint(v), false, false); return fmaxf(__uint_as_float(r[0]), __uint_as_float(r[1])); }
__device__ __forceinline__ float wave_max(float v) {
    v = fmaxf(v, swz_xor<1>(v)); v = fmaxf(v, swz_xor<2>(v)); v = fmaxf(v, swz_xor<4>(v)); v = fmaxf(v, swz_xor<8>(v)); v = max_xor16(v);
    return max_xor32(v);
}
__device__ __forceinline__ unsigned pack4_i8(float a, float b, float c, float d) {
    const int ia = (int)__builtin_rintf(a), ib = (int)__builtin_rintf(b), ic = (int)__builtin_rintf(c), id = (int)__builtin_rintf(d);
    return ((unsigned)ia & 255u) | (((unsigned)ib & 255u) << 8) | (((unsigned)ic & 255u) << 16) | ((unsigned)id << 24);
}
template <bool IN32>
__device__ __forceinline__ void phase_quant(const float* x32, u16* xh, unsigned long long* xq, const float* scale, float* rf, int gw, int NGW, int lane) {
    constexpr int rpw = 16;
    for (int grp = gw; grp < MTOK / rpw; grp += NGW) {
    const int m0 = grp * rpw, b = m0 >> 13;
    f32x4 sc[4][2];
    { const f32x4* sp = (const f32x4*)(scale + (size_t)b * ADAW) + 2 * lane;
#pragma unroll
      for (int j = 0; j < 4; ++j) { sc[j][0] = sp[128 * j] + 1.0f; sc[j][1] = sp[128 * j + 1] + 1.0f; } }
    h16x8 v[4];
#define PQ_LOAD(m_) do { if constexpr (IN32) { const f32x4* xr = (const f32x4*)(x32 + (size_t)(m_) * DM) + 2 * lane; \
            _Pragma("unroll") for (int j = 0; j < 4; ++j) { const f32x4 a = xr[128 * j], c = xr[128 * j + 1]; \
                v[j] = (h16x8){(_Float16)a.x, (_Float16)a.y, (_Float16)a.z, (_Float16)a.w, (_Float16)c.x, (_Float16)c.y, (_Float16)c.z, (_Float16)c.w}; } } \
        else { const h16x8* xr = (const h16x8*)(xh + (size_t)(m_) * DM) + lane; _Pragma("unroll") for (int j = 0; j < 4; ++j) v[j] = xr[64 * j]; } } while (0)
    PQ_LOAD(m0);
    for (int i = 0; i < rpw; ++i) {
        const int m = m0 + i;
        f32x4 y[4][2]; float s = 0.f, am = 0.f;
#pragma unroll
        for (int j = 0; j < 4; ++j) {
            const f32x4 a = (f32x4){(float)v[j][0], (float)v[j][1], (float)v[j][2], (float)v[j][3]}, c = (f32x4){(float)v[j][4], (float)v[j][5], (float)v[j][6], (float)v[j][7]};
            s += (a.x * a.x + a.y * a.y) + (a.z * a.z + a.w * a.w) + (c.x * c.x + c.y * c.y) + (c.z * c.z + c.w * c.w);
            y[j][0] = a * sc[j][0]; y[j][1] = c * sc[j][1];
            am = fmaxf(am, fmaxf(fmaxf(fmaxf(__builtin_fabsf(y[j][0].x), __builtin_fabsf(y[j][0].y)), fmaxf(__builtin_fabsf(y[j][0].z), __builtin_fabsf(y[j][0].w))),
                                 fmaxf(fmaxf(__builtin_fabsf(y[j][1].x), __builtin_fabsf(y[j][1].y)), fmaxf(__builtin_fabsf(y[j][1].z), __builtin_fabsf(y[j][1].w)))));
        }
        if constexpr (IN32) { h16x8* xo = (h16x8*)(xh + (size_t)m * DM) + lane;
#pragma unroll
            for (int j = 0; j < 4; ++j) xo[64 * j] = v[j]; }
        if (i + 1 < rpw) PQ_LOAD(m + 1);
        s = wave_sum(s); am = wave_max(am);
        const float inv = am > 0.f ? 127.0f / am : 0.f;
        if (lane == 0) rf[m] = rsqrtf(s * (1.0f / DM) + NORM_EPS) * (am * (1.0f / 127.0f));
        unsigned long long* o = xq + (size_t)m * (DM / 8) + lane;
#pragma unroll
        for (int j = 0; j < 4; ++j) o[64 * j] = (unsigned long long)pack4_i8(y[j][0].x * inv, y[j][0].y * inv, y[j][0].z * inv, y[j][0].w * inv)
                                              | ((unsigned long long)pack4_i8(y[j][1].x * inv, y[j][1].y * inv, y[j][1].z * inv, y[j][1].w * inv) << 32);
    }
    }
#undef PQ_LOAD
}
__device__ __forceinline__ void phase_prepx(const u16* xh, u16* xn, const float* scale, float* ssq0, int gw, int NGW, int lane) {
    for (int m = gw; m < MTOK; m += NGW) {
        const int b = m >> 13;
        const h16x8* xr = (const h16x8*)(xh + (size_t)m * DM) + lane;
        h16x8 v[4];
#pragma unroll
        for (int j = 0; j < 4; ++j) v[j] = xr[64 * j];
        const f32x4* sp = (const f32x4*)(scale + (size_t)b * ADAW) + 2 * lane;
        v4u* o = (v4u*)(xn + (size_t)m * DM) + lane;
        float s = 0.f;
#pragma unroll
        for (int j = 0; j < 4; ++j) {
            const f32x4 a = (f32x4){(float)v[j][0], (float)v[j][1], (float)v[j][2], (float)v[j][3]}, c = (f32x4){(float)v[j][4], (float)v[j][5], (float)v[j][6], (float)v[j][7]};
            s += (a.x * a.x + a.y * a.y) + (a.z * a.z + a.w * a.w) + (c.x * c.x + c.y * c.y) + (c.z * c.z + c.w * c.w);
            const f32x4 ya = a * (sp[128 * j] + 1.0f), yc = c * (sp[128 * j + 1] + 1.0f);
            v4u w; w.x = pkh(ya.x, ya.y); w.y = pkh(ya.z, ya.w); w.z = pkh(yc.x, yc.y); w.w = pkh(yc.z, yc.w);
            o[64 * j] = w;
        }
        s = wave_sum(s);
        if (lane == 0) ssq0[m] = s;
    }
}
__device__ __forceinline__ void quant_row_dff(const u16* src, unsigned char* dst, float* scale, int lane) {
    h16x8 raw[11]; float am = 0.f;
#pragma unroll
    for (int j = 0; j < 11; ++j) raw[j] = *((const h16x8*)src + lane + 64 * j);
#pragma unroll
    for (int j = 0; j < 11; ++j) { float w[8]; unpack8(raw[j], w);
#pragma unroll
        for (int e = 0; e < 8; ++e) am = fmaxf(am, __builtin_fabsf(w[e])); }
    am = wave_max(am); const float inv = am > 0.f ? 127.0f / am : 0.f;
#pragma unroll
    for (int j = 0; j < 11; ++j) { float w[8]; unpack8(raw[j], w);
        *((unsigned long long*)dst + lane + 64 * j) = (unsigned long long)pack4_i8(w[0] * inv, w[1] * inv, w[2] * inv, w[3] * inv) | ((unsigned long long)pack4_i8(w[4] * inv, w[5] * inv, w[6] * inv, w[7] * inv) << 32); }
    if (lane == 0) *scale = am * (1.0f / 127.0f);
}
template <int K, int NC, bool BIAS, bool F8 = false>
__device__ __forceinline__ void p0w_strip(const float* W, int N, int n0, unsigned char* Wq0, float* tq0, const float* shift, float* bias0, int bstride, LAS unsigned char* L, int tid) {
    constexpr int LPR = NC / 4, RPW = 64 / LPR, RB = 8 * RPW * 4, NG = K / RB, TS = K + 16;
    constexpr int OFF_T = BIAS ? 4 * K * 4 : 0, OFF_RA = OFF_T + NC * TS, OFF_RB = OFF_RA + 8 * NC * 4;
    static_assert(K % RB == 0 && OFF_RB + 8 * 4 * NC * 4 <= RING_BYTES_P0W, "p0w_strip LDS map");
    asm volatile("" : "+v"(tid));
    const int w = __builtin_amdgcn_readfirstlane(tid >> 6), lane = tid & 63, c4 = lane % LPR, kr = lane / LPR;
    f32x4 v[NG][4];
    { const float* wp = W + (size_t)(RPW * 4 * w + 4 * kr) * N + n0 + 4 * c4;
#pragma unroll
      for (int g = 0; g < NG; ++g)
#pragma unroll
          for (int j = 0; j < 4; ++j) v[g][j] = *(const f32x4*)(wp + (size_t)(RB * g + j) * N); }
    if constexpr (BIAS) {
#pragma unroll
        for (int r = 0; r < (4 * K / 4) / 512; ++r) { const int idx = tid + 512 * r, b = idx / (K / 4), kk = idx % (K / 4);
            *(LAS f32x4*)(L + (size_t)(b * K + 4 * kk) * 4) = *(const f32x4*)(shift + (size_t)b * ADAW + 4 * kk); }
    }
    f32x4 am = {0.f, 0.f, 0.f, 0.f};
#pragma unroll
    for (int g = 0; g < NG; ++g)
#pragma unroll
        for (int j = 0; j < 4; ++j) am = __builtin_elementwise_max(am, __builtin_elementwise_abs(v[g][j]));
#pragma unroll
    for (int e = 0; e < 4; ++e) { float x = am[e];
        if constexpr (LPR == 4) x = fmaxf(x, swz_xor<4>(x));
        x = fmaxf(x, swz_xor<8>(x)); x = fmaxf(x, swz_xor<16>(x)); x = max_xor32(x); am[e] = x; }
    if (kr == 0) *(LAS f32x4*)(L + OFF_RA + (w * NC + 4 * c4) * 4) = am;
    __syncthreads();
    f32x4 amx = *(const LAS f32x4*)(L + OFF_RA + (4 * c4) * 4);
#pragma unroll
    for (int ww = 1; ww < 8; ++ww) amx = __builtin_elementwise_max(amx, *(const LAS f32x4*)(L + OFF_RA + (ww * NC + 4 * c4) * 4));
    f32x4 inv;
#pragma unroll
    for (int e = 0; e < 4; ++e) inv[e] = amx[e] > 0.f ? (F8 ? pg8::F8_WMAX : 127.0f) / amx[e] : 0.f;
    if (tid < LPR) *(f32x4*)(tq0 + 4 * c4) = amx * (F8 ? 1.0f / (pg8::F8_WMAX * pg8::HID_S) : 1.0f / 127.0f);
    if constexpr (BIAS) {
        f32x4 acc[4];
#pragma unroll
        for (int b = 0; b < 4; ++b) acc[b] = (f32x4){0.f, 0.f, 0.f, 0.f};
#pragma unroll
        for (int g = 0; g < NG; ++g) { const int k0 = RB * g + RPW * 4 * w + 4 * kr;
#pragma unroll
            for (int b = 0; b < 4; ++b) { const f32x4 sh = *(const LAS f32x4*)(L + (size_t)(b * K + k0) * 4);
                acc[b] += v[g][0] * sh[0] + v[g][1] * sh[1] + v[g][2] * sh[2] + v[g][3] * sh[3]; } }
#pragma unroll
        for (int b = 0; b < 4; ++b) {
#pragma unroll
            for (int e = 0; e < 4; ++e) { float x = acc[b][e];
                if constexpr (LPR == 4) x += swz_xor<4>(x);
                x += swz_xor<8>(x); x += swz_xor<16>(x); x = add_xor32(x); acc[b][e] = x; }
            if (kr == 0) *(LAS f32x4*)(L + OFF_RB + ((w * 4 + b) * NC + 4 * c4) * 4) = acc[b]; }
    }
#pragma unroll
    for (int g = 0; g < NG; ++g) { const int k0 = RB * g + RPW * 4 * w + 4 * kr;
#pragma unroll
        for (int e = 0; e < 4; ++e) *(LAS unsigned*)(L + OFF_T + (4 * c4 + e) * TS + k0) = F8 ? pg8::pack4_f8(v[g][0][e] * inv[e], v[g][1][e] * inv[e], v[g][2][e] * inv[e], v[g][3][e] * inv[e])
                                                                                              : pack4_i8(v[g][0][e] * inv[e], v[g][1][e] * inv[e], v[g][2][e] * inv[e], v[g][3][e] * inv[e]); }
    __syncthreads();
    if constexpr (BIAS) {
        if (tid < 4 * NC) { const int b = tid / NC, col = tid % NC; float sum = 0.f;
#pragma unroll
            for (int ww = 0; ww < 8; ++ww) sum += *(const LAS float*)(L + OFF_RB + ((ww * 4 + b) * NC + col) * 4);
            bias0[(size_t)b * bstride + col] = sum; }
    }
    if (tid < K / 16) {
#pragma unroll 4
        for (int col = 0; col < NC; ++col) *(v4u*)(Wq0 + (size_t)col * K + 16 * tid) = *(const LAS v4u*)(L + OFF_T + col * TS + 16 * tid);
    }
    __syncthreads();
}
__device__ __forceinline__ void phase_bias_bin(const float* mod, const u16* WBIN, float* bias, int gw, int NGW, int lane) {
    for (int r = gw; r < 2 * B_INP; r += NGW) {
        const int mj = r / B_INP, n = r % B_INP, li = 2 * mj + 1, q = 3 * li + 1;
        const u16* wrow = WBIN + ((size_t)mj * B_INP + n) * DM + 8 * lane;
        h16x8 raw[4];
#pragma unroll
        for (int j = 0; j < 4; ++j) raw[j] = *(const h16x8*)(wrow + 512 * j);
        float d[4] = {0.f, 0.f, 0.f, 0.f};
#pragma unroll
        for (int bb = 0; bb < 4; ++bb) { const float* sp = mod + ((size_t)li * NB + bb) * ADAW + 3 * DM + 8 * lane;
#pragma unroll
            for (int j = 0; j < 4; ++j) { float w[8]; unpack8(raw[j], w); const f32x4 a0 = *(const f32x4*)(sp + 512 * j), a1 = *(const f32x4*)(sp + 512 * j + 4);
                d[bb] += (w[0] * a0[0] + w[1] * a0[1]) + (w[2] * a0[2] + w[3] * a0[3]) + (w[4] * a1[0] + w[5] * a1[1]) + (w[6] * a1[2] + w[7] * a1[3]); } }
#pragma unroll
        for (int bb = 0; bb < 4; ++bb) d[bb] = wave_sum(d[bb]);
        if (lane == 0) { float* bp = bias + (size_t)(q * 4) * GU_N + n; bp[0] = d[0]; bp[GU_N] = d[1]; bp[2 * GU_N] = d[2]; bp[3 * GU_N] = d[3]; }
    }
}
__device__ __forceinline__ int bias_nq(int q) { const int li = q / 3, s = q - 3 * li; return (s != 1) ? GU_N : ((li & 1) == 0 ? A_IN : B_INP); }
__device__ __forceinline__ void phase_bias(const float* mod, const u16* WGU, const u16* WAIN, const u16* WBIN, float* bias, unsigned char* WQ, float* TQ, unsigned char* WQA, float* TQA, int gw, int NGW, int lane) {
    constexpr int R = 8 * GU_N + 2 * A_IN + 2 * B_INP;
    const int chunk = (R + NGW - 1) / NGW; int r = gw * chunk; const int rend = (r + chunk < R) ? r + chunk : R;
    if (r >= rend) return;
    int q = 0, base = 0;
    while (r >= base + bias_nq(q)) { base += bias_nq(q); ++q; }
    float sh[4][32]; const u16* wt = nullptr; int nq = 0;
    bool fresh = true;
    for (; r < rend; ++r) {
        if (r >= base + nq && !fresh) { base += nq; ++q; fresh = true; }
        if (fresh) { fresh = false; nq = bias_nq(q); const int li = q / 3, s = q - 3 * li;
            wt = (s != 1) ? WGU + (size_t)(li * 2 + (s >> 1)) * GU_N * DM : (((li & 1) == 0) ? WAIN + (size_t)(li >> 1) * A_IN * DM : WBIN + (size_t)(li >> 1) * B_INP * DM);
#pragma unroll
            for (int bb = 0; bb < 4; ++bb) { const float* sp = mod + ((size_t)li * NB + bb) * ADAW + (3 * s) * DM + 8 * lane;
#pragma unroll
                for (int j = 0; j < 4; ++j) { const f32x4 a0 = *(const f32x4*)(sp + 512 * j), a1 = *(const f32x4*)(sp + 512 * j + 4);
#pragma unroll
                    for (int e = 0; e < 4; ++e) { sh[bb][8 * j + e] = a0[e]; sh[bb][8 * j + 4 + e] = a1[e]; } } } }
        const int n = r - base; const u16* wrow = wt + (size_t)n * DM + 8 * lane;
        float d0 = 0.f, d1 = 0.f, d2 = 0.f, d3 = 0.f;
        h16x8 raw[4];
#pragma unroll
        for (int j = 0; j < 4; ++j) raw[j] = *(const h16x8*)(wrow + 512 * j);
        float am = 0.f;
#pragma unroll
        for (int j = 0; j < 4; ++j) { float w[8]; unpack8(raw[j], w);
#pragma unroll
            for (int e = 0; e < 8; ++e) { d0 += w[e] * sh[0][8 * j + e]; d1 += w[e] * sh[1][8 * j + e]; d2 += w[e] * sh[2][8 * j + e]; d3 += w[e] * sh[3][8 * j + e]; am = fmaxf(am, __builtin_fabsf(w[e])); } }
        d0 = wave_sum(d0); d1 = wave_sum(d1); d2 = wave_sum(d2); d3 = wave_sum(d3);
        { const int li = q / 3, s = q - 3 * li;
          if (s != 1 || (li & 1) == 0) {
              am = wave_max(am); const float inv = am > 0.f ? 127.0f / am : 0.f; const int gi = li * 2 + (s >> 1);
              unsigned char* qrow = ((s != 1) ? WQ + ((size_t)gi * GU_N + n) * DM : WQA + ((size_t)(li >> 1) * A_IN + n) * DM) + 8 * lane;
#pragma unroll
              for (int j = 0; j < 4; ++j) { float w[8]; unpack8(raw[j], w);
                  const unsigned lo = pack4_i8(w[0] * inv, w[1] * inv, w[2] * inv, w[3] * inv), hi = pack4_i8(w[4] * inv, w[5] * inv, w[6] * inv, w[7] * inv);
                  *(unsigned long long*)(qrow + 512 * j) = (unsigned long long)lo | ((unsigned long long)hi << 32); }
              if (lane == 0) { if (s != 1) TQ[(size_t)gi * GU_N + n] = am * (1.0f / 127.0f); else TQA[(size_t)(li >> 1) * A_IN + n] = am * (1.0f / 127.0f); }
          } }
        if (lane == 0) { float* bp = bias + (size_t)(q * 4) * GU_N + n; bp[0] = d0; bp[GU_N] = d1; bp[2 * GU_N] = d2; bp[3 * GU_N] = d3; }
    }
}

__device__ __forceinline__ void phase_normropeA(const u16* P, u16* Qh, u16* Kh, u16* Vh, const float* qg, const float* kg, const float* cost, const float* sint, int gw, int NGW, int lane) {
    const int d0 = 8 * (lane & 15), sub = lane >> 4; const bool hiHalf = (lane & 8) != 0;
    float gq[8], gk[8];
#pragma unroll
    for (int e = 0; e < 8; ++e) { gq[e] = qg[d0 + e]; gk[e] = kg[d0 + e]; }
    for (int m = gw; m < MTOK; m += NGW) {
        const int b = m >> 13, t = m & (SEQ - 1);
        const u16* row = P + (size_t)m * A_IN;
        float cs[8], sn[8];
        { const f32x4 c0 = *(const f32x4*)(cost + t * 64 + (d0 & 63)), c1 = *(const f32x4*)(cost + t * 64 + (d0 & 63) + 4);
          const f32x4 s0 = *(const f32x4*)(sint + t * 64 + (d0 & 63)), s1 = *(const f32x4*)(sint + t * 64 + (d0 & 63) + 4);
#pragma unroll
          for (int e = 0; e < 4; ++e) { cs[e] = c0[e]; cs[4 + e] = c1[e]; sn[e] = s0[e]; sn[4 + e] = s1[e]; } }
#pragma unroll
        for (int j = 0; j < 8; ++j) {
            float v[8]; unpack8(*(const h16x8*)(row + 512 * j + 8 * lane), v);
            float ss = 0.f;
#pragma unroll
            for (int e = 0; e < 8; ++e) ss += v[e] * v[e];
            const float rstd = rsqrtf(sum16(ss) * (1.0f / 128.0f) + NORM_EPS);
            float o[8];
#pragma unroll
            for (int e = 0; e < 8; ++e) { const float y = v[e] * rstd * (j < 4 ? gq[e] : gk[e]); const float p = swz_xor<8>(y);
                o[e] = hiHalf ? (y * cs[e] + p * sn[e]) : (y * cs[e] - p * sn[e]); }
            const int ch = (4 * j + sub) & 15;
            u16* dst = (j < 4 ? Qh : Kh) + (((size_t)(b * 16 + ch) * SEQ + t) * 128 + d0);
            *(v4u*)dst = pack8h(o);
        }
#pragma unroll
        for (int j = 0; j < 4; ++j) {
            const v4u raw = *(const v4u*)(row + 4096 + 512 * j + 8 * lane);
            *(v4u*)(Vh + (((size_t)(b * 16 + 4 * j + sub) * SEQ + t) * 128 + d0)) = raw;
        }
    }
}
__device__ __forceinline__ void phase_combineA(const u16* O, unsigned char* AOQ, float* RFO, const float* lq1, const float* lk1, const float* lq2, const float* lk2, const float* subln, float lam_init, int gw, int NGW, int lane) {
    const float s1 = wave_sum(lq1[lane] * lk1[lane] + lq1[lane + 64] * lk1[lane + 64]);
    const float s2 = wave_sum(lq2[lane] * lk2[lane] + lq2[lane + 64] * lk2[lane + 64]);
    const float lam = __expf(s1) - __expf(s2) + lam_init;
    const int half = lane >> 5, e0 = 8 * (lane & 31), vh = e0 >> 7, d = e0 & 127;
    float sg[8];
#pragma unroll
    for (int e = 0; e < 8; ++e) sg[e] = subln[e0 + e] * (1.0f - lam_init);
    for (int m = gw; m < MTOK; m += NGW) {
        const int b = m >> 13, t = m & (SEQ - 1);
        float av[4][8]; float am = 0.f;
#pragma unroll
        for (int hp = 0; hp < 4; ++hp) {
            const int h = 2 * hp + half;
            const size_t s0i = ((size_t)((b * 8 + h) * 2 + 0) * SEQ + t) * 256 + e0, s1i = ((size_t)((b * 8 + h) * 2 + 1) * SEQ + t) * 256 + e0;
            float a[8], c[8]; unpack8(*(const h16x8*)(O + s0i), a); unpack8(*(const h16x8*)(O + s1i), c);
            float ss = 0.f;
#pragma unroll
            for (int e = 0; e < 8; ++e) { a[e] = a[e] - lam * c[e]; ss += a[e] * a[e]; }
            ss = sum16(ss); ss = add_xor16(ss);
            const float rstd = rsqrtf(ss * (1.0f / 256.0f) + NORM_EPS);
#pragma unroll
            for (int e = 0; e < 8; ++e) { av[hp][e] = a[e] * rstd * sg[e]; am = fmaxf(am, __builtin_fabsf(av[hp][e])); }
        }
        am = wave_max(am); const float inv = am > 0.f ? 127.0f / am : 0.f;
        if (lane == 0) RFO[m] = am * (1.0f / 127.0f);
#pragma unroll
        for (int hp = 0; hp < 4; ++hp) {
            const int h = 2 * hp + half;
            *(unsigned long long*)(AOQ + (size_t)m * DM + h * 256 + e0) = (unsigned long long)pack4_i8(av[hp][0] * inv, av[hp][1] * inv, av[hp][2] * inv, av[hp][3] * inv)
                                                                        | ((unsigned long long)pack4_i8(av[hp][4] * inv, av[hp][5] * inv, av[hp][6] * inv, av[hp][7] * inv) << 32);
        }
    }
}
__device__ __forceinline__ void phase_normropeB(const u16* P, u16* QB, u16* KB, u16* VB, u16* QI, u16* KI, float* WI, const float* qg, const float* kg, const float* kig, const float* kib,
                                                const float* cost, const float* sint, const float* costi, const float* sinti, int gw, int NGW, int lane) {
    const int ll = lane & 15, d0 = 8 * ll, sub = lane >> 4; const bool hiHalf = (lane & 8) != 0;
    float gq[8], g2[8], b2[8];
#pragma unroll
    for (int e = 0; e < 8; ++e) { gq[e] = qg[d0 + e]; g2[e] = (sub == 0) ? kg[d0 + e] : (sub == 2) ? kig[d0 + e] : 1.0f; b2[e] = (sub == 2) ? kib[d0 + e] : 0.0f; }
    for (int m = gw; m < MTOK; m += NGW) {
        const int t = m & (SEQ - 1);
        const u16* row = P + (size_t)m * B_INP;
        float cs[8], sn[8], ci[8], si[8];
        { const f32x4 c0 = *(const f32x4*)(cost + t * 64 + (d0 & 63)), c1 = *(const f32x4*)(cost + t * 64 + (d0 & 63) + 4);
          const f32x4 s0 = *(const f32x4*)(sint + t * 64 + (d0 & 63)), s1 = *(const f32x4*)(sint + t * 64 + (d0 & 63) + 4);
          const f32x4 e0 = *(const f32x4*)(costi + t * 32 + (d0 & 31)), e1 = *(const f32x4*)(costi + t * 32 + (d0 & 31) + 4);
          const f32x4 f0 = *(const f32x4*)(sinti + t * 32 + (d0 & 31)), f1 = *(const f32x4*)(sinti + t * 32 + (d0 & 31) + 4);
#pragma unroll
          for (int e = 0; e < 4; ++e) { cs[e] = c0[e]; cs[4 + e] = c1[e]; sn[e] = s0[e]; sn[4 + e] = s1[e]; ci[e] = e0[e]; ci[4 + e] = e1[e]; si[e] = f0[e]; si[4 + e] = f1[e]; } }
#pragma unroll
        for (int j = 0; j < 4; ++j) {
            float v[8]; unpack8(*(const h16x8*)(row + 512 * j + 8 * lane), v);
            float ss = 0.f;
#pragma unroll
            for (int e = 0; e < 8; ++e) ss += v[e] * v[e];
            const float rstd = rsqrtf(sum16(ss) * (1.0f / 128.0f) + NORM_EPS);
            float o[8];
#pragma unroll
            for (int e = 0; e < 8; ++e) { const float y = v[e] * rstd * gq[e]; const float p = swz_xor<8>(y);
                o[e] = hiHalf ? (y * cs[e] + p * sn[e]) : (y * cs[e] - p * sn[e]); }
            *(v4u*)(QB + (size_t)m * DM + (4 * j + sub) * 128 + d0) = pack8h(o);
        }
#pragma unroll
        for (int j = 0; j < 4; ++j) {
            float v[8]; unpack8(*(const h16x8*)(row + 2304 + 512 * j + 8 * lane), v);
            float o[8];
#pragma unroll
            for (int e = 0; e < 8; ++e) { const float y = v[e]; const float p = swz_xor<4>(y);
                o[e] = (ll < 4) ? (y * ci[e] - p * si[e]) : (ll < 8) ? (y * ci[e] + p * si[e]) : y; }
            *(v4u*)(QI + (size_t)m * DM + (4 * j + sub) * 128 + d0) = pack8h(o);
        }
        {
            const int col = (sub < 2) ? (2048 + 8 * lane) : (4352 + d0);
            float v[8]; unpack8(*(const h16x8*)(row + col), v);
            float s = 0.f;
#pragma unroll
            for (int e = 0; e < 8; ++e) s += v[e];
            const float mean = (sub >= 2) ? sum16(s) * (1.0f / 128.0f) : (sum16(s) * 0.0f);
            float ss = 0.f;
#pragma unroll
            for (int e = 0; e < 8; ++e) { v[e] -= mean; ss += v[e] * v[e]; }
            const float rstd = rsqrtf(sum16(ss) * (1.0f / 128.0f) + NORM_EPS);
            float o[8];
#pragma unroll
            for (int e = 0; e < 8; ++e) { const float y = v[e] * rstd * g2[e] + b2[e]; const float p8 = swz_xor<8>(y), p4 = swz_xor<4>(y);
                const float rk = hiHalf ? (y * cs[e] + p8 * sn[e]) : (y * cs[e] - p8 * sn[e]);
                const float ri = (ll < 4) ? (y * ci[e] - p4 * si[e]) : (ll < 8) ? (y * ci[e] + p4 * si[e]) : y;
                o[e] = (sub == 0) ? rk : (sub == 1) ? v[e] : ri; }
            u16* dst = (sub == 0) ? KB : (sub == 1) ? VB : KI;
            if (sub < 3) *(v4u*)(dst + (size_t)m * 128 + d0) = pack8h(o);
        }
        if (lane < 16) { const _Float16 w = __builtin_bit_cast(_Float16, row[4480 + lane]); WI[(size_t)m * 16 + lane] = (float)w * (0.25f * 0.08838834764831845f); }
    }
}

#ifndef B3_REP_SC
#define B3_REP_SC 1
#define B3_REP_TK 1
#define B3_REP_SP 1
#endif
typedef short s16x8 __attribute__((ext_vector_type(8)));
typedef float f32x16v __attribute__((ext_vector_type(16)));
constexpr int B3_V_OFF = 65536, B3_IDX_OFF = 133120;
typedef short s16x4v __attribute__((ext_vector_type(4)));
__device__ __forceinline__ int kswz(int row, int colB) { return row * 256 + (colB ^ ((row & 7) << 4)); }
__device__ __forceinline__ unsigned f2key(float f) { const unsigned u = __float_as_uint(f); return u ^ ((unsigned)((int)u >> 31) | 0x80000000u); }

__device__ __forceinline__ int count_ge16(int cnt, unsigned c, unsigned k0, unsigned k1, unsigned k2, unsigned k3, unsigned k4, unsigned k5, unsigned k6, unsigned k7, unsigned k8, unsigned k9, unsigned k10, unsigned k11, unsigned k12, unsigned k13, unsigned k14, unsigned k15) {
    unsigned long long m0, m1, m2, m3; int t0, t1;
    asm volatile("v_cmp_ge_u32_e64 %[m0], %[k0], %[c]\n\tv_cmp_ge_u32_e64 %[m1], %[k1], %[c]\n\tv_cmp_ge_u32_e64 %[m2], %[k2], %[c]\n\tv_cmp_ge_u32_e64 %[m3], %[k3], %[c]\n\ts_bcnt1_i32_b64 %[t0], %[m0]\n\tv_cmp_ge_u32_e64 %[m0], %[k4], %[c]\n\ts_add_i32 %[cnt], %[cnt], %[t0]\n\ts_bcnt1_i32_b64 %[t1], %[m1]\n\tv_cmp_ge_u32_e64 %[m1], %[k5], %[c]\n\ts_add_i32 %[cnt], %[cnt], %[t1]\n\ts_bcnt1_i32_b64 %[t0], %[m2]\n\tv_cmp_ge_u32_e64 %[m2], %[k6], %[c]\n\ts_add_i32 %[cnt], %[cnt], %[t0]\n\ts_bcnt1_i32_b64 %[t1], %[m3]\n\tv_cmp_ge_u32_e64 %[m3], %[k7], %[c]\n\ts_add_i32 %[cnt], %[cnt], %[t1]\n\ts_bcnt1_i32_b64 %[t0], %[m0]\n\tv_cmp_ge_u32_e64 %[m0], %[k8], %[c]\n\ts_add_i32 %[cnt], %[cnt], %[t0]\n\ts_bcnt1_i32_b64 %[t1], %[m1]\n\tv_cmp_ge_u32_e64 %[m1], %[k9], %[c]\n\ts_add_i32 %[cnt], %[cnt], %[t1]\n\ts_bcnt1_i32_b64 %[t0], %[m2]\n\tv_cmp_ge_u32_e64 %[m2], %[k10], %[c]\n\ts_add_i32 %[cnt], %[cnt], %[t0]\n\ts_bcnt1_i32_b64 %[t1], %[m3]\n\tv_cmp_ge_u32_e64 %[m3], %[k11], %[c]\n\ts_add_i32 %[cnt], %[cnt], %[t1]\n\ts_bcnt1_i32_b64 %[t0], %[m0]\n\tv_cmp_ge_u32_e64 %[m0], %[k12], %[c]\n\ts_add_i32 %[cnt], %[cnt], %[t0]\n\ts_bcnt1_i32_b64 %[t1], %[m1]\n\tv_cmp_ge_u32_e64 %[m1], %[k13], %[c]\n\ts_add_i32 %[cnt], %[cnt], %[t1]\n\ts_bcnt1_i32_b64 %[t0], %[m2]\n\tv_cmp_ge_u32_e64 %[m2], %[k14], %[c]\n\ts_add_i32 %[cnt], %[cnt], %[t0]\n\ts_bcnt1_i32_b64 %[t1], %[m3]\n\tv_cmp_ge_u32_e64 %[m3], %[k15], %[c]\n\ts_add_i32 %[cnt], %[cnt], %[t1]\n\ts_bcnt1_i32_b64 %[t0], %[m0]\n\ts_add_i32 %[cnt], %[cnt], %[t0]\n\ts_bcnt1_i32_b64 %[t1], %[m1]\n\ts_add_i32 %[cnt], %[cnt], %[t1]\n\ts_bcnt1_i32_b64 %[t0], %[m2]\n\ts_add_i32 %[cnt], %[cnt], %[t0]\n\ts_bcnt1_i32_b64 %[t1], %[m3]\n\ts_add_i32 %[cnt], %[cnt], %[t1]"
        : [cnt] "+s"(cnt), [m0] "=&s"(m0), [m1] "=&s"(m1), [m2] "=&s"(m2), [m3] "=&s"(m3), [t0] "=&s"(t0), [t1] "=&s"(t1)
        : [c] "s"(c), [k0] "v"(k0), [k1] "v"(k1), [k2] "v"(k2), [k3] "v"(k3), [k4] "v"(k4), [k5] "v"(k5), [k6] "v"(k6), [k7] "v"(k7), [k8] "v"(k8), [k9] "v"(k9), [k10] "v"(k10), [k11] "v"(k11), [k12] "v"(k12), [k13] "v"(k13), [k14] "v"(k14), [k15] "v"(k15)
        : "scc");
    return cnt;
}
__device__ __forceinline__ int count_gef16(int cnt, unsigned c, float k0, float k1, float k2, float k3, float k4, float k5, float k6, float k7, float k8, float k9, float k10, float k11, float k12, float k13, float k14, float k15) {
    unsigned long long m0, m1, m2, m3; int t0, t1;
    asm volatile("v_cmp_ge_f32_e64 %[m0], %[k0], %[c]\n\tv_cmp_ge_f32_e64 %[m1], %[k1], %[c]\n\tv_cmp_ge_f32_e64 %[m2], %[k2], %[c]\n\tv_cmp_ge_f32_e64 %[m3], %[k3], %[c]\n\ts_bcnt1_i32_b64 %[t0], %[m0]\n\tv_cmp_ge_f32_e64 %[m0], %[k4], %[c]\n\ts_add_i32 %[cnt], %[cnt], %[t0]\n\ts_bcnt1_i32_b64 %[t1], %[m1]\n\tv_cmp_ge_f32_e64 %[m1], %[k5], %[c]\n\ts_add_i32 %[cnt], %[cnt], %[t1]\n\ts_bcnt1_i32_b64 %[t0], %[m2]\n\tv_cmp_ge_f32_e64 %[m2], %[k6], %[c]\n\ts_add_i32 %[cnt], %[cnt], %[t0]\n\ts_bcnt1_i32_b64 %[t1], %[m3]\n\tv_cmp_ge_f32_e64 %[m3], %[k7], %[c]\n\ts_add_i32 %[cnt], %[cnt], %[t1]\n\ts_bcnt1_i32_b64 %[t0], %[m0]\n\tv_cmp_ge_f32_e64 %[m0], %[k8], %[c]\n\ts_add_i32 %[cnt], %[cnt], %[t0]\n\ts_bcnt1_i32_b64 %[t1], %[m1]\n\tv_cmp_ge_f32_e64 %[m1], %[k9], %[c]\n\ts_add_i32 %[cnt], %[cnt], %[t1]\n\ts_bcnt1_i32_b64 %[t0], %[m2]\n\tv_cmp_ge_f32_e64 %[m2], %[k10], %[c]\n\ts_add_i32 %[cnt], %[cnt], %[t0]\n\ts_bcnt1_i32_b64 %[t1], %[m3]\n\tv_cmp_ge_f32_e64 %[m3], %[k11], %[c]\n\ts_add_i32 %[cnt], %[cnt], %[t1]\n\ts_bcnt1_i32_b64 %[t0], %[m0]\n\tv_cmp_ge_f32_e64 %[m0], %[k12], %[c]\n\ts_add_i32 %[cnt], %[cnt], %[t0]\n\ts_bcnt1_i32_b64 %[t1], %[m1]\n\tv_cmp_ge_f32_e64 %[m1], %[k13], %[c]\n\ts_add_i32 %[cnt], %[cnt], %[t1]\n\ts_bcnt1_i32_b64 %[t0], %[m2]\n\tv_cmp_ge_f32_e64 %[m2], %[k14], %[c]\n\ts_add_i32 %[cnt], %[cnt], %[t0]\n\ts_bcnt1_i32_b64 %[t1], %[m3]\n\tv_cmp_ge_f32_e64 %[m3], %[k15], %[c]\n\ts_add_i32 %[cnt], %[cnt], %[t1]\n\ts_bcnt1_i32_b64 %[t0], %[m0]\n\ts_add_i32 %[cnt], %[cnt], %[t0]\n\ts_bcnt1_i32_b64 %[t1], %[m1]\n\ts_add_i32 %[cnt], %[cnt], %[t1]\n\ts_bcnt1_i32_b64 %[t0], %[m2]\n\ts_add_i32 %[cnt], %[cnt], %[t0]\n\ts_bcnt1_i32_b64 %[t1], %[m3]\n\ts_add_i32 %[cnt], %[cnt], %[t1]"
        : [cnt] "+s"(cnt), [m0] "=&s"(m0), [m1] "=&s"(m1), [m2] "=&s"(m2), [m3] "=&s"(m3), [t0] "=&s"(t0), [t1] "=&s"(t1)
        : [c] "s"(c), [k0] "v"(k0), [k1] "v"(k1), [k2] "v"(k2), [k3] "v"(k3), [k4] "v"(k4), [k5] "v"(k5), [k6] "v"(k6), [k7] "v"(k7), [k8] "v"(k8), [k9] "v"(k9), [k10] "v"(k10), [k11] "v"(k11), [k12] "v"(k12), [k13] "v"(k13), [k14] "v"(k14), [k15] "v"(k15)
        : "scc");
    return cnt;
}
__device__ __forceinline__ unsigned key2f(unsigned k) { return (k & 0x80000000u) ? (k ^ 0x80000000u) : ~k; }
constexpr unsigned B3_KLO = 0x00800000u, B3_KHI = 0xFF800000u;
template <int NBITS> __device__ __forceinline__ int wave_total_u8(unsigned v) {
    int t = 0;
#pragma unroll
    for (int b = 0; b < NBITS; ++b) t += __popcll(__ballot(((v >> b) & 1u) != 0u)) << b;
    return t;
}
template <int NBITS> __device__ __forceinline__ unsigned wave_excl_prefix(unsigned v, int) {
    unsigned s = 0u;
#pragma unroll
    for (int b = 0; b < NBITS; ++b) { const unsigned long long m = __ballot(((v >> b) & 1u) != 0u);
        s += __builtin_amdgcn_mbcnt_hi((unsigned)(m >> 32), __builtin_amdgcn_mbcnt_lo((unsigned)m, 0u)) << b; }
    return s;
}

__device__ __forceinline__ void phase_B3(char* lds, const u16* QB, const u16* KB, const u16* VB, const u16* QI, const u16* KI, const float* WI, float* SCR, unsigned char* AOQ, float* RFO, int vcu, int G) {
    constexpr int r_sc = B3_REP_SC, r_tk = B3_REP_TK, r_sp = B3_REP_SP;
    const int wid = __builtin_amdgcn_readfirstlane(opaque_tid() >> 6);
    float* myscr = SCR + (size_t)((vcu * NWAVES + wid) * 4) * SEQ;
    for (int U = vcu; U < NB * 256; U += G) {
        const int b = U >> 8, tt = U & 255, t = (b & 1) ? 255 - tt : tt, q0 = 32 * t;
        const size_t brow = (size_t)b * SEQ;
        const size_t mrow0 = brow + q0 + 4 * wid;
#pragma unroll 1
        for (int rsc_ = 0; rsc_ < r_sc; ++rsc_) {
            const int tid = opaque_tid(), lane = tid & 63, r32 = lane & 31, hi = lane >> 5;
            const int sr = tid >> 4, sc = (tid & 15) * 8, kws = kswz(sr, sc * 2);
            s16x8 af[2][8]; float wr[2][16];
#pragma unroll
            for (int rb = 0; rb < 2; ++rb) {
#pragma unroll
                for (int ks = 0; ks < 8; ++ks) af[rb][ks] = *(const s16x8*)(QI + (mrow0 + 2 * rb + (r32 >> 4)) * DM + (r32 & 15) * 128 + 16 * ks + 8 * hi);
#pragma unroll
                for (int i = 0; i < 16; ++i) wr[rb][i] = WI[(mrow0 + 2 * rb + (i >> 3)) * 16 + (i & 3) + 8 * ((i >> 2) & 1) + 4 * hi];
            }
            const int nkt = (q0 + 32 + 127) >> 7;
            const u16* kip = KI + (brow + sr) * 128 + sc;
            s16x8 st0 = *(const s16x8*)kip, st1 = *(const s16x8*)(kip + 32 * 128), st2 = *(const s16x8*)(kip + 64 * 128), st3 = *(const s16x8*)(kip + 96 * 128);
            *(s16x8*)(lds + kws) = st0; *(s16x8*)(lds + kws + 32 * 256) = st1; *(s16x8*)(lds + kws + 64 * 256) = st2; *(s16x8*)(lds + kws + 96 * 256) = st3;
            __syncthreads();
            for (int kt = 0; kt < nkt; ++kt) {
                const char* buf = lds + (kt & 1) * 32768;
                if (kt + 1 < nkt) { const u16* kn = kip + (size_t)(kt + 1) * 128 * 128;
                    st0 = *(const s16x8*)kn; st1 = *(const s16x8*)(kn + 32 * 128); st2 = *(const s16x8*)(kn + 64 * 128); st3 = *(const s16x8*)(kn + 96 * 128); }
                s16x8 bf[8];
#pragma unroll
                for (int ks = 0; ks < 8; ++ks) bf[ks] = *(const s16x8*)(buf + kswz(r32, (16 * ks + 8 * hi) * 2));
                f32x16v aA0, aA1, aB0, aB1; float s00 = 0.f, s01 = 0.f, s10 = 0.f, s11 = 0.f;
#define B3_MM(a0_, a1_, ks_) do { a0_ = __builtin_amdgcn_mfma_f32_32x32x16_f16(__builtin_bit_cast(h16x8, af[0][ks_]), __builtin_bit_cast(h16x8, bf[ks_]), a0_, 0, 0, 0); \
                                   a1_ = __builtin_amdgcn_mfma_f32_32x32x16_f16(__builtin_bit_cast(h16x8, af[1][ks_]), __builtin_bit_cast(h16x8, bf[ks_]), a1_, 0, 0, 0); } while (0)
#define B3_RELU(x_) __builtin_amdgcn_fmed3f((x_), 0.f, __builtin_inff())
#define B3_SLICE(a0_, a1_, ks_, kbn_, REFILL, e0_, e1_, DOEPI) do { B3_MM(a0_, a1_, ks_); \
                    if (REFILL) bf[ks_] = *(const s16x8*)(buf + kswz(32 * (kbn_) + r32, (16 * (ks_) + 8 * hi) * 2)); \
                    if (DOEPI) { s00 += wr[0][ks_] * B3_RELU(e0_[ks_]); s01 += wr[0][8 + (ks_)] * B3_RELU(e0_[8 + (ks_)]); s10 += wr[1][ks_] * B3_RELU(e1_[ks_]); s11 += wr[1][8 + (ks_)] * B3_RELU(e1_[8 + (ks_)]); } \
                    __builtin_amdgcn_sched_barrier(0); } while (0)
#define B3_FIN(kb2_) do { const auto x0 = __builtin_amdgcn_permlane32_swap(__float_as_uint(s00), __float_as_uint(s01), false, false); \
                    const auto x1 = __builtin_amdgcn_permlane32_swap(__float_as_uint(s10), __float_as_uint(s11), false, false); \
                    const int kcol = kt * 128 + (kb2_) * 32 + r32; \
                    myscr[(size_t)(0 + hi) * SEQ + kcol] = __uint_as_float(x0[0]) + __uint_as_float(x0[1]);     \
                    myscr[(size_t)(2 + hi) * SEQ + kcol] = __uint_as_float(x1[0]) + __uint_as_float(x1[1]); s00 = 0.f; s01 = 0.f; s10 = 0.f; s11 = 0.f; } while (0)
#define B3_BLOCK(a0_, a1_, kb_, REFILL, e0_, e1_, DOEPI) do { a0_ = (f32x16v){}; a1_ = (f32x16v){}; \
                    B3_SLICE(a0_, a1_, 0, (kb_) + 1, REFILL, e0_, e1_, DOEPI); B3_SLICE(a0_, a1_, 1, (kb_) + 1, REFILL, e0_, e1_, DOEPI); B3_SLICE(a0_, a1_, 2, (kb_) + 1, REFILL, e0_, e1_, DOEPI); B3_SLICE(a0_, a1_, 3, (kb_) + 1, REFILL, e0_, e1_, DOEPI); \
                    B3_SLICE(a0_, a1_, 4, (kb_) + 1, REFILL, e0_, e1_, DOEPI); B3_SLICE(a0_, a1_, 5, (kb_) + 1, REFILL, e0_, e1_, DOEPI); B3_SLICE(a0_, a1_, 6, (kb_) + 1, REFILL, e0_, e1_, DOEPI); B3_SLICE(a0_, a1_, 7, (kb_) + 1, REFILL, e0_, e1_, DOEPI); \
                    if (DOEPI) { B3_FIN((kb_) - 1); __builtin_amdgcn_sched_barrier(0); } } while (0)
                __builtin_amdgcn_sched_barrier(0);
                B3_BLOCK(aA0, aA1, 0, true, aA0, aA1, false);
                B3_BLOCK(aB0, aB1, 1, true, aA0, aA1, true);
                B3_BLOCK(aA0, aA1, 2, true, aB0, aB1, true);
                B3_BLOCK(aB0, aB1, 3, false, aA0, aA1, true);
#pragma unroll
                for (int i = 0; i < 8; ++i) { s00 += wr[0][i] * B3_RELU(aB0[i]); s01 += wr[0][8 + i] * B3_RELU(aB0[8 + i]); s10 += wr[1][i] * B3_RELU(aB1[i]); s11 += wr[1][8 + i] * B3_RELU(aB1[8 + i]); }
                B3_FIN(3);
#undef B3_SLICE
#undef B3_FIN
#undef B3_RELU
#undef B3_MM
#undef B3_EPI
#undef B3_BLOCK
                if (kt + 1 < nkt) { char* nb = lds + ((kt + 1) & 1) * 32768; *(s16x8*)(nb + kws) = st0; *(s16x8*)(nb + kws + 32 * 256) = st1; *(s16x8*)(nb + kws + 64 * 256) = st2; *(s16x8*)(nb + kws + 96 * 256) = st3; }
                __syncthreads();
            }
        }
        VM_WAIT();
        unsigned fprev = 0xBF800000u;
        unsigned tprev = 0xBF800000u;
#pragma unroll 1
        for (int qq = 0; qq < 4; ++qq) {
            const int lane = opaque_tid() & 63, l15 = lane & 15, kq = lane >> 4;
            unsigned* idxl = (unsigned*)(lds + B3_IDX_OFF + wid * 2048);
#pragma unroll
            for (int j = 0; j < 4; ++j) idxl[lane + 64 * j] = 0u;
            asm volatile("" ::: "memory");
            const int qpos = q0 + 4 * wid + qq, n = qpos + 1;
            const size_t token = brow + qpos;
            const float* srow = myscr + (size_t)qq * SEQ;
            h16x8 qb[4];
#define B3_QLOAD() do { int qp_ = qpos; asm volatile("" : "+s"(qp_)); const int ln_ = opaque_lane(); const u16* qa_ = QB + (brow + (size_t)qp_) * DM + (ln_ & 15) * 128 + 8 * (ln_ >> 4);     \
        _Pragma("unroll") for (int ks_ = 0; ks_ < 4; ++ks_) qb[ks_] = *(const h16x8*)(qa_ + 32 * ks_); } while (0)
            int count = 0;
#pragma unroll 1
            for (int rtk_ = 0; rtk_ < r_tk; ++rtk_) {
            if (n <= 256) {
                { const int ln_ = opaque_lane();
#pragma unroll
                for (int j = 0; j < 4; ++j) idxl[ln_ + 64 * j] = (ln_ + 64 * j < n) ? (unsigned)(ln_ + 64 * j) : 0u; }
                count = n; B3_QLOAD();
            } else {
                unsigned lo = 0u, hi = 0u; bool have_lo = false, have_hi = false;
                bool done = false; int C = 0;
                float* ks = (float*)(lds + B3_V_OFF + wid * 8192); unsigned* ps = (unsigned*)(lds + B3_V_OFF + wid * 8192 + 4096);
                if (n > 1024) {
                    float kf[128];
#pragma unroll
                    for (int g = 0; g < 8; ++g) {
                        if (1024 * g < n) {
#pragma unroll
                            for (int i4 = 4 * g; i4 < 4 * g + 4; ++i4) { const f32x4 t = *(const f32x4*)(srow + 256 * i4 + 4 * lane); kf[4 * i4] = t.x; kf[4 * i4 + 1] = t.y; kf[4 * i4 + 2] = t.z; kf[4 * i4 + 3] = t.w; }
                        } else {
#pragma unroll
                            for (int i = 16 * g; i < 16 * g + 16; ++i) kf[i] = -__builtin_inff();
                        }
                    }
                    __builtin_amdgcn_sched_barrier(0);
#pragma unroll
                    for (int g = 0; g < 8; ++g) {
                        if (1024 * g < n && n < 1024 * (g + 1)) {
#pragma unroll
                            for (int i = 16 * g; i < 16 * g + 16; ++i) kf[i] = (256 * (i >> 2) + (i & 3) + 4 * lane < n) ? kf[i] : -__builtin_inff();
                        }
                    }
                    unsigned F = 0u, probe = fprev, step = 1u << 17;
#pragma unroll 1
                    for (;;) {
                        const unsigned cand = __builtin_amdgcn_readfirstlane(probe), cf = key2f(cand); int c = 0;
#pragma unroll
                        for (int g = 0; g < 8; ++g) {
                            if (1024 * g < n) c = count_gef16(c, cf, kf[16 * g + 0], kf[16 * g + 1], kf[16 * g + 2], kf[16 * g + 3], kf[16 * g + 4], kf[16 * g + 5], kf[16 * g + 6], kf[16 * g + 7], kf[16 * g + 8], kf[16 * g + 9], kf[16 * g + 10], kf[16 * g + 11], kf[16 * g + 12], kf[16 * g + 13], kf[16 * g + 14], kf[16 * g + 15]);
                        }
                        if (c >= 256 && c <= 960) { F = cand; C = c; break; }
                        if (c > 960) { lo = cand; have_lo = true; } else { hi = cand; have_hi = true; }
                        if (!have_hi) { if (lo >= B3_KHI - step) { hi = B3_KHI; have_hi = true; } else { probe = lo + step; step = (step < (1u << 29)) ? step << 2 : step; continue; } }
                        if (!have_lo) { if (hi <= B3_KLO + step) { lo = B3_KLO; have_lo = true; } else { probe = hi - step; step = (step < (1u << 29)) ? step << 2 : step; continue; } }
                        if (hi - lo <= 1u) break;
                        probe = lo + ((hi - lo) >> 1);
                    }
                    if (C > 0) {
                        unsigned base = 0u; const float Ff = __uint_as_float(key2f(F));
                        unsigned Fs = __builtin_amdgcn_readfirstlane(__float_as_uint(Ff));
#pragma unroll
                        for (int g = 0; g < 8; ++g) {
                            if (1024 * g < n) {
#pragma unroll
                                for (int i = 16 * g; i < 16 * g + 16; ++i) {
                                    asm volatile("" : "+s"(Fs), "+s"(base));
                                    const bool take = kf[i] >= __uint_as_float(Fs);
                                    const unsigned long long m = __ballot(take);
                                    const unsigned slot = base + __builtin_amdgcn_mbcnt_hi((unsigned)(m >> 32), __builtin_amdgcn_mbcnt_lo((unsigned)m, 0u));
                                    const unsigned a = take ? slot : (960u + (unsigned)lane);
                                    ks[a] = kf[i]; ps[a] = (unsigned)(256 * (i >> 2) + (i & 3) + 4 * lane);
                                    base += (unsigned)__popcll(m);
                                }
                            }
                        }
                        if (C == 256) { have_lo = false; have_hi = false; lo = F; }
                        else { lo = F; have_lo = true; }
                        tprev = F; fprev = F;
                    } else {
                        unsigned base = 0u;
#pragma unroll 1
                        for (int pass = 0; pass < 2; ++pass) {
                            unsigned As = __builtin_amdgcn_readfirstlane(key2f(pass == 0 ? hi : lo)), Bs = __builtin_amdgcn_readfirstlane(pass == 0 ? 0x7F800000u : key2f(lo));
#pragma unroll
                            for (int g = 0; g < 8; ++g) {
                                if (1024 * g < n) {
#pragma unroll
                                    for (int i = 16 * g; i < 16 * g + 16; ++i) {
                                        asm volatile("" : "+s"(As), "+s"(Bs), "+s"(base));
                                        const bool in = kf[i] >= __uint_as_float(As) && kf[i] <= __uint_as_float(Bs);
                                        const unsigned long long m = __ballot(in);
                                        const unsigned slot = base + __builtin_amdgcn_mbcnt_hi((unsigned)(m >> 32), __builtin_amdgcn_mbcnt_lo((unsigned)m, 0u));
                                        idxl[(in && slot < 256u) ? slot : (256u + (unsigned)lane)] = (unsigned)(256 * (i >> 2) + (i & 3) + 4 * lane);
                                        base += (unsigned)__popcll(m);
                                    }
                                }
                            }
                        }
                        tprev = lo; done = true;
                    }
                } else {
#pragma unroll
                    for (int i4 = 0; i4 < 4; ++i4) { const f32x4 t = *(const f32x4*)(srow + 256 * i4 + 4 * lane); const unsigned pos = (unsigned)(256 * i4 + 4 * lane);
                        *(f32x4*)(ks + pos) = t; *(v4u*)(ps + pos) = (v4u){pos, pos + 1u, pos + 2u, pos + 3u}; }
                    C = n;
                }
                B3_QLOAD();
                if (!done) {
                    LDS_WAIT(); asm volatile("" ::: "memory");
                    float ck[16]; unsigned cp[16];
#pragma unroll
                    for (int j = 0; j < 16; ++j) { const bool v = 64 * j + lane < C; ck[j] = v ? ks[64 * j + lane] : -__builtin_inff(); cp[j] = ps[64 * j + lane]; }
                    unsigned T = 0u, probe = tprev, step = 1u << 14;
                    if (have_lo) { if (have_hi) probe = lo + ((hi - lo) >> 1); else probe = lo + step; }
#pragma unroll 1
                    for (;;) {
                        if (have_lo && have_hi && hi - lo <= 1u) { T = lo; break; }
                        const unsigned cand = __builtin_amdgcn_readfirstlane(probe), cf = key2f(cand);
                        const int c = count_gef16(0, cf, ck[0], ck[1], ck[2], ck[3], ck[4], ck[5], ck[6], ck[7], ck[8], ck[9], ck[10], ck[11], ck[12], ck[13], ck[14], ck[15]);
                        if (c == 256) { T = cand; break; }
                        if (c > 256) { lo = cand; have_lo = true; } else { hi = cand; have_hi = true; }
                        if (!have_hi) { if (lo >= B3_KHI - step) { hi = B3_KHI; have_hi = true; } else { probe = lo + step; step = (step < (1u << 29)) ? step << 2 : step; continue; } }
                        if (!have_lo) { if (hi <= B3_KLO + step) { lo = B3_KLO; have_lo = true; } else { probe = hi - step; step = (step < (1u << 29)) ? step << 2 : step; continue; } }
                        probe = lo + ((hi - lo) >> 1);
                    }
                    tprev = T;
                    const float Tf = __uint_as_float(key2f(T));
                    unsigned cg = 0u, ce = 0u;
#pragma unroll
                    for (int j = 0; j < 16; ++j) { cg += (ck[j] > Tf) ? 1u : 0u; ce += (ck[j] == Tf) ? 1u : 0u; }
                    const int need_eq = 256 - wave_total_u8<5>(cg);
                    const int eq_room = need_eq - (int)wave_excl_prefix<5>(ce, lane);
                    unsigned erem = (eq_room <= 0) ? 0u : ((unsigned)eq_room < ce ? (unsigned)eq_room : ce);
                    unsigned off = wave_excl_prefix<5>(cg, lane) + wave_excl_prefix<5>(erem, lane);
                    const unsigned dl_ = 256u + (unsigned)opaque_lane();
#pragma unroll
                    for (int j = 0; j < 16; ++j) {
                        const bool gt = ck[j] > Tf, eqk = (ck[j] == Tf) && (erem > 0u), take = gt || eqk;
                        erem -= eqk ? 1u : 0u;
                        idxl[take ? off : dl_] = cp[j];
                        off += take ? 1u : 0u;
                    }
                }
                count = 256;
            }
            LDS_WAIT(); asm volatile("" ::: "memory");
            }
#pragma unroll 1
            for (int rsp_ = 0; rsp_ < r_sp; ++rsp_) {
            f32x4 St[16];
#define B3_KLOAD(dst, gb_) do { _Pragma("unroll") for (int g4 = 0; g4 < 4; ++g4) { const unsigned krow_ = idxl[16 * (4 * (gb_) + g4) + l15]; const u16* kp_ = KB + (brow + krow_) * 128 + 8 * kq; \
                _Pragma("unroll") for (int ks = 0; ks < 4; ++ks) dst[g4][ks] = *(const h16x8*)(kp_ + 32 * ks); } } while (0)
#define B3_KMMA(src, gb_) do { _Pragma("unroll") for (int g4 = 0; g4 < 4; ++g4) { f32x4 a_ = {0.f, 0.f, 0.f, 0.f}; \
                _Pragma("unroll") for (int ks = 0; ks < 4; ++ks) a_ = __builtin_amdgcn_mfma_f32_16x16x32_f16(src[g4][ks], qb[ks], a_, 0, 0, 0); St[4 * (gb_) + g4] = a_; } } while (0)
            {
                h16x8 kfA[4][4], kfB[4][4];
                B3_KLOAD(kfA, 0); B3_KLOAD(kfB, 1);
                B3_KMMA(kfA, 0); B3_KLOAD(kfA, 2);
                B3_KMMA(kfB, 1); B3_KLOAD(kfB, 3);
                B3_KMMA(kfA, 2); B3_KMMA(kfB, 3);
            }
#undef B3_KLOAD
#undef B3_QLOAD
#undef B3_KMMA
            char* vbuf = lds + B3_V_OFF + wid * 8192;
            h16x8 vsA[8], vsB[8], vsC[8], vsD[8];
#define B3_VLOAD(dst, c) do { _Pragma("unroll") for (int i_ = 0; i_ < 8; ++i_) { const unsigned kr_ = idxl[32 * (c) + 4 * i_ + kq]; dst[i_] = *(const h16x8*)(VB + (brow + kr_) * 128 + 8 * l15); } } while (0)
            B3_VLOAD(vsA, 0); B3_VLOAD(vsB, 1); B3_VLOAD(vsC, 2); B3_VLOAD(vsD, 3);
            float mx = -__builtin_inff();
#pragma unroll
            for (int g = 0; g < 16; ++g)
#pragma unroll
                for (int i = 0; i < 4; ++i) { const float s = (16 * g + 4 * kq + i < count) ? St[g][i] * 0.08838834764831845f : -__builtin_inff(); St[g][i] = s; mx = fmaxf(mx, s); }
            mx = fmaxf(mx, swz_xor<16>(mx));
            { auto r = __builtin_amdgcn_permlane32_swap(__float_as_uint(mx), __float_as_uint(mx), false, false); mx = fmaxf(__uint_as_float(r[0]), __uint_as_float(r[1])); }
            float sm = 0.f;
#pragma unroll
            for (int g = 0; g < 16; ++g)
#pragma unroll
                for (int i = 0; i < 4; ++i) { const float p = __expf(St[g][i] - mx); St[g][i] = p; sm += p; }
            sm += swz_xor<16>(sm); sm = add_xor32(sm);
            const float inv = 1.0f / sm;
            h16x8 pb[8];
#pragma unroll
            for (int c = 0; c < 8; ++c) { h16x8 t;
#pragma unroll
                for (int i = 0; i < 4; ++i) { t[i] = (_Float16)(St[2 * c][i] * inv); t[4 + i] = (_Float16)(St[2 * c + 1][i] * inv); }
                pb[c] = t; }
            f32x4 o[8];
#pragma unroll
            for (int db = 0; db < 8; ++db) o[db] = (f32x4){0.f, 0.f, 0.f, 0.f};
            const int wrow = kq, wf = ((wrow & 3) << 2);
            const int rq = l15 >> 2, rp = l15 & 3, rf = (rq << 2) | kq;
            const int vb0 = (int)(uintptr_t)vbuf;
            int traddr[8];
#pragma unroll
            for (int db = 0; db < 8; ++db) traddr[db] = vb0 + 256 * (4 * kq + rq) + 16 * ((2 * db + (rp >> 1)) ^ rf) + 8 * (rp & 1);
#define B3_VWRITE(src) do { _Pragma("unroll") for (int i_ = 0; i_ < 8; ++i_) *(h16x8*)(vbuf + 256 * (4 * i_ + kq) + 16 * (l15 ^ (wf | (i_ & 3)))) = src[i_]; } while (0)
#define B3_TRRD(dst, addr, off) asm volatile("ds_read_b64_tr_b16 %0, %1 offset:%2" : "=&v"(dst) : "v"(addr), "i"(off) : "memory")
#define B3_PVCHUNK(c) do { _Pragma("unroll") for (int dh = 0; dh < 2; ++dh) { s16x4v a0[4], a1[4]; \
                _Pragma("unroll") for (int d4 = 0; d4 < 4; ++d4) { B3_TRRD(a0[d4], traddr[4 * dh + d4], 0); B3_TRRD(a1[d4], traddr[4 * dh + d4], 4096); } \
                asm volatile("s_waitcnt lgkmcnt(0)" ::: "memory"); __builtin_amdgcn_sched_barrier(0); \
                _Pragma("unroll") for (int d4 = 0; d4 < 4; ++d4) { const s16x8 av = {a0[d4][0], a0[d4][1], a0[d4][2], a0[d4][3], a1[d4][0], a1[d4][1], a1[d4][2], a1[d4][3]}; \
                    o[4 * dh + d4] = __builtin_amdgcn_mfma_f32_16x16x32_f16(__builtin_bit_cast(h16x8, av), pb[c], o[4 * dh + d4], 0, 0, 0); } } } while (0)
            B3_VWRITE(vsA); B3_VLOAD(vsA, 4); B3_PVCHUNK(0);
            B3_VWRITE(vsB); B3_VLOAD(vsB, 5); B3_PVCHUNK(1);
            B3_VWRITE(vsC); B3_VLOAD(vsC, 6); B3_PVCHUNK(2);
            B3_VWRITE(vsD); B3_VLOAD(vsD, 7); B3_PVCHUNK(3);
            B3_VWRITE(vsA); B3_PVCHUNK(4);
            B3_VWRITE(vsB); B3_PVCHUNK(5);
            B3_VWRITE(vsC); B3_PVCHUNK(6);
            B3_VWRITE(vsD); B3_PVCHUNK(7);
#undef B3_VLOAD
#undef B3_VWRITE
#undef B3_TRRD
#undef B3_PVCHUNK
            { float am = 0.f;
#pragma unroll
              for (int db = 0; db < 8; ++db) am = fmaxf(am, fmaxf(fmaxf(__builtin_fabsf(o[db][0]), __builtin_fabsf(o[db][1])), fmaxf(__builtin_fabsf(o[db][2]), __builtin_fabsf(o[db][3]))));
              am = wave_max(am); const float inv = am > 0.f ? 127.0f / am : 0.f;
              if (lane == 0) RFO[token] = am * (1.0f / 127.0f);
#pragma unroll
              for (int db = 0; db < 8; ++db) *(unsigned*)(AOQ + token * DM + l15 * 128 + 16 * db + 4 * kq) = pack4_i8(o[db][0] * inv, o[db][1] * inv, o[db][2] * inv, o[db][3] * inv); }
            }
        }
    }
}

__device__ __forceinline__ att::BlockRef<u16, u16> attA_ref(int stream, int qb, const u16* Qh, const u16* Kh, const u16* Vh, u16* O) {
    const int vh = stream & 1, c = (stream >> 1) & 1, bh = stream >> 2;
    const int qk = (bh * 2 + c), vv = (bh * 2 + vh);
    att::BlockRef<u16, u16> r;
    r.Q = Qh + ((size_t)qk * SEQ + (size_t)qb * 256) * 128; r.K = Kh + (size_t)qk * SEQ * 128; r.V = Vh + (size_t)vv * SEQ * 128;
    r.O = O + ((size_t)stream * SEQ + (size_t)qb * 256) * 128; r.P0 = qb * 256;
    return r;
}
__device__ __forceinline__ void phase_attnA(char* lds, const u16* Qh, const u16* Kh, const u16* Vh, u16* O, int vcu, int G) {
    constexpr int total = NB * 8 * 4 * 16;
    int L = vcu; if (L >= total) return;
    int pass = 0;
    att::BlockRef<u16, u16> cur = attA_ref(L >> 4, (L & 15), Qh, Kh, Vh, O);
    att::Seam<u16> S;
    att::causal_swa_prime<u16, u16>(cur, SEQ, lds, S);
    for (;;) {
        const bool more_pass = pass == 0, more_item = L + G < total, last = !more_pass && !more_item;
        int passn = pass + 1, Ln = L;
        if (!more_pass) { passn = 0; Ln = more_item ? L + G : L; }
        const int xn = Ln & 15;
        const att::BlockRef<u16, u16> nxt = last ? cur : attA_ref(Ln >> 4, passn ? 31 - xn : xn, Qh, Kh, Vh, O);
        att::causal_swa_block<u16, u16>(cur, nxt, SEQ, SEQ, lds, S);
        if (last) break;
        cur = nxt; pass = passn; L = Ln;
    }
}


namespace att {
constexpr int A2_K = 0, A2_V0 = 32768, A2_V1 = 65536, A2_P01 = 114688, A2_X = 132096, A2_P23 = 136192;

__device__ __forceinline__ void pv_tile2(f32x16* o, int vb, bf16x8 pa0, bf16x8 pa1, bf16x8 pa2, bf16x8 pa3) {
#define TRRD2(dst, off) asm volatile("ds_read_b64_tr_b16 %0, %1 offset:%2" : "=&v"(dst) : "v"(vb), "i"(off) : "memory")
#define PV_LD(S, ks) do { TRRD2(S##l0, v_rd_off(0, ks, 0)); TRRD2(S##h0, v_rd_off(0, ks, 1)); TRRD2(S##l1, v_rd_off(1, ks, 0)); TRRD2(S##h1, v_rd_off(1, ks, 1)); \
        TRRD2(S##l2, v_rd_off(2, ks, 0)); TRRD2(S##h2, v_rd_off(2, ks, 1)); TRRD2(S##l3, v_rd_off(3, ks, 0)); TRRD2(S##h3, v_rd_off(3, ks, 1)); } while (0)
#define PV_MM(S, pa) do { \
        o[0] = mfma32h(pa, (bf16x8){S##l0[0], S##l0[1], S##l0[2], S##l0[3], S##h0[0], S##h0[1], S##h0[2], S##h0[3]}, o[0], 0, 0, 0); \
        o[1] = mfma32h(pa, (bf16x8){S##l1[0], S##l1[1], S##l1[2], S##l1[3], S##h1[0], S##h1[1], S##h1[2], S##h1[3]}, o[1], 0, 0, 0); \
        o[2] = mfma32h(pa, (bf16x8){S##l2[0], S##l2[1], S##l2[2], S##l2[3], S##h2[0], S##h2[1], S##h2[2], S##h2[3]}, o[2], 0, 0, 0); \
        o[3] = mfma32h(pa, (bf16x8){S##l3[0], S##l3[1], S##l3[2], S##l3[3], S##h3[0], S##h3[1], S##h3[2], S##h3[3]}, o[3], 0, 0, 0); } while (0)
    s16x4 Al0, Ah0, Al1, Ah1, Al2, Ah2, Al3, Ah3, Bl0, Bh0, Bl1, Bh1, Bl2, Bh2, Bl3, Bh3;
    PV_LD(A, 0); PV_LD(B, 1);
    asm volatile("s_waitcnt lgkmcnt(8)" ::: "memory"); SBAR(); PV_MM(A, pa0); SBAR();
    PV_LD(A, 2);
    asm volatile("s_waitcnt lgkmcnt(8)" ::: "memory"); SBAR(); PV_MM(B, pa1); SBAR();
    PV_LD(B, 3);
    asm volatile("s_waitcnt lgkmcnt(8)" ::: "memory"); SBAR(); PV_MM(A, pa2); SBAR();
    asm volatile("s_waitcnt lgkmcnt(0)" ::: "memory"); SBAR(); PV_MM(B, pa3);
#undef PV_MM
#undef PV_LD
#undef TRRD2
}
__device__ __forceinline__ void qkt2(f32x16& p0, f32x16& p1, const char* Kt, int r32, int hi, const bf16x8* qr) {
    p0 = f32x16{}; p1 = f32x16{};
    const char* kb[4];
#pragma unroll
    for (int dd = 0; dd < 4; ++dd) kb[dd] = Kt + KSWZ(r32, (dd * 16 + hi * 8) * 2);
    bf16x8 c0 = *reinterpret_cast<const bf16x8*>(kb[0]), c1 = *reinterpret_cast<const bf16x8*>(kb[0] + 32 * 256);
#pragma unroll
    for (int d0 = 0; d0 < 8; ++d0) {
        bf16x8 n0 = c0, n1 = c1;
        if (d0 < 7) { const char* a = kb[(d0 + 1) & 3] + ((d0 + 1) >> 2) * 128; n0 = *reinterpret_cast<const bf16x8*>(a); n1 = *reinterpret_cast<const bf16x8*>(a + 32 * 256); }
        SBAR();
        p0 = mfma32h(c0, qr[d0], p0, 0, 0, 0);
        p1 = mfma32h(c1, qr[d0], p1, 0, 0, 0);
        SBAR();
        c0 = n0; c1 = n1;
    }
}
__device__ __forceinline__ void qkt3(f32x16& p0, f32x16& p1, const char* Kt, int r32, int hi, const bf16x8* qr) {
    p0 = f32x16{}; p1 = f32x16{};
    const char* kb[4];
#pragma unroll
    for (int dd = 0; dd < 4; ++dd) kb[dd] = Kt + KSWZ(r32, (dd * 16 + hi * 8) * 2);
#pragma unroll
    for (int d0 = 0; d0 < 8; ++d0) { const char* a = kb[d0 & 3] + (d0 >> 2) * 128;
        const bf16x8 b0 = *reinterpret_cast<const bf16x8*>(a), b1 = *reinterpret_cast<const bf16x8*>(a + 32 * 256);
        p0 = mfma32h(b0, qr[d0], p0, 0, 0, 0);
        p1 = mfma32h(b1, qr[d0], p1, 0, 0, 0); }
}
#define A2_BAR() do { asm volatile("s_waitcnt lgkmcnt(0)" ::: "memory"); __builtin_amdgcn_s_barrier(); asm volatile("" ::: "memory"); } while (0)
__device__ __forceinline__ void attnA2_block(const u16* Q, const u16* K, const u16* V0, const u16* V1, u16* O, int P0, char* lds) {
    const int tid = opaque_tid(), wid = __builtin_amdgcn_readfirstlane(tid >> 6), lane = tid & 63, r32 = lane & 31, hi = lane >> 5;
    const bool heavy = wid < 4; const int w4 = wid & 3;
    const int NT = P0 / KVBLK + 2;
    char* K_lds = lds + A2_K; char* Va = lds + A2_V0; char* Vb = lds + A2_V1;
    char* Pw = lds + (w4 < 2 ? A2_P01 + w4 * 8192 : A2_P23 + (w4 - 2) * 8192);
    float* al = (float*)(lds + A2_X + w4 * 512); unsigned* fl = (unsigned*)(al + 64); float* lf = al + 96;
    const int vb0 = (int)(uintptr_t)(heavy ? Va : Vb) + v_rd_base(lane);
    bf16x8 qr[8];
    if (heavy) {
#pragma unroll
        for (int d0 = 0; d0 < 8; ++d0) qr[d0] = load8<u16>(Q + (size_t)(w4 * QBLK + r32) * D + d0 * 16 + hi * 8);
    }
    const int lt = tid & 255, sc = (lt & 15) * 8;
    bf16x8 sk[4], sa[4], sb[4];
#define A2_LOADK(k0) do { _Pragma("unroll") for (int i_ = 0; i_ < 4; ++i_) sk[i_] = load8<u16>(K + (size_t)((k0) + (lt >> 4) + 16 * i_) * D + sc); } while (0)
#define A2_LOADV(k0) do { _Pragma("unroll") for (int i_ = 0; i_ < 4; ++i_) { const size_t ro_ = (size_t)((k0) + (lt >> 4) + 16 * i_) * D + sc; sa[i_] = load8<u16>(V0 + ro_); sb[i_] = load8<u16>(V1 + ro_); } } while (0)
#define A2_WRITEK(bf) do { _Pragma("unroll") for (int i_ = 0; i_ < 4; ++i_) { const int row_ = (lt >> 4) + 16 * i_; *(bf16x8*)(K_lds + (bf) * SHM_K + KSWZ(row_, sc * 2)) = sk[i_]; } } while (0)
#define A2_WRITEV(bf, bf3) do { _Pragma("unroll") for (int i_ = 0; i_ < 4; ++i_) { const int vs_ = v_st((lt >> 4) + 16 * i_, sc); *(bf16x8*)(Va + (bf) * SHM_V + vs_) = sa[i_]; *(bf16x8*)(Vb + (bf3) * SHM_V + vs_) = sb[i_]; } } while (0)
    if (!heavy) { A2_LOADK(0); A2_LOADV(0); asm volatile("s_waitcnt vmcnt(0)" ::: "memory"); A2_WRITEK(0); A2_WRITEV(0, 0); A2_LOADK(KVBLK); asm volatile("s_waitcnt vmcnt(0)" ::: "memory"); A2_WRITEK(1);
        if (2 < NT) A2_LOADK(2 * KVBLK); A2_LOADV(KVBLK); }
    A2_BAR();
    f32x16 o[4] = {};
    if (heavy) {
        float m_reg = -1e30f, l_reg = 0.f;
        const int qlo = P0 + w4 * QBLK, qm = qlo + r32 - 4 * hi;
        f32x16 pc0, pc1;
        qkt2(pc0, pc1, K_lds, r32, hi, qr);
        A2_BAR();
#pragma unroll 1
        for (int t = 0; t <= NT; ++t) {
            if (t < NT) {
                const int bf = t & 1; f32x16 pn0, pn1; float mn, alpha; bf16x8 pa0, pa1, pa2, pa3;
                { const int kb = t * KVBLK; if (kb + KVBLK - 1 > qlo) mask_tile(pc0, pc1, qm - kb, (unsigned)SEQ); }
                partialSM(pc0, pc1, m_reg, mn, alpha);
                qkt3(pn0, pn1, K_lds + ((t + 1) & 1) * SHM_K, r32, hi, qr);
                finishSM(pc0, pc1, alpha, l_reg, pa0, pa1, pa2, pa3);
#pragma unroll
                for (int g_ = 0; g_ < 16; ++g_) { __builtin_amdgcn_sched_group_barrier(0x100, 1, 0); __builtin_amdgcn_sched_group_barrier(0x008, 1, 0); __builtin_amdgcn_sched_group_barrier(0x002, 8, 0); }
                SBAR();
                const bool rs = __any(alpha < 1.f);
                if (rs) { if (hi == 0) al[bf * 32 + r32] = alpha; asm volatile("s_waitcnt lgkmcnt(0)" ::: "memory");
#pragma unroll
                    for (int d_ = 0; d_ < 4; ++d_)
#pragma unroll
                        for (int r = 0; r < 16; ++r) o[d_][r] *= al[bf * 32 + crow(r, hi)]; }
                if (lane == 0) fl[bf] = rs ? 1u : 0u;
                *(bf16x8*)(Pw + bf * 4096 + lane * 16) = pa0; *(bf16x8*)(Pw + bf * 4096 + 1024 + lane * 16) = pa1; *(bf16x8*)(Pw + bf * 4096 + 2048 + lane * 16) = pa2; *(bf16x8*)(Pw + bf * 4096 + 3072 + lane * 16) = pa3;
                if (t == NT - 1 && hi == 0) lf[r32] = l_reg;
                SBAR();
                pv_tile2(o, vb0 + bf * SHM_V, pa0, pa1, pa2, pa3);
                pc0 = pn0; pc1 = pn1;
            }
            A2_BAR();
        }
    } else {
        A2_BAR();
#pragma unroll 1
        for (int t = 0; t <= NT; ++t) {
            asm volatile("s_waitcnt vmcnt(0)" ::: "memory");
            if (t + 2 < NT) A2_WRITEK(t & 1);
            if (t + 1 < NT) A2_WRITEV((t + 1) & 1, (t + 1) % 3);
            if (t + 3 < NT) A2_LOADK((t + 3) * KVBLK);
            if (t + 2 < NT) A2_LOADV((t + 2) * KVBLK);
            SBAR();
            if (t >= 1) {
                const int bf = (t - 1) & 1, bf3 = (t - 1) % 3;
                const unsigned f = __builtin_amdgcn_readfirstlane(fl[bf]);
                if (f) {
#pragma unroll
                    for (int d_ = 0; d_ < 4; ++d_)
#pragma unroll
                        for (int r = 0; r < 16; ++r) o[d_][r] *= al[bf * 32 + crow(r, hi)]; }
                const bf16x8 pa0 = *(const bf16x8*)(Pw + bf * 4096 + lane * 16), pa1 = *(const bf16x8*)(Pw + bf * 4096 + 1024 + lane * 16), pa2 = *(const bf16x8*)(Pw + bf * 4096 + 2048 + lane * 16), pa3 = *(const bf16x8*)(Pw + bf * 4096 + 3072 + lane * 16);
                asm volatile("s_waitcnt lgkmcnt(0)" ::: "memory"); SBAR();
                pv_tile2(o, vb0 + bf3 * SHM_V, pa0, pa1, pa2, pa3);
            }
            A2_BAR();
        }
    }
#undef A2_LOADK
#undef A2_LOADV
#undef A2_WRITEK
#undef A2_WRITEV
    float rli[16];
#pragma unroll
    for (int r = 0; r < 16; ++r) rli[r] = __builtin_amdgcn_rcpf(lf[crow(r, hi)]);
    u16* Ow = O + (size_t)(w4 * QBLK) * 256 + (heavy ? 0 : 128);
#pragma unroll
    for (int r = 0; r < 16; ++r) { const int orow = crow(r, hi);
#pragma unroll
        for (int d0 = 0; d0 < 4; ++d0) { const float v = o[d0][r] * rli[r]; const float vn = swz_xor<1>(v);
            if ((r32 & 1) == 0) *(unsigned*)(Ow + (size_t)orow * 256 + d0 * 32 + r32) = cvtpk(v, vn); } }
    A2_BAR();
}
#undef A2_BAR
}
__device__ __forceinline__ void phase_attnA2(char* lds, const u16* Qh, const u16* Kh, const u16* Vh, u16* O, int vcu, int G) {
    for (int L = vcu; L < NB * 8 * 2 * 32; L += G) {
        const int s = L >> 5, y = L & 31, bh = s >> 1;
        const u16* Kp = Kh + (size_t)s * SEQ * 128; const u16* V0 = Vh + (size_t)(bh * 2) * SEQ * 128; const u16* V1 = Vh + (size_t)(bh * 2 + 1) * SEQ * 128;
#pragma unroll 1
        for (int pass = 0; pass < 2; ++pass) { const int P0 = (pass ? 63 - y : y) * 128;
            att::attnA2_block(Qh + ((size_t)s * SEQ + P0) * 128, Kp, V0, V1, O + ((size_t)s * SEQ + P0) * 256, P0, lds); }
    }
}
struct Args { const float* in[22]; float* out; unsigned char* ws; int ph_lo, ph_hi; int rep[8]; };
typedef const __attribute__((address_space(4))) unsigned long long* kargp_t;
__device__ __forceinline__ unsigned long long karg_u64(int idx) { asm volatile("" : "+s"(idx)); return ((kargp_t)__builtin_amdgcn_kernarg_segment_ptr())[idx]; }
#define KIN(i) ((const float*)(const __attribute__((address_space(1))) float*)karg_u64(i))
#define KOUT() ((float*)(__attribute__((address_space(1))) float*)karg_u64(22))
#define KREP(i) ((int)(karg_u64(25 + ((i) >> 1)) >> (32 * ((i) & 1))))
#define KWS() ((unsigned char*)(__attribute__((address_space(1))) unsigned char*)karg_u64(23))
#define FRAME() const int tid = opaque_tid(), lane = tid & 63, wave = __builtin_amdgcn_readfirstlane(tid >> 6); const int G = gridDim.x, bx = blockIdx.x; \
    const int vcu = (G % 8 == 0) ? (bx % 8) * (G / 8) + bx / 8 : bx; const int gw = vcu * NWAVES + wave, NGW = G * NWAVES; (void)lane; (void)gw; (void)NGW; (void)vcu; (void)bx
__global__ void __launch_bounds__(NWAVES * 64, 2) fwd_kernel(Args args) {
    extern __shared__ __attribute__((aligned(16))) unsigned char lds[];
    LAS unsigned char* L3 = (LAS unsigned char*)lds;
    volatile LAS unsigned* MISC = (volatile LAS unsigned*)(L3 + MISC_OFF);
    if (threadIdx.x < 32) MISC[threadIdx.x] = 0u;
    if ((threadIdx.x & 63) == 0) ((volatile LAS int*)(L3 + TIDTAB_OFF))[hw_wave_slot()] = (int)(threadIdx.x >> 6);
    __syncthreads();
    { XcdBarrier b0 = xcd_barrier_post((unsigned*)(KWS() + WS_CTL) + CW_BAR, MISC + 8); (void)b0; }
    int ph = 0; const int lo = args.ph_lo, hi = args.ph_hi;
#define IN() (lo <= ph && ph < hi)
#define OPQ_LS() int li = li0, s = s0; asm volatile("" : "+s"(li), "+s"(s)); (void)li; (void)s
#define SEAM() do { if (lo <= ph && ph + 1 < hi) { XcdBarrier b_; b_.bar = (unsigned*)(KWS() + WS_CTL) + CW_BAR; b_.x = xb_xcc_id(); b_.st = MISC + 8; xcd_barrier(b_); } ++ph; } while (0)

    if (IN()) {
        FRAME(); unsigned char* ws = KWS();
        LAS float* scr = (LAS float*)(L3 + wave * 16384);
        { const float* cin = KIN(1); const float* adaw = KIN(2); float* modp = (float*)(ws + WS_MODP);
          for (int it = gw; it < 4 * 72 * 8; it += NGW) p0_ada_item(cin, adaw, modp, it, scr, lane); }
        constexpr int I_BIN = 32 * 144;
        for (int it = gw; it < 2 * I_BIN; it += NGW) { const int mj = it / I_BIN, q = it % I_BIN, kb = q / 144, nb = q % 144;
            p0_transpose_item(KIN(16) + (size_t)mj * DM * B_IN, DM, B_IN, (u16*)(ws + WS_WBIN) + (size_t)mj * B_INP * DM, 32 * nb, 64 * kb, 32 * nb, scr, lane); }
        { float* cost = (float*)(ws + WS_COS); float* sint = (float*)(ws + WS_SIN); float* costi = (float*)(ws + WS_COSI); float* sinti = (float*)(ws + WS_SINI);
          for (int e = gw * 64 + lane; e < SEQ * 64; e += NGW * 64) { float co, si; sincos_d((double)(e >> 6) * powi_d(0.8659643233600653, e & 63), co, si); cost[e] = co; sint[e] = si; }
          for (int e = gw * 64 + lane; e < SEQ * 32; e += NGW * 64) { float co, si; sincos_d((double)(e >> 5) * powi_d(0.7498942093324559, e & 31), co, si); costi[e] = co; sinti[e] = si; } }
    }
    SEAM();
    if (IN()) {
        FRAME(); unsigned char* ws = KWS(); const float* adab = KIN(3); const float* modp = (const float*)(ws + WS_MODP); float* mod = (float*)(ws + WS_MOD);
        for (int e = gw * 64 + lane; e < DEPTH * NB * ADAW; e += NGW * 64) {
            const int layer = e / (NB * ADAW), col = e % ADAW;
            float s = adab[layer * ADAW + col];
#pragma unroll
            for (int kc = 0; kc < 8; ++kc) s += modp[(size_t)kc * DEPTH * NB * ADAW + e];
            const int slot = col / DM; mod[e] = (slot == 2 || slot == 8) ? 0.5f * s : s;
        }
    }
    SEAM();
    if (IN()) {
        FRAME(); unsigned char* ws = KWS(); const float* mod = (const float*)(ws + WS_MOD); float* bias = (float*)(ws + WS_BIAS);
        constexpr int S_GU = 16 * 176, S_AIN = 2 * 192, S_OUT = 4 * 64, S_DN = 8 * 128;
        for (int st = bx; st < S_GU + S_AIN + S_OUT + S_DN; st += G) {
            if (st < S_GU) { const int mi = st / 176, nb = st % 176, lj = mi >> 1, isup = mi & 1, n0 = 32 * nb, li = lj >> 1, sl = (lj & 1) * 2, q = 3 * li + sl;
                const int drow0 = 256 * (n0 >> 7) + (n0 & 127) + 128 * isup;
                p0w_strip<DM, 32, true>(KIN(4 + isup) + (size_t)lj * DM * DFF, DFF, n0, ws + WS_WQ + ((size_t)lj * GU_N + drow0) * DM, (float*)(ws + WS_TQ) + (size_t)lj * GU_N + drow0,
                                        mod + (size_t)li * NB * ADAW + (3 * sl) * DM, bias + (size_t)(q * 4) * GU_N + drow0, GU_N, L3, tid);
            } else if (st < S_GU + S_AIN) { const int r = st - S_GU, mj = r / 192, nb = r % 192, n0 = 32 * nb, li = 2 * mj, q = 3 * li + 1;
                const int chunk = n0 >> 7, d = n0 & 127, drow0 = (n0 < 4096) ? 256 * (chunk >> 1) + 128 * (d >> 6) + 64 * (chunk & 1) + 32 * ((d >> 5) & 1) : n0;
                p0w_strip<DM, 32, true>(KIN(7) + (size_t)mj * DM * A_IN, A_IN, n0, ws + WS_WQA + ((size_t)mj * A_IN + drow0) * DM, (float*)(ws + WS_TQA) + (size_t)mj * A_IN + drow0,
                                        mod + (size_t)li * NB * ADAW + 3 * DM, bias + (size_t)(q * 4) * GU_N + drow0, GU_N, L3, tid);
            } else if (st < S_GU + S_AIN + S_OUT) { const int r = st - S_GU - S_AIN, mi = r / 64, nb = r % 64, n0 = 32 * nb;
                const float* Wsrc = (mi < 2) ? KIN(8) + (size_t)mi * DM * DM : KIN(17) + (size_t)(mi - 2) * DM * DM;
                p0w_strip<DM, 32, false>(Wsrc, DM, n0, ws + WS_WOQ + ((size_t)mi * DM + n0) * DM, (float*)(ws + WS_TQO) + (size_t)mi * DM + n0, nullptr, nullptr, 0, L3, tid);
            } else { const int r = st - S_GU - S_AIN - S_OUT, gi = r / 128, nb = r % 128, n0 = 16 * nb;
                p0w_strip<DFF, 16, false, true>(KIN(6) + (size_t)gi * DFF * DM, DM, n0, ws + WS_WQD + ((size_t)gi * DM + n0) * DFF, (float*)(ws + WS_TQD) + (size_t)gi * DM + n0, nullptr, nullptr, 0, L3, tid);
            }
        }
        phase_bias_bin(mod, (const u16*)(ws + WS_WBIN), bias, gw, NGW, lane);
    }
    SEAM();

#pragma unroll 1
    for (int li0 = 0; li0 < DEPTH; ++li0) {
#pragma unroll 1
        for (int s0 = 0; s0 < 3; ++s0) {
            if (s0 != 1) {
                if (IN()) { OPQ_LS();
                    FRAME(); unsigned char* ws = KWS(); const float* modl = (const float*)(ws + WS_MOD) + (size_t)li * NB * ADAW;
                    if (li == 0 && s == 0) { phase_quant<true>(KIN(0), (u16*)(ws + WS_XH), (unsigned long long*)(ws + WS_XQ), modl + (3 * s + 1) * DM, (float*)(ws + WS_RF), gw, NGW, lane);
                    }
                    else phase_quant<false>(nullptr, (u16*)(ws + WS_XH), (unsigned long long*)(ws + WS_XQ), modl + (3 * s + 1) * DM, (float*)(ws + WS_RF), gw, NGW, lane);
                }
                SEAM();
                if (IN()) { OPQ_LS();
                    unsigned char* ws = KWS(); const int G = gridDim.x, bx = blockIdx.x; const int gi = li * 2 + (s >> 1);
                    pg8::Gemm g{(const u16*)(ws + WS_XQ), (const u16*)(ws + WS_WQ + (size_t)gi * GU_N * DM), MTOK, GU_N, DM / 2}; pg8::StaticOrder S; S.init(MTOK, GU_N, G, bx);
                    const int q = 3 * li + s; pg8::EpiSwiglu8 E{ws + WS_HQ, DFF, (const float*)(ws + WS_RF), (const float*)(ws + WS_TQ) + (size_t)gi * GU_N, (const float*)(ws + WS_BIAS) + (size_t)q * 4 * GU_N, GU_N};
                    pg8::gemm_phase<pg8::EpiSwiglu8, pg8::StaticOrder, true, true, 1>(L3, g, S, E);
                }
                SEAM();
            } else {
                const bool isA = (li0 & 1) == 0;
                if (IN()) { OPQ_LS();
                    FRAME(); unsigned char* ws = KWS(); const float* modl = (const float*)(ws + WS_MOD) + (size_t)li * NB * ADAW; const int q = 3 * li + s;
                    if ((li & 1) == 0) phase_quant<false>(nullptr, (u16*)(ws + WS_XH), (unsigned long long*)(ws + WS_XQ), modl + (3 * s + 1) * DM, (float*)(ws + WS_RF), gw, NGW, lane);
                    else phase_prepx((const u16*)(ws + WS_XH), (u16*)(ws + WS_XN), modl + (3 * s + 1) * DM, (float*)(ws + WS_SSQ) + (q & 1) * MTOK, gw, NGW, lane);
                }
                SEAM();
                if (IN()) { OPQ_LS();
                    unsigned char* ws = KWS(); const int G = gridDim.x, bx = blockIdx.x; const int mj = li >> 1; const int q = 3 * li + s;
                    const pg8::RowCol rc{(const float*)(ws + WS_SSQ) + (q & 1) * MTOK, (const float*)(ws + WS_BIAS) + (size_t)q * 4 * GU_N, GU_N};
                    if ((li & 1) == 0) {
                        pg8::Gemm g{(const u16*)(ws + WS_XQ), (const u16*)(ws + WS_WQA + (size_t)mj * A_IN * DM), MTOK, A_IN, DM / 2}; pg8::StaticOrder S; S.init(MTOK, A_IN, G, bx);
                        const pg8::RowCol rcq{(const float*)(ws + WS_RF), rc.bias, rc.bstride};
                        pg8::EpiQkvA E{(u16*)(ws + WS_Q), (u16*)(ws + WS_K), (u16*)(ws + WS_V), rcq, (const float*)(ws + WS_TQA) + (size_t)mj * A_IN, KIN(9) + mj * 128, KIN(10) + mj * 128, (const float*)(ws + WS_COS), (const float*)(ws + WS_SIN), (LAS float*)(L3 + 132096)};
                        pg8::gemm_phase<pg8::EpiQkvA, pg8::StaticOrder, true, true, 1>(L3, g, S, E);
                    } else {
                        pg8::Gemm g{(const u16*)(ws + WS_XN), (const u16*)(ws + WS_WBIN) + (size_t)mj * B_INP * DM, MTOK, B_INP, DM}; pg8::StaticOrder S; S.init(MTOK, B_INP, G, bx);
                        pg8::EpiF16 E{(u16*)(ws + WS_BIG), B_INP, rc};
                        pg8::gemm_phase<pg8::EpiF16, pg8::StaticOrder, true, true>(L3, g, S, E);
                    }
                }
                SEAM();
                if (isA) {
                    if (IN()) { OPQ_LS(); unsigned char* ws = KWS(); const int G = gridDim.x, bx = blockIdx.x; const int vcu = (G % 8 == 0) ? (bx % 8) * (G / 8) + bx / 8 : bx;
                        phase_attnA2((char*)lds, (const u16*)(ws + WS_Q), (const u16*)(ws + WS_K), (const u16*)(ws + WS_V), (u16*)(ws + WS_O), vcu, G); __syncthreads(); }
                    SEAM();
                    if (IN()) { OPQ_LS(); FRAME(); unsigned char* ws = KWS(); const int mj = li >> 1;
                        phase_combineA((const u16*)(ws + WS_O), ws + WS_AO, (float*)(ws + WS_RFO), KIN(11) + mj * 128, KIN(12) + mj * 128, KIN(13) + mj * 128, KIN(14) + mj * 128, KIN(15) + mj * 256,
                                       li == 0 ? 0.2f : 0.47071301834358414f, gw, NGW, lane); }
                    SEAM();
                } else {
                    if (IN()) { OPQ_LS(); FRAME(); unsigned char* ws = KWS(); const int mj = li >> 1;
                        phase_normropeB((const u16*)(ws + WS_BIG), (u16*)(ws + WS_Q), (u16*)(ws + WS_V), (u16*)(ws + WS_V + 8 * MiB), (u16*)(ws + WS_K), (u16*)(ws + WS_V + 16 * MiB), (float*)(ws + WS_V + 24 * MiB),
                                        KIN(18) + mj * 128, KIN(19) + mj * 128, KIN(20) + mj * 128, KIN(21) + mj * 128,
                                        (const float*)(ws + WS_COS), (const float*)(ws + WS_SIN), (const float*)(ws + WS_COSI), (const float*)(ws + WS_SINI), gw, NGW, lane); }
                    SEAM();
                    if (IN()) { OPQ_LS(); unsigned char* ws = KWS(); const int G = gridDim.x, bx = blockIdx.x; const int vcu = (G % 8 == 0) ? (bx % 8) * (G / 8) + bx / 8 : bx;
                        phase_B3((char*)lds, (const u16*)(ws + WS_Q), (const u16*)(ws + WS_V), (const u16*)(ws + WS_V + 8 * MiB), (const u16*)(ws + WS_K), (const u16*)(ws + WS_V + 16 * MiB),
                                 (const float*)(ws + WS_V + 24 * MiB), (float*)(ws + WS_O), ws + WS_AO, (float*)(ws + WS_RFO), vcu, G); __syncthreads(); }
                    SEAM();
                }
            }
            if (IN()) { OPQ_LS();
                unsigned char* ws = KWS(); const int G = gridDim.x, bx = blockIdx.x;
                const float* gate = (const float*)(ws + WS_MOD) + (size_t)li * NB * ADAW + (3 * s + 2) * DM;
                const int mi = (li & 1) * 2 + (li >> 1), gi = li * 2 + (s >> 1);
                pg8::StaticOrder S; S.init(MTOK, DM, G, bx);
                if (s != 1) {
                    pg8::Gemm g{(const u16*)(ws + WS_HQ), (const u16*)(ws + WS_WQD + (size_t)gi * DM * DFF), MTOK, DM, DFF / 2};
                    pg8::EpiResidQ E{(const u16*)(ws + WS_XH), (u16*)(ws + WS_XH), KOUT(), gate, nullptr, (const float*)(ws + WS_TQD) + (size_t)gi * DM, (li == DEPTH - 1 && s == 2) ? 1 : 0};
                    pg8::gemm_phase<pg8::EpiResidQ, pg8::StaticOrder, true, true, 2>(L3, g, S, E);
                } else {
                    pg8::Gemm g{(const u16*)(ws + WS_AO), (const u16*)(ws + WS_WOQ + (size_t)mi * DM * DM), MTOK, DM, DM / 2};
                    pg8::EpiResidQ E{(const u16*)(ws + WS_XH), (u16*)(ws + WS_XH), KOUT(), gate, (const float*)(ws + WS_RFO), (const float*)(ws + WS_TQO) + (size_t)mi * DM, 0};
                    pg8::gemm_phase<pg8::EpiResidQ, pg8::StaticOrder, true, true, 1>(L3, g, S, E);
                }
            }
            SEAM();
        }
    }
#undef IN
#undef SEAM
}

#ifndef MK_PER_PHASE
#define MK_PER_PHASE 0
#endif
extern "C" void kernel_launch(void* const* d_in, const int* in_sizes, int n_in, void* d_out, int out_size, void* d_ws, size_t ws_size, hipStream_t stream) {
    static int grid = 0;
    if (grid == 0) {
        if (n_in != 22 || out_size != MTOK * DM || ws_size < WS_END) { fprintf(stderr, "kernel_launch: unexpected shapes (n_in %d out %d ws %zu)\n", n_in, out_size, ws_size); grid = -1; return; }
        int dev = 0, cus = 0, per_cu = 0;
        if (hipGetDevice(&dev) != hipSuccess || hipDeviceGetAttribute(&cus, hipDeviceAttributeMultiprocessorCount, dev) != hipSuccess) { grid = -1; return; }
        if (hipFuncSetAttribute((const void*)fwd_kernel, hipFuncAttributeMaxDynamicSharedMemorySize, LDS_BYTES) != hipSuccess) { fprintf(stderr, "kernel_launch: hipFuncSetAttribute failed\n"); grid = -1; return; }
        if (hipOccupancyMaxActiveBlocksPerMultiprocessor(&per_cu, (const void*)fwd_kernel, NWAVES * 64, LDS_BYTES) != hipSuccess || per_cu < 1) { fprintf(stderr, "kernel_launch: occupancy query says %d\n", per_cu); grid = -1; (void)hipGetLastError(); return; }
        (void)hipGetLastError();
        grid = cus;
    }
    if (grid < 0) return;
    if (hipMemsetAsync((char*)d_ws + WS_CTL, 0, CTL_ZERO_BYTES, stream) != hipSuccess) return;
    Args a{};
    for (int i = 0; i < 22; ++i) a.in[i] = (const float*)d_in[i];
    a.out = (float*)d_out; a.ws = (unsigned char*)d_ws;
#ifndef PROBE_REP0
#define PROBE_REP0 1
#define PROBE_REP1 1
#define PROBE_REP2 1
#define PROBE_REP3 1
#define PROBE_REP4 1
#define PROBE_REP5 1
#define PROBE_REP6 1
#endif
    a.rep[0] = PROBE_REP0; a.rep[1] = PROBE_REP1; a.rep[2] = PROBE_REP2; a.rep[3] = PROBE_REP3; a.rep[4] = PROBE_REP4; a.rep[5] = PROBE_REP5; a.rep[6] = PROBE_REP6; a.rep[7] = 1;
#if MK_PER_PHASE
    for (int p = 0; p < 40; ++p) { a.ph_lo = p; a.ph_hi = p + 1; hipLaunchKernelGGL(fwd_kernel, dim3(grid), dim3(NWAVES * 64), LDS_BYTES, stream, a); }
#else
    a.ph_lo = 0; a.ph_hi = 1 << 20;
    hipLaunchKernelGGL(fwd_kernel, dim3(grid), dim3(NWAVES * 64), LDS_BYTES, stream, a);
#endif
}
```

```cpp
#include <hip/hip_runtime.h>
#include <cstdio>
#include <cstdint>

typedef unsigned short u16;
typedef _Float16 h16x8 __attribute__((ext_vector_type(8)));
typedef _Float16 h16x4 __attribute__((ext_vector_type(4)));
typedef _Float16 h16x2 __attribute__((ext_vector_type(2)));

constexpr int DM = 2048, NB = 4, SEQ = 8192, DEPTH = 4, DFF = 5632, MTOK = NB * SEQ;
constexpr int NADA = 9, ADAW = NADA * DM;
constexpr int A_IN = 6144, B_IN = 4496, B_INP = 4608;
constexpr int GU_N = 2 * DFF;
constexpr float NORM_EPS = 1e-6f;

constexpr int TIDTAB_OFF = 131072 + 320 + 128;
__device__ __forceinline__ int hw_wave_slot() { return (int)(__builtin_amdgcn_s_getreg((5 << 11) | 4) & 63u); }
__device__ __forceinline__ int opaque_lane() { int ln; asm volatile("v_mbcnt_lo_u32_b32 %0, -1, 0\n\tv_mbcnt_hi_u32_b32 %0, -1, %0" : "=v"(ln)); return ln; }
__device__ __forceinline__ int opaque_tid() {
    extern __shared__ __attribute__((aligned(16))) unsigned char lds_tid_[];
    const int w = ((volatile __attribute__((address_space(3))) int*)((__attribute__((address_space(3))) unsigned char*)lds_tid_ + TIDTAB_OFF))[hw_wave_slot()];
    int ln; asm volatile("v_mbcnt_lo_u32_b32 %0, -1, 0\n\tv_mbcnt_hi_u32_b32 %0, -1, %0" : "=v"(ln));
    int t = (w << 6) | ln;
    asm volatile("" : "+v"(t)); return t;
}

template <int K> __device__ __forceinline__ float swz_xor(float v) { static_assert(K > 0 && K < 32, "swz_xor"); return __builtin_bit_cast(float, __builtin_amdgcn_ds_swizzle(__builtin_bit_cast(int, v), (K << 10) | 0x1F)); }
__device__ __forceinline__ float add_xor16(float v) { auto r = __builtin_amdgcn_permlane16_swap(__float_as_uint(v), __float_as_uint(v), false, false); return __uint_as_float(r[0]) + __uint_as_float(r[1]); }
__device__ __forceinline__ float add_xor32(float v) { auto r = __builtin_amdgcn_permlane32_swap(__float_as_uint(v), __float_as_uint(v), false, false); return __uint_as_float(r[0]) + __uint_as_float(r[1]); }

namespace pg8 {
#define PG8_LAS __attribute__((address_space(3)))
typedef unsigned short bf16_t;
typedef short bf16x8 __attribute__((ext_vector_type(8)));
typedef float f32x4 __attribute__((ext_vector_type(4)));
typedef unsigned u32x4 __attribute__((ext_vector_type(4)));
typedef int i32x4 __attribute__((ext_vector_type(4)));
constexpr int BM = 256, BK = 64, HALF = 128, HTB = HALF * BK * 2  , STAGE_BYTES = 8 * HTB, NXCD = 8, WGM = 4;

__host__ __device__ __forceinline__ int lds_byte(int r, int c) { const int st = (r >> 4) * 2 + (c >> 5), rr = r & 15, cc = c & 31, ob = rr * 64 + cc * 2; return st * 1024 + (ob ^ (((ob >> 9) & 1) << 5)); }
__host__ __device__ __forceinline__ void stage_rc(int b, int& R, int& C) { const int st = b / 1024, sb = b % 1024, swz = sb ^ (((sb >> 9) & 1) << 5); R = (st >> 1) * 16 + swz / 64; C = (st & 1) * 32 + (swz % 64) / 2; }
__host__ __device__ __forceinline__ int perm32(int rho) { const int n = rho >> 4, i = rho & 15; return 8 * (i >> 2) + 4 * n + (i & 3); }

struct Unit { int pm, pn; };
struct Gemm { const bf16_t* A; const bf16_t* Bt; int M, N, K; };

struct StaticOrder {
    int nM, nN, nwg, G, c;
    __host__ __device__ void init(int M, int N, int G_, int c_) { nM = M / BM; nN = N / BM; nwg = nM * nN; G = G_; c = c_; }
    __host__ __device__ bool next(int i, Unit& u) const {
        const long L = (long)i * G + c; if (L >= nwg) return false;
        int wgid = (int)L; { const int q = nwg / NXCD, r = nwg % NXCD, xcd = wgid % NXCD, off = wgid / NXCD; wgid = (xcd < r ? xcd * (q + 1) : r * (q + 1) + (xcd - r) * q) + off; }
        const int nig = WGM * nN, gid = wgid / nig, fm = gid * WGM, gsz = (nM - fm) < WGM ? (nM - fm) : WGM;
        u.pm = fm + ((wgid % nig) % gsz); u.pn = (wgid % nig) / gsz; return true;
    }
    __device__ __forceinline__ void a_ready(const Unit&) const {}
    __device__ __forceinline__ void done(const Unit&) const {}
};

__device__ __forceinline__ unsigned cvt_pk_h(float lo, float hi) { h16x2 v = {(_Float16)lo, (_Float16)hi}; return __builtin_bit_cast(unsigned, v); }
__device__ __forceinline__ float silu_f(float g) { return g * __builtin_amdgcn_rcpf(1.0f + __builtin_amdgcn_exp2f(g * -1.4426950408889634f)); }

struct RowCol { const float* ssq; const float* bias; int bstride; };
__device__ __forceinline__ float rstd_of(const float* ssq, int row) { return rsqrtf(ssq[row] * (1.0f / DM) + NORM_EPS); }

struct EpiSwiglu {
    static constexpr bool PERM = true, AFTER_DRAIN = false;
    u16* O; int ldc; const float* rf; const float* tq; const float* bias; int bstride;
    __device__ __forceinline__ void operator()(const f32x4 (&acc)[2][2][4][2], const Unit& u, int wr, int wc, int fr, int fq) const {
        const int row0 = u.pm * BM + wr * 64 + fr, col0 = u.pn * HALF + wc * 32 + 8 * fq;
        const float* bp = bias + (size_t)(u.pm >> 5) * bstride + u.pn * BM + wc * 32 + 8 * fq;
        const float* tp = tq + u.pn * BM + wc * 32 + 8 * fq;
        const f32x4 bg0 = *(const f32x4*)bp, bg1 = *(const f32x4*)(bp + 4), bu0 = *(const f32x4*)(bp + HALF), bu1 = *(const f32x4*)(bp + HALF + 4);
        const f32x4 tg0 = *(const f32x4*)tp, tg1 = *(const f32x4*)(tp + 4), tu0 = *(const f32x4*)(tp + HALF), tu1 = *(const f32x4*)(tp + HALF + 4);
#pragma unroll
        for (int ai = 0; ai < 2; ++ai)
#pragma unroll
            for (int m = 0; m < 4; ++m) {
                const int row = row0 + ai * HALF + m * 16; const float rs = rf[row];
                u16* rowp = O + (size_t)row * ldc + col0;
                const f32x4 g0 = (acc[ai][0][m][0] * rs) * tg0 + bg0, g1 = (acc[ai][0][m][1] * rs) * tg1 + bg1, u0 = (acc[ai][1][m][0] * rs) * tu0 + bu0, u1 = (acc[ai][1][m][1] * rs) * tu1 + bu1;
                u32x4 w;
                w.x = cvt_pk_h(silu_f(g0[0]) * u0[0], silu_f(g0[1]) * u0[1]); w.y = cvt_pk_h(silu_f(g0[2]) * u0[2], silu_f(g0[3]) * u0[3]);
                w.z = cvt_pk_h(silu_f(g1[0]) * u1[0], silu_f(g1[1]) * u1[1]); w.w = cvt_pk_h(silu_f(g1[2]) * u1[2], silu_f(g1[3]) * u1[3]);
                *(u32x4*)rowp = w;
            }
    }
};
constexpr float HID_S = 4.0f, F8_MAX = 448.0f, F8_WMAX = 440.0f;
__device__ __forceinline__ unsigned pack4_f8(float a, float b, float c, float d) { int w = __builtin_amdgcn_cvt_pk_fp8_f32(a, b, 0, false); w = __builtin_amdgcn_cvt_pk_fp8_f32(c, d, w, true); return (unsigned)w; }
__device__ __forceinline__ float clamp_f8(float x) { return __builtin_amdgcn_fmed3f(x, -F8_MAX, F8_MAX); }
struct EpiSwiglu8 {
    static constexpr bool PERM = true, AFTER_DRAIN = false;
    unsigned char* O; int ldc; const float* rf; const float* tq; const float* bias; int bstride;
    __device__ __forceinline__ void operator()(const f32x4 (&acc)[2][2][4][2], const Unit& u, int wr, int wc, int fr, int fq) const {
        const int row0 = u.pm * BM + wr * 64 + fr, col0 = u.pn * HALF + wc * 32 + 8 * fq;
        const float* bp = bias + (size_t)(u.pm >> 5) * bstride + u.pn * BM + wc * 32 + 8 * fq;
        const float* tp = tq + u.pn * BM + wc * 32 + 8 * fq;
        const f32x4 bg0 = *(const f32x4*)bp, bg1 = *(const f32x4*)(bp + 4), bu0 = *(const f32x4*)(bp + HALF) * HID_S, bu1 = *(const f32x4*)(bp + HALF + 4) * HID_S;
        const f32x4 tg0 = *(const f32x4*)tp, tg1 = *(const f32x4*)(tp + 4), tu0 = *(const f32x4*)(tp + HALF) * HID_S, tu1 = *(const f32x4*)(tp + HALF + 4) * HID_S;
#pragma unroll
        for (int ai = 0; ai < 2; ++ai)
#pragma unroll
            for (int m = 0; m < 4; ++m) {
                const int row = row0 + ai * HALF + m * 16; const float rs = rf[row];
                unsigned char* rowp = O + (size_t)row * ldc + col0;
                const f32x4 g0 = (acc[ai][0][m][0] * rs) * tg0 + bg0, g1 = (acc[ai][0][m][1] * rs) * tg1 + bg1, u0 = (acc[ai][1][m][0] * rs) * tu0 + bu0, u1 = (acc[ai][1][m][1] * rs) * tu1 + bu1;
                unsigned long long w;
                const unsigned wlo = pack4_f8(clamp_f8(silu_f(g0[0]) * u0[0]), clamp_f8(silu_f(g0[1]) * u0[1]), clamp_f8(silu_f(g0[2]) * u0[2]), clamp_f8(silu_f(g0[3]) * u0[3]));
                const unsigned whi = pack4_f8(clamp_f8(silu_f(g1[0]) * u1[0]), clamp_f8(silu_f(g1[1]) * u1[1]), clamp_f8(silu_f(g1[2]) * u1[2]), clamp_f8(silu_f(g1[3]) * u1[3]));
                w = (unsigned long long)wlo | ((unsigned long long)whi << 32); *(unsigned long long*)rowp = w;
            }
    }
};
struct EpiResid {
    static constexpr bool PERM = true, AFTER_DRAIN = false;
    const u16* xin; u16* xout16; float* xout32; const float* gate; int out32;
    __device__ __forceinline__ void operator()(const f32x4 (&acc)[2][2][4][2], const Unit& u, int wr, int wc, int fr, int fq) const {
        const int row0 = u.pm * BM + wr * 64 + fr, col0 = u.pn * BM + wc * 32 + 8 * fq;
        const float* gp = gate + (size_t)(u.pm >> 5) * ADAW + col0;
        f32x4 gv[2][2];
#pragma unroll
        for (int bj = 0; bj < 2; ++bj)
#pragma unroll
            for (int n = 0; n < 2; ++n) gv[bj][n] = *(const f32x4*)(gp + bj * HALF + n * 4);
#pragma unroll
        for (int ai = 0; ai < 2; ++ai)
#pragma unroll
            for (int m = 0; m < 4; ++m) {
                const int row = row0 + ai * HALF + m * 16;
                const size_t ro = (size_t)row * DM + col0;
#pragma unroll
                for (int bj = 0; bj < 2; ++bj) {
                    const h16x8 xi = *(const h16x8*)(xin + ro + bj * HALF);
                    const f32x4 x0 = (f32x4){(float)xi[0], (float)xi[1], (float)xi[2], (float)xi[3]} + gv[bj][0] * acc[ai][bj][m][0], x1 = (f32x4){(float)xi[4], (float)xi[5], (float)xi[6], (float)xi[7]} + gv[bj][1] * acc[ai][bj][m][1];
                    if (out32) { *(f32x4*)(xout32 + ro + bj * HALF) = x0; *(f32x4*)(xout32 + ro + bj * HALF + 4) = x1; }
                    else { u32x4 w; w.x = cvt_pk_h(x0[0], x0[1]); w.y = cvt_pk_h(x0[2], x0[3]); w.z = cvt_pk_h(x1[0], x1[1]); w.w = cvt_pk_h(x1[2], x1[3]); *(u32x4*)(xout16 + ro + bj * HALF) = w; }
                }
            }
    }
};
struct EpiResidQ {
    static constexpr bool PERM = true, AFTER_DRAIN = false;
    const u16* xin; u16* xout16; float* xout32; const float* gate; const float* rfo; const float* tqo; int out32;
    __device__ __forceinline__ void operator()(const f32x4 (&acc)[2][2][4][2], const Unit& u, int wr, int wc, int fr, int fq) const {
        const int row0 = u.pm * BM + wr * 64 + fr, col0 = u.pn * BM + wc * 32 + 8 * fq;
        const float* gp = gate + (size_t)(u.pm >> 5) * ADAW + col0;
        f32x4 gv[2][2];
#pragma unroll
        for (int bj = 0; bj < 2; ++bj)
#pragma unroll
            for (int n = 0; n < 2; ++n) gv[bj][n] = *(const f32x4*)(gp + bj * HALF + n * 4) * *(const f32x4*)(tqo + col0 + bj * HALF + n * 4);
#pragma unroll
        for (int ai = 0; ai < 2; ++ai)
#pragma unroll
            for (int m = 0; m < 4; ++m) {
                const int row = row0 + ai * HALF + m * 16; const float rs = rfo ? rfo[row] : 1.0f;
                const size_t ro = (size_t)row * DM + col0;
#pragma unroll
                for (int bj = 0; bj < 2; ++bj) {
                    const h16x8 xi = *(const h16x8*)(xin + ro + bj * HALF);
                    const f32x4 x0 = (f32x4){(float)xi[0], (float)xi[1], (float)xi[2], (float)xi[3]} + gv[bj][0] * (acc[ai][bj][m][0] * rs), x1 = (f32x4){(float)xi[4], (float)xi[5], (float)xi[6], (float)xi[7]} + gv[bj][1] * (acc[ai][bj][m][1] * rs);
                    if (out32) { *(f32x4*)(xout32 + ro + bj * HALF) = x0; *(f32x4*)(xout32 + ro + bj * HALF + 4) = x1; }
                    else { u32x4 w; w.x = cvt_pk_h(x0[0], x0[1]); w.y = cvt_pk_h(x0[2], x0[3]); w.z = cvt_pk_h(x1[0], x1[1]); w.w = cvt_pk_h(x1[2], x1[3]); *(u32x4*)(xout16 + ro + bj * HALF) = w; }
                }
            }
    }
};
struct EpiF16 {
    static constexpr bool PERM = true, AFTER_DRAIN = false;
    u16* O; int ldc; RowCol rc;
    __device__ __forceinline__ void operator()(const f32x4 (&acc)[2][2][4][2], const Unit& u, int wr, int wc, int fr, int fq) const {
        const int row0 = u.pm * BM + wr * 64 + fr, col0 = u.pn * BM + wc * 32 + 8 * fq;
        const float* bp = rc.bias + (size_t)(u.pm >> 5) * rc.bstride + col0;
        f32x4 bv[2][2];
#pragma unroll
        for (int bj = 0; bj < 2; ++bj)
#pragma unroll
            for (int n = 0; n < 2; ++n) bv[bj][n] = *(const f32x4*)(bp + bj * HALF + n * 4);
#pragma unroll
        for (int ai = 0; ai < 2; ++ai)
#pragma unroll
            for (int m = 0; m < 4; ++m) {
                const int row = row0 + ai * HALF + m * 16; const float rs = rstd_of(rc.ssq, row);
                u16* rowp = O + (size_t)row * ldc + col0;
#pragma unroll
                for (int bj = 0; bj < 2; ++bj) {
                    const f32x4 v0 = acc[ai][bj][m][0] * rs + bv[bj][0], v1 = acc[ai][bj][m][1] * rs + bv[bj][1];
                    u32x4 w; w.x = cvt_pk_h(v0[0], v0[1]); w.y = cvt_pk_h(v0[2], v0[3]); w.z = cvt_pk_h(v1[0], v1[1]); w.w = cvt_pk_h(v1[2], v1[3]);
                    *(u32x4*)(rowp + bj * HALF) = w;
                }
            }
    }
};

struct EpiF16Q {
    static constexpr bool PERM = true, AFTER_DRAIN = false;
    u16* O; int ldc; const float* rf; const float* tq; const float* bias; int bstride;
    __device__ __forceinline__ void operator()(const f32x4 (&acc)[2][2][4][2], const Unit& u, int wr, int wc, int fr, int fq) const {
        const int row0 = u.pm * BM + wr * 64 + fr, col0 = u.pn * BM + wc * 32 + 8 * fq;
        const float* bp = bias + (size_t)(u.pm >> 5) * bstride + col0;
        f32x4 bv[2][2], tv[2][2];
#pragma unroll
        for (int bj = 0; bj < 2; ++bj)
#pragma unroll
            for (int n = 0; n < 2; ++n) { bv[bj][n] = *(const f32x4*)(bp + bj * HALF + n * 4); tv[bj][n] = *(const f32x4*)(tq + col0 + bj * HALF + n * 4); }
#pragma unroll
        for (int ai = 0; ai < 2; ++ai)
#pragma unroll
            for (int m = 0; m < 4; ++m) {
                const int row = row0 + ai * HALF + m * 16; const float rs = rf[row];
                u16* rowp = O + (size_t)row * ldc + col0;
#pragma unroll
                for (int bj = 0; bj < 2; ++bj) {
                    const f32x4 v0 = (acc[ai][bj][m][0] * rs) * tv[bj][0] + bv[bj][0], v1 = (acc[ai][bj][m][1] * rs) * tv[bj][1] + bv[bj][1];
                    u32x4 w; w.x = cvt_pk_h(v0[0], v0[1]); w.y = cvt_pk_h(v0[2], v0[3]); w.z = cvt_pk_h(v1[0], v1[1]); w.w = cvt_pk_h(v1[2], v1[3]);
                    *(u32x4*)(rowp + bj * HALF) = w;
                }
            }
    }
};

struct EpiQkvA {
    static constexpr bool PERM = true, AFTER_DRAIN = false;
    u16* Qh; u16* Kh; u16* Vh; RowCol rc; const float* tq; const float* qgain; const float* kgain; const float* cost; const float* sint; PG8_LAS float* xch;
    __device__ __forceinline__ void operator()(const f32x4 (&acc)[2][2][4][2], const Unit& u, int wr, int wc, int fr, int fq) const {
        const int row0 = u.pm * BM + wr * 64 + fr, b = u.pm >> 5;
        {
            f32x4 (&a)[2][2][4][2] = const_cast<f32x4 (&)[2][2][4][2]>(acc);
            const float* tp = tq + u.pn * BM + wc * 32 + 8 * fq;
#pragma unroll
            for (int bj = 0; bj < 2; ++bj)
#pragma unroll
                for (int n = 0; n < 2; ++n) { const f32x4 tv = *(const f32x4*)(tp + bj * HALF + n * 4);
#pragma unroll
                    for (int ai = 0; ai < 2; ++ai)
#pragma unroll
                        for (int m = 0; m < 4; ++m) a[ai][bj][m][n] = a[ai][bj][m][n] * tv; }
        }
        const float* bp = rc.bias + (size_t)b * rc.bstride + u.pn * BM + wc * 32 + 8 * fq;
        f32x4 bv[2][2];
#pragma unroll
        for (int bj = 0; bj < 2; ++bj)
#pragma unroll
            for (int n = 0; n < 2; ++n) bv[bj][n] = *(const f32x4*)(bp + bj * HALF + n * 4);
        if (u.pn >= 16) {
#pragma unroll
            for (int ai = 0; ai < 2; ++ai)
#pragma unroll
                for (int m = 0; m < 4; ++m) {
                    const int row = row0 + ai * HALF + m * 16, t = row & (SEQ - 1); const float rs = rc.ssq[row];
#pragma unroll
                    for (int bj = 0; bj < 2; ++bj) {
                        const f32x4 v0 = acc[ai][bj][m][0] * rs + bv[bj][0], v1 = acc[ai][bj][m][1] * rs + bv[bj][1];
                        u32x4 w; w.x = cvt_pk_h(v0[0], v0[1]); w.y = cvt_pk_h(v0[2], v0[3]); w.z = cvt_pk_h(v1[0], v1[1]); w.w = cvt_pk_h(v1[2], v1[3]);
                        *(u32x4*)(Vh + ((size_t)(b * 16 + 2 * (u.pn - 16) + bj) * SEQ + t) * 128 + wc * 32 + 8 * fq) = w;
                    }
                }
            return;
        }
        int frx = fr; asm volatile("" : "+v"(frx));
        const int wid = wr * 4 + wc, dlo = 32 * (wc & 1) + 8 * fq;
        const float* gp = (u.pn < 8 ? qgain : kgain) + dlo;
        f32x4 gn[2][2];
#pragma unroll
        for (int bj = 0; bj < 2; ++bj)
#pragma unroll
            for (int n = 0; n < 2; ++n) gn[bj][n] = *(const f32x4*)(gp + 64 * bj + 4 * n);
#pragma unroll
        for (int ai = 0; ai < 2; ++ai)
#pragma unroll
            for (int m = 0; m < 4; ++m) {
                const int row = row0 + ai * HALF + m * 16; const float rs = rc.ssq[row];
                float ss = 0.f;
#pragma unroll
                for (int bj = 0; bj < 2; ++bj)
#pragma unroll
                    for (int n = 0; n < 2; ++n) { const f32x4 v = acc[ai][bj][m][n] * rs + bv[bj][n]; ss += (v[0] * v[0] + v[1] * v[1]) + (v[2] * v[2] + v[3] * v[3]); }
                ss += swz_xor<16>(ss); ss = add_xor32(ss);
                if (fq == 0) xch[wid * 128 + ai * 64 + m * 16 + frx] = ss;
            }
        asm volatile("s_waitcnt lgkmcnt(0)" ::: "memory"); __builtin_amdgcn_s_barrier(); asm volatile("" ::: "memory");
        u16* dstb = (u.pn < 8 ? Qh : Kh) + ((size_t)(b * 16 + 2 * (u.pn & 7) + (wc >> 1)) * SEQ) * 128 + dlo;
#pragma unroll
        for (int ai = 0; ai < 2; ++ai)
#pragma unroll
            for (int m = 0; m < 4; ++m) {
                const int rl = ai * 64 + m * 16 + frx, row = row0 + ai * HALF + m * 16, t = row & (SEQ - 1);
                const float tot = xch[wid * 128 + rl] + xch[(wid ^ 1) * 128 + rl];
                const float rs = rc.ssq[row], rn = rsqrtf(tot * (1.0f / 128.0f) + NORM_EPS);
                const f32x4 c0 = *(const f32x4*)(cost + t * 64 + dlo), c1 = *(const f32x4*)(cost + t * 64 + dlo + 4), s0 = *(const f32x4*)(sint + t * 64 + dlo), s1 = *(const f32x4*)(sint + t * 64 + dlo + 4);
                const f32x4 a0 = (acc[ai][0][m][0] * rs + bv[0][0]) * rn * gn[0][0], a1 = (acc[ai][0][m][1] * rs + bv[0][1]) * rn * gn[0][1], b0 = (acc[ai][1][m][0] * rs + bv[1][0]) * rn * gn[1][0], b1 = (acc[ai][1][m][1] * rs + bv[1][1]) * rn * gn[1][1];
                const f32x4 lo0 = a0 * c0 - b0 * s0, lo1 = a1 * c1 - b1 * s1, hi0 = b0 * c0 + a0 * s0, hi1 = b1 * c1 + a1 * s1;
                u16* dp = dstb + (size_t)t * 128;
                u32x4 w; w.x = cvt_pk_h(lo0[0], lo0[1]); w.y = cvt_pk_h(lo0[2], lo0[3]); w.z = cvt_pk_h(lo1[0], lo1[1]); w.w = cvt_pk_h(lo1[2], lo1[3]);
                *(u32x4*)dp = w;
                w.x = cvt_pk_h(hi0[0], hi0[1]); w.y = cvt_pk_h(hi0[2], hi0[3]); w.z = cvt_pk_h(hi1[0], hi1[1]); w.w = cvt_pk_h(hi1[2], hi1[3]);
                *(u32x4*)(dp + 64) = w;
            }
        asm volatile("s_waitcnt lgkmcnt(0)" ::: "memory"); __builtin_amdgcn_s_barrier(); asm volatile("" ::: "memory");
    }
};
typedef int i32x8 __attribute__((ext_vector_type(8)));
__device__ __forceinline__ void mfma_f8_tied(f32x4& c, i32x8 a, i32x8 b) { asm volatile("v_mfma_f32_16x16x128_f8f6f4 %0, %1, %2, %0" : "+v"(c) : "v"(a), "v"(b)); }
template <class Epi, class Sched, bool ALIGN_EPI = false, bool SP2 = false, int I8 = 0>
__device__ __forceinline__ void gemm_phase(PG8_LAS unsigned char* lds, const Gemm g, const Sched& S, const Epi& E) {
    const int tid = opaque_tid(), wid = __builtin_amdgcn_readfirstlane(tid >> 6), lane = tid & 63, wr = wid >> 2, wc = wid & 3, fr = lane & 15, fq = lane >> 4;
    const int K = g.K, nt = K / BK;
    unsigned voffA[2], voffB[2];
#pragma unroll
    for (int i = 0; i < 2; ++i) { int R, C; stage_rc(tid * 16 + i * 8192, R, C); const int Rb = Epi::PERM ? ((R & ~31) + perm32(R & 31)) : R;
        voffA[i] = (unsigned)(R * K + C) * 2u; voffB[i] = (unsigned)(Rb * K + C) * 2u; }
    const size_t kstep = (size_t)(BK * 2);
    const size_t hstep = (size_t)HALF * K * 2;
    const size_t tstep = 2 * hstep;
    const unsigned ldsw = (unsigned)wid * 1024u;
    const int aoff = lds_byte(wr * 64 + fr, fq * 8), boff = lds_byte(wc * 32 + fr, fq * 8);
#define PG8_SA(b, h) (((b) * 2 + (h)) * HTB)
#define PG8_SB(b, h) ((4 + (b) * 2 + (h)) * HTB)
#define PG8_STAGE(bufoff, gbase, voff) do { _Pragma("unroll") for (int _i = 0; _i < 2; ++_i) \
        __builtin_amdgcn_global_load_lds((const unsigned*)((const char*)(gbase) + (voff)[_i]), (PG8_LAS unsigned*)(lds + (bufoff) + ldsw + _i * 8192), 16, 0, 0); } while (0)
#define PG8_LDA(dst, b, h) do { _Pragma("unroll") for (int m = 0; m < 4; ++m) _Pragma("unroll") for (int k = 0; k < 2; ++k) dst[m][k] = *(const PG8_LAS bf16x8*)(lds + PG8_SA(b, h) + aoff + m * 2048 + k * 1024); } while (0)
#define PG8_LDB(dst, b, h) do { _Pragma("unroll") for (int n = 0; n < 2; ++n) _Pragma("unroll") for (int k = 0; k < 2; ++k) dst[n][k] = *(const PG8_LAS bf16x8*)(lds + PG8_SB(b, h) + boff + n * 2048 + k * 1024); } while (0)
#define PG8_MMA(ai, bj, At, Bt) do { __builtin_amdgcn_s_setprio(1); _Pragma("unroll") for (int m = 0; m < 4; ++m) _Pragma("unroll") for (int n = 0; n < 2; ++n) _Pragma("unroll") for (int k = 0; k < (I8 == 2 ? 1 : 2); ++k) { \
        if constexpr (I8 == 2) mfma_f8_tied(acc[ai][bj][m][n], __builtin_shufflevector(__builtin_bit_cast(i32x4, Bt[n][0]), __builtin_bit_cast(i32x4, Bt[n][1]), 0, 1, 2, 3, 4, 5, 6, 7), \
                __builtin_shufflevector(__builtin_bit_cast(i32x4, At[m][0]), __builtin_bit_cast(i32x4, At[m][1]), 0, 1, 2, 3, 4, 5, 6, 7)); \
        else if constexpr (I8 == 1) acc[ai][bj][m][n] = __builtin_bit_cast(f32x4, __builtin_amdgcn_mfma_i32_16x16x64_i8(__builtin_bit_cast(i32x4, Bt[n][k]), __builtin_bit_cast(i32x4, At[m][k]), __builtin_bit_cast(i32x4, acc[ai][bj][m][n]), 0, 0, 0)); \
        else acc[ai][bj][m][n] = __builtin_amdgcn_mfma_f32_16x16x32_f16(__builtin_bit_cast(h16x8, Bt[n][k]), __builtin_bit_cast(h16x8, At[m][k]), acc[ai][bj][m][n], 0, 0, 0); } __builtin_amdgcn_s_setprio(0); } while (0)
#define PG8_WAIT_V(n) asm volatile("s_waitcnt vmcnt(" #n ")" ::: "memory")
#define PG8_WAIT_L(n) asm volatile("s_waitcnt lgkmcnt(" #n ")" ::: "memory")
#define PG8_BAR __builtin_amdgcn_s_barrier()
#define PG8_SCHED __builtin_amdgcn_sched_barrier(0)
    Unit cur, nxt; int ui = 0;
    if (!S.next(0, cur)) return;
    f32x4 acc[2][2][4][2];
#pragma unroll
    for (int a = 0; a < 2; ++a)
#pragma unroll
        for (int b = 0; b < 2; ++b)
#pragma unroll
            for (int m = 0; m < 4; ++m)
#pragma unroll
                for (int n = 0; n < 2; ++n) acc[a][b][m][n] = (f32x4){0.f, 0.f, 0.f, 0.f};
    bf16x8 At[4][2], B0[2][2], B1[2][2];
    const char* cA = (const char*)g.A + (size_t)cur.pm * tstep; const char* cB = (const char*)g.Bt + (size_t)cur.pn * tstep;
    S.a_ready(cur);
    if constexpr (SP2) {
        PG8_STAGE(PG8_SB(0, 0), cB, voffB); PG8_STAGE(PG8_SB(0, 1), cB + hstep, voffB); PG8_STAGE(PG8_SA(0, 0), cA, voffA); PG8_STAGE(PG8_SA(0, 1), cA + hstep, voffA);
        if (wr == 1) PG8_BAR;
        PG8_WAIT_V(2); PG8_BAR;
        PG8_STAGE(PG8_SB(1, 0), cB + kstep, voffB); PG8_STAGE(PG8_SA(1, 0), cA + kstep, voffA); PG8_STAGE(PG8_SB(1, 1), cB + hstep + kstep, voffB);
        PG8_WAIT_V(6); PG8_BAR;
    } else {
        PG8_STAGE(PG8_SB(0, 0), cB, voffB); PG8_STAGE(PG8_SA(0, 0), cA, voffA); PG8_STAGE(PG8_SB(0, 1), cB + hstep, voffB); PG8_STAGE(PG8_SA(0, 1), cA + hstep, voffA);
        if (wr == 1) PG8_BAR;
        PG8_WAIT_V(4); PG8_BAR;
        PG8_STAGE(PG8_SB(1, 0), cB + kstep, voffB); PG8_STAGE(PG8_SA(1, 0), cA + kstep, voffA); PG8_STAGE(PG8_SB(1, 1), cB + hstep + kstep, voffB);
        PG8_WAIT_V(6); PG8_BAR;
    }
    for (;;) {
        const bool has_next = S.next(ui + 1, nxt);
        const char* nA = has_next ? (const char*)g.A + (size_t)nxt.pm * tstep : cA; const char* nB = has_next ? (const char*)g.Bt + (size_t)nxt.pn * tstep : cB;
        for (int t = 0; t < nt; t += 2) {
            const bool last = (t == nt - 2);
            const char* a1 = cA + (size_t)(t + 1) * kstep;
            const char* a2 = last ? nA : cA + (size_t)(t + 2) * kstep; const char* b2 = last ? nB : cB + (size_t)(t + 2) * kstep;
            const char* a3 = a2 + kstep; const char* b3 = b2 + kstep;
            if (last && has_next) S.a_ready(nxt);
            if constexpr (SP2) {
            PG8_LDB(B0, 0, 0); PG8_LDB(B1, 0, 1); PG8_SCHED; PG8_LDA(At, 0, 0); PG8_STAGE(PG8_SA(1, 1), a1 + hstep, voffA);
            PG8_WAIT_V(8); PG8_WAIT_L(0); PG8_BAR; PG8_MMA(0, 0, At, B0); PG8_MMA(0, 1, At, B1); PG8_BAR; PG8_SCHED;
            PG8_LDA(At, 0, 1); PG8_STAGE(PG8_SB(0, 0), b2, voffB); PG8_STAGE(PG8_SB(0, 1), b2 + hstep, voffB); PG8_STAGE(PG8_SA(0, 0), a2, voffA);
            PG8_WAIT_V(8); PG8_WAIT_L(0); PG8_BAR; PG8_MMA(1, 0, At, B0); PG8_MMA(1, 1, At, B1); PG8_BAR; PG8_SCHED;
            PG8_LDB(B0, 1, 0); PG8_LDB(B1, 1, 1); PG8_SCHED; PG8_LDA(At, 1, 0); PG8_STAGE(PG8_SA(0, 1), a2 + hstep, voffA);
            PG8_WAIT_V(8); PG8_WAIT_L(0); PG8_BAR; PG8_MMA(0, 0, At, B0); PG8_MMA(0, 1, At, B1); PG8_BAR; PG8_SCHED;
            PG8_LDA(At, 1, 1); PG8_STAGE(PG8_SB(1, 0), b3, voffB); PG8_STAGE(PG8_SB(1, 1), b3 + hstep, voffB); PG8_STAGE(PG8_SA(1, 0), a3, voffA);
            PG8_WAIT_V(8); PG8_WAIT_L(0); PG8_BAR; PG8_MMA(1, 0, At, B0); PG8_MMA(1, 1, At, B1); PG8_BAR; PG8_SCHED;
            } else {
            PG8_LDB(B0, 0, 0); PG8_SCHED; PG8_LDA(At, 0, 0); PG8_STAGE(PG8_SA(1, 1), a1 + hstep, voffA);
            PG8_WAIT_L(8); PG8_BAR; PG8_WAIT_L(0); PG8_MMA(0, 0, At, B0); PG8_BAR; PG8_SCHED;
            PG8_LDB(B1, 0, 1); PG8_STAGE(PG8_SB(0, 0), b2, voffB);
            PG8_BAR; PG8_WAIT_L(0); PG8_MMA(0, 1, At, B1); PG8_BAR;
            PG8_LDA(At, 0, 1); PG8_STAGE(PG8_SA(0, 0), a2, voffA);
            PG8_BAR; PG8_WAIT_L(0); PG8_MMA(1, 0, At, B0); PG8_BAR; PG8_SCHED;
            PG8_STAGE(PG8_SB(0, 1), b2 + hstep, voffB);
            PG8_WAIT_V(6); PG8_BAR; PG8_MMA(1, 1, At, B1); PG8_BAR;
            PG8_LDB(B0, 1, 0); PG8_SCHED; PG8_LDA(At, 1, 0); PG8_STAGE(PG8_SA(0, 1), a2 + hstep, voffA);
            PG8_WAIT_L(8); PG8_BAR; PG8_WAIT_L(0); PG8_MMA(0, 0, At, B0); PG8_BAR; PG8_SCHED;
            PG8_LDB(B1, 1, 1); PG8_STAGE(PG8_SB(1, 0), b3, voffB);
            PG8_BAR; PG8_WAIT_L(0); PG8_MMA(0, 1, At, B1); PG8_BAR;
            PG8_LDA(At, 1, 1); PG8_STAGE(PG8_SA(1, 0), a3, voffA);
            PG8_BAR; PG8_WAIT_L(0); PG8_MMA(1, 0, At, B0); PG8_BAR; PG8_SCHED;
            PG8_STAGE(PG8_SB(1, 1), b3 + hstep, voffB);
            PG8_WAIT_V(6); PG8_BAR; PG8_MMA(1, 1, At, B1); PG8_BAR;
            }
        }
        if constexpr (ALIGN_EPI) { if (wr == 0) PG8_BAR; }
        if constexpr (I8 == 2) asm volatile("s_nop 15\n\ts_nop 15" ::: "memory");
        if constexpr (I8 == 1) {
#pragma unroll
            for (int a = 0; a < 2; ++a)
#pragma unroll
                for (int b = 0; b < 2; ++b)
#pragma unroll
                    for (int m = 0; m < 4; ++m)
#pragma unroll
                        for (int n = 0; n < 2; ++n) { const i32x4 iv = __builtin_bit_cast(i32x4, acc[a][b][m][n]); acc[a][b][m][n] = (f32x4){(float)iv[0], (float)iv[1], (float)iv[2], (float)iv[3]}; }
        }
        if constexpr (!Epi::AFTER_DRAIN) { E(acc, cur, wr, wc, fr, fq); S.done(cur); }
        if (!has_next) break;
#pragma unroll
        for (int a = 0; a < 2; ++a)
#pragma unroll
            for (int b = 0; b < 2; ++b)
#pragma unroll
                for (int m = 0; m < 4; ++m)
#pragma unroll
                    for (int n = 0; n < 2; ++n) acc[a][b][m][n] = (f32x4){0.f, 0.f, 0.f, 0.f};
        cur = nxt; cA = nA; cB = nB; ++ui;
        if constexpr (ALIGN_EPI) { if (wr == 1) PG8_BAR; }
    }
    PG8_WAIT_V(0);
    if constexpr (!ALIGN_EPI) { if (wr == 0) PG8_BAR; }
    PG8_BAR;
    if constexpr (Epi::AFTER_DRAIN) { E.fused(acc, cur, wr, wc, fr, fq, lds, wid, lane); S.done(cur); }
#undef PG8_SA
#undef PG8_SB
#undef PG8_STAGE
#undef PG8_LDA
#undef PG8_LDB
#undef PG8_MMA
#undef PG8_WAIT_V
#undef PG8_WAIT_L
#undef PG8_BAR
#undef PG8_SCHED
}
}

namespace att {
typedef short bf16x8 __attribute__((ext_vector_type(8)));
typedef short s16x4 __attribute__((ext_vector_type(4)));
typedef float f32x16 __attribute__((ext_vector_type(16)));
typedef float f32x4 __attribute__((ext_vector_type(4)));
typedef unsigned u32x4 __attribute__((ext_vector_type(4)));
template <class A, class Bt> struct same_t { static constexpr bool v = false; };
template <class A> struct same_t<A, A> { static constexpr bool v = true; };
constexpr int D = 128;
constexpr float THR = 8.f;
constexpr bool WSKIP = false;
constexpr float SCALE = 0.08838834764831845f;
constexpr int NW = 8, QBLK = 32, KVBLK = 64, QB = NW * QBLK;
constexpr int SHM_V = KVBLK * D * 2, SHM_K = KVBLK * D * 2;
constexpr int LDS_BYTES = 2 * SHM_V + 2 * SHM_K + NW * 64 * 4;
__device__ __forceinline__ f32x16 mfma32h(bf16x8 a, bf16x8 b, f32x16 c, int, int, int) {
    return __builtin_amdgcn_mfma_f32_32x32x16_f16(__builtin_bit_cast(h16x8, a), __builtin_bit_cast(h16x8, b), c, 0, 0, 0);
}
#define KSWZ(row, colB) ((row) * 256 + ((colB) ^ (((row) & 7) << 4)))
#define SBAR() __builtin_amdgcn_sched_barrier(0)
__device__ __forceinline__ int v_st(int k, int c) { const int kk = (k & ~0xC) | ((k & 4) << 1) | ((k & 8) >> 1); return ((kk >> 3) * 4 + (c >> 5)) * 512 + ((kk & 7) * 32 + (c & 31)) * 2; }
__device__ __forceinline__ int v_rd_base(int lane) { return ((lane & 3) << 3) | (((lane >> 2) & 3) << 6) | (((lane >> 4) & 1) << 5) | (((lane >> 5) & 1) << 8); }
constexpr int v_rd_off(int d0, int ks, int half) { return d0 * 512 + ks * 4096 + half * 2048; }
__device__ __forceinline__ int crow(int r, int hi) { return (r & 3) + 8 * (r >> 2) + 4 * hi; }
__device__ __forceinline__ unsigned cvtpk(float lo, float hi) {
    unsigned r; asm volatile("v_cvt_pk_f16_f32 %0, %1, %2" : "=v"(r) : "v"(lo), "v"(hi)); return r;
}
__device__ __forceinline__ bf16x8 pack8(f32x4 a, f32x4 b) {
    u32x4 w = {cvtpk(a[0], a[1]), cvtpk(a[2], a[3]), cvtpk(b[0], b[1]), cvtpk(b[2], b[3])};
    return *reinterpret_cast<bf16x8*>(&w);
}
template <class T> __device__ __forceinline__ bf16x8 load8(const T* p) {
    if constexpr (same_t<T, float>::v) { return pack8(*(const f32x4*)p, *(const f32x4*)(p + 4)); }
    else { return *reinterpret_cast<const bf16x8*>(p); }
}
__device__ __forceinline__ void mask_tile(f32x16& p0, f32x16& p1, int dq, unsigned W) {
    const float NEG = -__builtin_inff();
#pragma unroll
    for (int r = 0; r < 16; ++r) {
        const int c = (r & 3) + 8 * (r >> 2);
        if ((unsigned)(dq - c) >= W) p0[r] = NEG;
        if ((unsigned)(dq - c - 32) >= W) p1[r] = NEG;
    }
}
__device__ __forceinline__ void partialSM(f32x16& p0, f32x16& p1, float& m_reg, float& mn, float& alpha) {
    float pmax = p0[0]; for (int r = 1; r < 16; ++r) pmax = fmaxf(pmax, p0[r]); for (int r = 0; r < 16; ++r) pmax = fmaxf(pmax, p1[r]);
    { auto rr = __builtin_amdgcn_permlane32_swap(__float_as_uint(pmax), __float_as_uint(pmax), false, false);
      pmax = fmaxf(__uint_as_float(rr[0]), __uint_as_float(rr[1])); }
    constexpr float C2 = 1.4426950408889634f * SCALE;
    if (__builtin_expect(__all((pmax - m_reg) * SCALE <= THR), 1)) { mn = m_reg; alpha = 1.f; }
    else { mn = fmaxf(m_reg, pmax); alpha = __builtin_amdgcn_exp2f((m_reg - mn) * C2); m_reg = mn; }
    const float mnL = -mn * C2;
    for (int r = 0; r < 16; ++r) p0[r] = fmaf(p0[r], C2, mnL); for (int r = 0; r < 16; ++r) p1[r] = fmaf(p1[r], C2, mnL);
    for (int r = 0; r < 16; ++r) p0[r] = __builtin_amdgcn_exp2f(p0[r]);
}
__device__ __forceinline__ void finishSM(f32x16& p0, f32x16& p1, float alpha, float& l_reg, bf16x8& pa0, bf16x8& pa1, bf16x8& pa2, bf16x8& pa3) {
    for (int r = 0; r < 16; ++r) p1[r] = __builtin_amdgcn_exp2f(p1[r]);
    float ps = 0; for (int r = 0; r < 16; ++r) ps += p0[r]; for (int r = 0; r < 16; ++r) ps += p1[r];
    { auto rr = __builtin_amdgcn_permlane32_swap(__float_as_uint(ps), __float_as_uint(ps), false, false);
      ps = __uint_as_float(rr[0]) + __uint_as_float(rr[1]); }
    l_reg = l_reg * alpha + ps;
#define PK4(P, B_, OUT) do { unsigned a0 = cvtpk(P[B_+0], P[B_+1]), a1 = cvtpk(P[B_+2], P[B_+3]);                          \
        unsigned b0 = cvtpk(P[B_+4], P[B_+5]), b1 = cvtpk(P[B_+6], P[B_+7]);                                             \
        auto r0 = __builtin_amdgcn_permlane32_swap(a0, b0, false, false); auto r1 = __builtin_amdgcn_permlane32_swap(a1, b1, false, false); \
        u32x4 w = {r0[0], r1[0], r0[1], r1[1]}; OUT = *reinterpret_cast<bf16x8*>(&w); } while (0)
    PK4(p0, 0, pa0); PK4(p0, 8, pa1); PK4(p1, 0, pa2); PK4(p1, 8, pa3);
#undef PK4
}
template <int KB, bool SK>
__device__ __forceinline__ void qkt(f32x16& p0, f32x16& p1, const char* K_lds, int r32, int hi, const bf16x8* qr, bool act) {
    if (SK && !act) { const float NEG = -__builtin_inff();
#pragma unroll
        for (int r = 0; r < 16; ++r) { p0[r] = NEG; p1[r] = NEG; } return; }
    p0 = f32x16{}; p1 = f32x16{};
    const char* kb[4];
#pragma unroll
    for (int dd = 0; dd < 4; ++dd) kb[dd] = K_lds + KB * SHM_K + KSWZ(r32, (dd * 16 + hi * 8) * 2);
#pragma unroll
    for (int d0 = 0; d0 < 8; ++d0) { const char* a = kb[d0 & 3] + (d0 >> 2) * 128;
        bf16x8 b0 = *reinterpret_cast<const bf16x8*>(a);
        bf16x8 b1 = *reinterpret_cast<const bf16x8*>(a + 32 * 256);
        p0 = mfma32h(b0, qr[d0], p0, 0, 0, 0);
        p1 = mfma32h(b1, qr[d0], p1, 0, 0, 0); }
}
template <int VB, bool SK>
__device__ __forceinline__ void pv_tile(f32x16* o, int vb0, bf16x8 pa0, bf16x8 pa1, bf16x8 pa2, bf16x8 pa3, bool act) {
    if (SK && !act) return;
#define TRRD(dst, off) asm volatile("ds_read_b64_tr_b16 %0, %1 offset:%2" : "=&v"(dst) : "v"(vb0), "i"(off) : "memory")
#define PV_D0(d0) do { s16x4 l0, l1, l2, l3, h0, h1, h2, h3; constexpr int b_ = VB * SHM_V + v_rd_off(d0, 0, 0);     \
        TRRD(l0, b_); TRRD(h0, b_ + 2048); TRRD(l1, b_ + 4096); TRRD(h1, b_ + 6144); TRRD(l2, b_ + 8192); TRRD(h2, b_ + 10240); TRRD(l3, b_ + 12288); TRRD(h3, b_ + 14336); \
        asm volatile("s_waitcnt lgkmcnt(0)" ::: "memory"); SBAR();                 \
        o[d0] = mfma32h(pa0, (bf16x8){l0[0], l0[1], l0[2], l0[3], h0[0], h0[1], h0[2], h0[3]}, o[d0], 0, 0, 0);   \
        o[d0] = mfma32h(pa1, (bf16x8){l1[0], l1[1], l1[2], l1[3], h1[0], h1[1], h1[2], h1[3]}, o[d0], 0, 0, 0);   \
        o[d0] = mfma32h(pa2, (bf16x8){l2[0], l2[1], l2[2], l2[3], h2[0], h2[1], h2[2], h2[3]}, o[d0], 0, 0, 0);   \
        o[d0] = mfma32h(pa3, (bf16x8){l3[0], l3[1], l3[2], l3[3], h3[0], h3[1], h3[2], h3[3]}, o[d0], 0, 0, 0); } while (0)
    PV_D0(0); PV_D0(1); PV_D0(2); PV_D0(3);
#undef PV_D0
#undef TRRD
}

template <class TIn, class TOut> struct BlockRef { const TIn* Q; const TIn* K; const TIn* V; TOut* O; int P0; };
template <class TIn> struct Seam {
    bf16x8 qr[8];
    bf16x8 st_v0, st_v1, st_k0, st_k1; f32x4 sf0, sf1, sf2, sf3;
    f32x4 tq[16];
};
__device__ __forceinline__ int swa_jlo(int P0, int W) { const int lowk = P0 - W + 1; return lowk > 0 ? lowk / KVBLK : 0; }
#define ROW(p, k0, rr) ((p) + (size_t)((k0) + (rr)) * D + sc)
#define VMW() asm volatile("s_waitcnt vmcnt(0)" ::: "memory")
#define VMWN(n) asm volatile("s_waitcnt vmcnt(%0)" :: "i"(n) : "memory")
#define SLOAD_H(Kp, Vp, k0) do { S.st_v0 = load8<TIn>(ROW(Vp, k0, sr)); S.st_v1 = load8<TIn>(ROW(Vp, k0, 32 + sr));              \
                         S.st_k0 = load8<TIn>(ROW(Kp, k0, sr)); S.st_k1 = load8<TIn>(ROW(Kp, k0, 32 + sr)); } while (0)
#define SWRITE_HK(bf) do { *(bf16x8*)(K_lds + (bf) * SHM_K + kws) = S.st_k0; *(bf16x8*)(K_lds + (bf) * SHM_K + kws + 32 * 256) = S.st_k1; } while (0)
#define SWRITE_HV(bf) do { *(bf16x8*)(V_lds + (bf) * SHM_V + vst0) = S.st_v0; *(bf16x8*)(V_lds + (bf) * SHM_V + vst1) = S.st_v1; } while (0)
#define SWRITE_H(bf) do { SWRITE_HV(bf); SWRITE_HK(bf); } while (0)
#define SLOAD_F(p, k0) do { S.sf0 = *(const f32x4*)ROW(p, k0, sr); S.sf1 = *(const f32x4*)(ROW(p, k0, sr) + 4);                \
                            S.sf2 = *(const f32x4*)ROW(p, k0, 32 + sr); S.sf3 = *(const f32x4*)(ROW(p, k0, 32 + sr) + 4); } while (0)
#define SWRITE_KF(bf) do { *(bf16x8*)(K_lds + (bf) * SHM_K + kws) = pack8(S.sf0, S.sf1); *(bf16x8*)(K_lds + (bf) * SHM_K + kws + 32 * 256) = pack8(S.sf2, S.sf3); } while (0)
#define SWRITE_VF(bf) do { *(bf16x8*)(V_lds + (bf) * SHM_V + vst0) = pack8(S.sf0, S.sf1); *(bf16x8*)(V_lds + (bf) * SHM_V + vst1) = pack8(S.sf2, S.sf3); } while (0)
template <class TIn, class TOut>
__device__ __forceinline__ void causal_swa_prime(const BlockRef<TIn, TOut>& cur, int W, char* lds, Seam<TIn>& S) {
    constexpr bool F32 = same_t<TIn, float>::v;
    const int tid = opaque_tid(), wid = __builtin_amdgcn_readfirstlane(tid >> 6), lane = tid & 63, r32 = lane & 31, hi = lane >> 5;
    const int sr = tid >> 4, sc = (tid & 15) * 8, kws = KSWZ(sr, sc * 2); char* K_lds = lds + 2 * SHM_V;
    const int kb0 = swa_jlo(cur.P0, W) * KVBLK;
    for (int d0 = 0; d0 < 8; ++d0) S.qr[d0] = load8<TIn>(cur.Q + (size_t)(wid * QBLK + r32) * D + d0 * 16 + hi * 8);
    if constexpr (F32) { SLOAD_F((const float*)cur.K, kb0); VMW(); SWRITE_KF(0); SBAR(); SLOAD_F((const float*)cur.V, kb0); }
    else { SLOAD_H(cur.K, cur.V, kb0); VMW(); SWRITE_HK(0); }
    __syncthreads();
}
template <class TIn, class TOut>
__device__ __forceinline__ void causal_swa_block(const BlockRef<TIn, TOut>& cur, const BlockRef<TIn, TOut>& nxt, int skv, int W, char* lds, Seam<TIn>& S) {
    constexpr bool F32 = same_t<TIn, float>::v;
    const int tid = opaque_tid(), wid = __builtin_amdgcn_readfirstlane(tid >> 6), lane = tid & 63, r32 = lane & 31, hi = lane >> 5;
    const int j_lo = swa_jlo(cur.P0, W);
    int j_hi = (cur.P0 + QB - 1) / KVBLK + 1; if (j_hi > skv / KVBLK) j_hi = skv / KVBLK;
    const int NT = j_hi - j_lo;
    const int kbn = swa_jlo(nxt.P0, W) * KVBLK;
    const int qlo = cur.P0 + wid * QBLK, qm = qlo + r32 - 4 * hi;
    char* V_lds = lds; char* K_lds = lds + 2 * SHM_V;
    float* ws = (float*)(lds + 2 * SHM_V + 2 * SHM_K) + wid * 64; float* li_l = ws, * al_l = ws + 32;
    float m_reg = -1e30f, l_reg = 0; f32x16 o[4] = {};
    const int sr = tid >> 4, sc = (tid & 15) * 8, vst0 = v_st(sr, sc), vst1 = v_st(32 + sr, sc), kws = KSWZ(sr, sc * 2);
    const int vb0 = (int)(uintptr_t)V_lds + v_rd_base(lane);
    const TIn* Kh = cur.K; const TIn* Vh = cur.V;
#define RESC(a) do { if (__any((a) < 1.f)) { if (hi == 0) al_l[r32] = (a); asm volatile("s_waitcnt lgkmcnt(0)" ::: "memory");              \
                     for (int d_ = 0; d_ < 4; ++d_) for (int r = 0; r < 16; ++r) o[d_][r] *= al_l[crow(r, hi)]; } } while (0)
#define KBASE(t) ((j_lo + (t)) * KVBLK)
#define ACT(t) (KBASE(t) <= qlo + QBLK - 1 && KBASE(t) + KVBLK - 1 >= qlo - W + 1)
#define MASKT(P0_, P1_, t) do { const int kb_ = KBASE(t); if ((!SK || ACT(t)) && (kb_ + KVBLK - 1 > qlo || kb_ <= qlo + QBLK - 1 - W)) mask_tile(P0_, P1_, qm - kb_, (unsigned)W); } while (0)
    constexpr int NQL = F32 ? 16 : 8;
    constexpr bool SK = WSKIP && !F32;
#define SEAM_K0() do { VMWN(NQL); if constexpr (F32) { SWRITE_KF(0); SBAR(); SLOAD_F((const float*)nxt.V, kbn); } else { SWRITE_HK(0); } SBAR(); } while (0)
    f32x16 pA0, pA1, pB0, pB1; float mnA, mnB, alA, alB; bf16x8 pa0, pa1, pa2, pa3;
    if constexpr (F32) { VMW(); SWRITE_VF(0); SBAR(); } else { SWRITE_HV(0); SBAR(); }
    if (NT > 1) { if constexpr (F32) SLOAD_F((const float*)Kh, KBASE(1)); else SLOAD_H(Kh, Vh, KBASE(1)); }
    SBAR(); qkt<0, SK>(pA0, pA1, K_lds, r32, hi, S.qr, ACT(0));
    if constexpr (F32) { if (NT > 1) { VMW(); SWRITE_KF(1); SBAR(); SLOAD_F((const float*)Vh, KBASE(1)); } }
    MASKT(pA0, pA1, 0); partialSM(pA0, pA1, m_reg, mnA, alA);
    if (NT > 1) { VMW(); if constexpr (F32) { SWRITE_VF(1); SBAR(); if (NT > 2) SLOAD_F((const float*)Kh, KBASE(2)); } else SWRITE_H(1); }
    __syncthreads();
#define HALF_STEP(PX0, PX1, mnX, alX, PY0, PY1, alY, t, KB, VB, SB) do {                                                      \
        SBAR(); qkt<KB, SK>(PX0, PX1, K_lds, r32, hi, S.qr, ACT(t));                                             \
        finishSM(PY0, PY1, alY, l_reg, pa0, pa1, pa2, pa3); SBAR();                                                           \
        if ((t) + 1 < NT) { if constexpr (F32) { VMW(); SWRITE_KF(SB); SBAR(); SLOAD_F((const float*)Vh, KBASE((t) + 1)); }  \
                            else { SLOAD_H(Kh, Vh, KBASE((t) + 1)); } SBAR(); }                                               \
        pv_tile<VB, SK>(o, vb0, pa0, pa1, pa2, pa3, ACT((t) - 1)); MASKT(PX0, PX1, (t)); partialSM(PX0, PX1, m_reg, mnX, alX);                                        \
        __syncthreads();                                                                                                      \
        if ((t) + 1 < NT) { VMW(); if constexpr (F32) { SWRITE_VF(SB); SBAR(); if ((t) + 2 < NT) SLOAD_F((const float*)Kh, KBASE((t) + 2)); } \
                            else { SWRITE_H(SB); } }                                                                          \
        RESC(alX); __syncthreads(); } while (0)
    for (int t = 1; t + 1 < NT; t += 2) {
        HALF_STEP(pB0, pB1, mnB, alB, pA0, pA1, alA, t, 1, 0, 0);
        HALF_STEP(pA0, pA1, mnA, alA, pB0, pB1, alB, t + 1, 0, 1, 1);
    }
    const bool even = (NT & 1) == 0;
    if (even) { SBAR(); qkt<1, SK>(pB0, pB1, K_lds, r32, hi, S.qr, ACT(NT - 1)); SBAR(); }
#define QROW(e) (nxt.Q + (size_t)(wid * QBLK + r32) * D + ((e) >> 1) * 16 + hi * 8 + ((e) & 1) * 4)
    if constexpr (F32) { SLOAD_F((const float*)nxt.K, kbn); SBAR();
#pragma unroll
        for (int e = 0; e < 8; ++e) S.tq[e] = *(const f32x4*)QROW(e); }
    else { SLOAD_H(nxt.K, nxt.V, kbn); SBAR();
#pragma unroll
        for (int d0 = 0; d0 < 8; ++d0) S.qr[d0] = load8<TIn>(nxt.Q + (size_t)(wid * QBLK + r32) * D + d0 * 16 + hi * 8); }
    SBAR();
    finishSM(pA0, pA1, alA, l_reg, pa0, pa1, pa2, pa3); SBAR();
    if constexpr (F32) {
#pragma unroll
        for (int e = 8; e < 16; ++e) S.tq[e] = *(const f32x4*)QROW(e); SBAR(); }
#undef QROW
    pv_tile<0, SK>(o, vb0, pa0, pa1, pa2, pa3, ACT(even ? NT - 2 : NT - 1));
    if (even) { MASKT(pB0, pB1, NT - 1); partialSM(pB0, pB1, m_reg, mnB, alB); __syncthreads(); RESC(alB);
        finishSM(pB0, pB1, alB, l_reg, pa0, pa1, pa2, pa3); SBAR(); pv_tile<1, SK>(o, vb0, pa0, pa1, pa2, pa3, ACT(NT - 1)); }
    SBAR(); SEAM_K0();
    if (hi == 0) li_l[r32] = l_reg; asm volatile("s_waitcnt lgkmcnt(0)" ::: "memory");
    float rli[16];
#pragma unroll
    for (int r = 0; r < 16; ++r) rli[r] = __builtin_amdgcn_rcpf(li_l[crow(r, hi)]);
    TOut* Ow = cur.O + (size_t)(wid * QBLK) * D;
#pragma unroll
    for (int r = 0; r < 16; ++r) { const int orow = crow(r, hi);
#pragma unroll
        for (int d0 = 0; d0 < 4; ++d0) { const float v = o[d0][r] * rli[r];
            if constexpr (same_t<TOut, float>::v) { Ow[(size_t)orow * D + d0 * 32 + r32] = v; }
            else { const float vn = swz_xor<1>(v);
                   if ((r32 & 1) == 0) *(unsigned*)(Ow + (size_t)orow * D + d0 * 32 + r32) = cvtpk(v, vn); } } }
    if constexpr (F32) {
#pragma unroll
        for (int d0 = 0; d0 < 8; ++d0) S.qr[d0] = pack8(S.tq[2 * d0], S.tq[2 * d0 + 1]); }
    __syncthreads();
#undef RESC
#undef KBASE
#undef ACT
#undef MASKT
#undef SEAM_K0
#undef HALF_STEP
}
#undef ROW
#undef VMW
#undef VMWN
#undef SLOAD_H
#undef SWRITE_HK
#undef SWRITE_HV
#undef SWRITE_H
#undef SLOAD_F
#undef SWRITE_KF
#undef SWRITE_VF

}

constexpr size_t MiB = 1u << 20;
constexpr size_t WS_CTL = 0, CTL_ZERO_BYTES = 64 * 1024;
constexpr size_t WS_MODP = 2 * MiB;
constexpr size_t WS_MOD = 12 * MiB;
constexpr size_t WS_SSQ = 13 * MiB + 256 * 1024;
constexpr size_t WS_BIAS = 20 * MiB;
constexpr size_t WS_COS = 14 * MiB, WS_SIN = 16 * MiB;
constexpr size_t WS_COSI = 18 * MiB, WS_SINI = 19 * MiB;
constexpr size_t WS_WGU = 32 * MiB;
constexpr size_t WS_WDN = WS_WGU + 8 * 44 * MiB;
constexpr size_t WS_WAIN = WS_WDN + 8 * 22 * MiB;
constexpr size_t WS_WAOUT = WS_WAIN + 2 * 24 * MiB;
constexpr size_t WS_WBIN = WS_WAOUT + 2 * 8 * MiB;
constexpr size_t WS_WBOUT = WS_WBIN + 2 * 18 * MiB;
constexpr size_t WS_XN = WS_WBOUT + 2 * 8 * MiB;
constexpr size_t WS_AO = WS_XN + 128 * MiB;
constexpr size_t WS_BIG = WS_AO + 128 * MiB;
constexpr size_t WS_Q = WS_BIG + 384 * MiB, WS_K = WS_Q + 128 * MiB, WS_V = WS_K + 128 * MiB;
constexpr size_t WS_O = WS_V + 128 * MiB;
constexpr size_t WS_WQ = WS_O + 256 * MiB;
constexpr size_t WS_XQ = WS_WQ + 8 * 22 * MiB;
constexpr size_t WS_WOQ = WS_XQ + 64 * MiB;
constexpr size_t WS_WQA = WS_WOQ + 16 * MiB;
constexpr size_t WS_END = WS_WQA + 24 * MiB;
constexpr size_t WS_XH = WS_WGU;
constexpr size_t WS_TQ = 24 * MiB;
constexpr size_t WS_WQD = WS_WGU + 128 * MiB;
constexpr size_t WS_WQB = WS_WGU + 224 * MiB;
constexpr size_t WS_TQB = 30 * MiB;
constexpr int B_QKV = 2304;
constexpr size_t WS_HQ = WS_Q;
constexpr size_t WS_TQD = 29 * MiB;
constexpr size_t WS_RFH = 30 * MiB;
constexpr unsigned DN_I8_MASK = 0xFFFu;
constexpr size_t WS_TQA = 28 * MiB;
constexpr size_t WS_TQO = 26 * MiB;
constexpr size_t WS_RFO = 27 * MiB;
constexpr size_t WS_RF = 25 * MiB;
static_assert(WS_XN == 676 * MiB && WS_WQ == 1956 * MiB && WS_END == 2236 * MiB, "d_ws map");
constexpr int CW_BAR = 4096;

constexpr int RING_BYTES = 131072;
constexpr int RING_BYTES_P0W = 131072;
constexpr int MISC_OFF = RING_BYTES + 320;
static_assert(TIDTAB_OFF == MISC_OFF + 128, "LDS map");
constexpr int LDS_BYTES = 155648;
constexpr int NWAVES = 8;

#define GAS __attribute__((address_space(1)))
#define LAS __attribute__((address_space(3)))
typedef unsigned v4u __attribute__((ext_vector_type(4)));
typedef float f32x4 __attribute__((ext_vector_type(4)));
typedef float f32x2 __attribute__((ext_vector_type(2)));
#define LDS_WAIT() asm volatile("s_waitcnt lgkmcnt(0)" ::: "memory")
#define VM_WAIT() asm volatile("s_waitcnt vmcnt(0)" ::: "memory")
__device__ __forceinline__ unsigned pkh(float lo, float hi) { h16x2 v = {(_Float16)lo, (_Float16)hi}; return __builtin_bit_cast(unsigned, v); }
__device__ __forceinline__ float wave_sum(float v) {
    v += swz_xor<1>(v); v += swz_xor<2>(v); v += swz_xor<4>(v); v += swz_xor<8>(v); v = add_xor16(v);
    return add_xor32(v);
}

#define XB_TMO      128
#define XB_XCNT(j)  (256  + 64 * (j))
#define XB_XSUB(j)  (1280 + 64 * (j))
#define XB_XGEN(j)  (2304 + 64 * (j))
#define XB_TOP      3328
#define XB_TOPGEN   3392
#define XCD_BAR_WORDS 3456
#define XB_SPIN_CAP (1u << 21)

__device__ __forceinline__ unsigned xb_ld(unsigned* p)              { return __hip_atomic_load(p, __ATOMIC_RELAXED, __HIP_MEMORY_SCOPE_AGENT); }
__device__ __forceinline__ unsigned xb_add(unsigned* p, unsigned v) { return __hip_atomic_fetch_add(p, v, __ATOMIC_RELAXED, __HIP_MEMORY_SCOPE_AGENT); }
__device__ __forceinline__ unsigned xb_xcc_id() { return (unsigned)__builtin_amdgcn_s_getreg((3 << 11) | 20) & 0xFu; }
#define XB_SPIN(cond, bar) do { unsigned _sp = 0; while (cond) { __builtin_amdgcn_s_sleep(1); \
    if ((++_sp & 255u) == 0u) { if (xb_ld(&(bar)[XB_TMO])) break; if (_sp > XB_SPIN_CAP) { atomicAdd(&(bar)[XB_TMO], 1u); break; } } } } while (0)

struct XcdBarrier { unsigned* bar; unsigned x; volatile LAS unsigned* st; };

__device__ __forceinline__ XcdBarrier xcd_barrier_post(unsigned* bar, volatile LAS unsigned* st) {
    XcdBarrier b; b.bar = bar; b.x = xb_xcc_id(); b.st = st;
    if (opaque_tid() == 0) (void)xb_add(&bar[XB_XCNT(b.x)], 1u);
    return b;
}
__device__ __forceinline__ void xcd_barrier_complete(unsigned* bar, unsigned x, unsigned& nloc, unsigned& nx) {
    const unsigned G = gridDim.x * gridDim.y * gridDim.z;
    unsigned sum, cnt, mine, sp = 0u;
    for (;;) {
        sum = 0u; cnt = 0u; mine = 0u;
#pragma unroll
        for (unsigned j = 0; j < 16; ++j) { const unsigned c = xb_ld(&bar[XB_XCNT(j)]); sum += c; cnt += (c > 0u) ? 1u : 0u; mine = (j == x) ? c : mine; }
        if (sum == G) break;
        __builtin_amdgcn_s_sleep(1);
        if ((++sp & 255u) == 0u) { if (xb_ld(&bar[XB_TMO])) break; if (sp > XB_SPIN_CAP) { atomicAdd(&bar[XB_TMO], 1u); break; } }
    }
    nloc = mine > 0u ? mine : 1u; nx = cnt > 0u ? cnt : 1u;
}
__device__ __forceinline__ void xcd_barrier(const XcdBarrier& b) {
    asm volatile("s_waitcnt vmcnt(0)" ::: "memory");
    __syncthreads();
    if (opaque_tid() == 0) {
        unsigned* bar = b.bar;
        __builtin_amdgcn_s_waitcnt(0);
        unsigned nloc = b.st[0], nx = b.st[1];
        if (nloc == 0u) { xcd_barrier_complete(bar, b.x, nloc, nx); b.st[0] = nloc; b.st[1] = nx; }
        const unsigned old = xb_add(&bar[XB_XSUB(b.x)], 1u);
        const unsigned gen = old / nloc;
        if (old + 1u == (gen + 1u) * nloc) {
            __builtin_amdgcn_fence(__ATOMIC_RELEASE, "agent");
            asm volatile("s_waitcnt vmcnt(0)" ::: "memory");
            const unsigned og = xb_add(&bar[XB_TOP], 1u);
            const unsigned tg = og / nx;
            if (og + 1u == (tg + 1u) * nx) xb_add(&bar[XB_TOPGEN], 1u);
            else XB_SPIN(xb_ld(&bar[XB_TOPGEN]) == tg, bar);
            __builtin_amdgcn_fence(__ATOMIC_ACQUIRE, "agent");
            xb_add(&bar[XB_XGEN(b.x)], 1u);
            asm volatile("s_waitcnt vmcnt(0)" ::: "memory");
        } else {
            XB_SPIN(xb_ld(&bar[XB_XGEN(b.x)]) == gen, bar);
            __builtin_amdgcn_fence(__ATOMIC_ACQUIRE, "agent");
            asm volatile("s_waitcnt vmcnt(0)" ::: "memory");
        }
    }
    __syncthreads();
}

__device__ __forceinline__ void p0_transpose_item(const float* W, int K, int N, u16* WT, int dest_row, int k0, int n0, LAS float* scr, int lane) {
    {
        const int c4 = lane & 7, kr = lane >> 3; const bool ok = n0 + 4 * c4 + 3 < N;
        const float* wp = W + (size_t)(k0 + kr) * N + n0 + 4 * c4;
        f32x4 v[8];
#pragma unroll
        for (int i = 0; i < 8; ++i) v[i] = ok ? *(const f32x4*)(wp + (size_t)(8 * i) * N) : (f32x4){0.f, 0.f, 0.f, 0.f};
#pragma unroll
        for (int i = 0; i < 8; ++i) { LAS float* d = scr + (kr + 8 * i) * 33 + 4 * c4; d[0] = v[i].x; d[1] = v[i].y; d[2] = v[i].z; d[3] = v[i].w; }
    }
    LDS_WAIT(); asm volatile("" ::: "memory");
    const int c = lane & 7;
#pragma unroll
    for (int j = 0; j < 4; ++j) { const int n = (lane >> 3) + 8 * j; const LAS float* s = scr + (8 * c) * 33 + n;
        v4u o; o.x = pkh(s[0 * 33], s[1 * 33]); o.y = pkh(s[2 * 33], s[3 * 33]); o.z = pkh(s[4 * 33], s[5 * 33]); o.w = pkh(s[6 * 33], s[7 * 33]);
        *(GAS v4u*)(WT + (size_t)(dest_row + n) * K + k0 + 8 * c) = o; }
    LDS_WAIT(); asm volatile("" ::: "memory");
}
__device__ __forceinline__ void p0_ada_item(const float* c, const float* ada_w, float* part, int item, LAS float* scr, int lane) {
    const int kc = item & 7, cc = (item >> 3) % 72, layer = item / (8 * 72);
#pragma unroll
    for (int i = 0; i < 4; ++i) { const int k = lane + 64 * i;
#pragma unroll
        for (int b = 0; b < NB; ++b) { const float v = c[b * DM + kc * 256 + k]; scr[k * 4 + b] = v / (1.0f + __expf(-v)); } }
    LDS_WAIT(); asm volatile("" ::: "memory");
    f32x4 a0 = {0.f, 0.f, 0.f, 0.f}, a1 = a0, a2 = a0, a3 = a0;
    const float* wp = ada_w + ((size_t)layer * DM + kc * 256) * ADAW + cc * 256 + lane * 4;
#pragma unroll 8
    for (int k = 0; k < 256; ++k) {
        const f32x4 w = *(const f32x4*)(wp + (size_t)k * ADAW); const f32x4 cb = *(const LAS f32x4*)(scr + k * 4);
        a0 += w * cb[0]; a1 += w * cb[1]; a2 += w * cb[2]; a3 += w * cb[3];
    }
    float* pp = part + ((size_t)(kc * DEPTH + layer) * NB) * ADAW + cc * 256 + lane * 4;
    *(f32x4*)(pp) = a0; *(f32x4*)(pp + ADAW) = a1; *(f32x4*)(pp + 2 * ADAW) = a2; *(f32x4*)(pp + 3 * ADAW) = a3;
    LDS_WAIT(); asm volatile("" ::: "memory");
}
__device__ __forceinline__ void sincos_d(double ang, float& co, float& si) {
    const double k = __builtin_rint(ang * 0.6366197723675814);
    double r = __builtin_fma(-k, 1.5707963267948966, ang); r = __builtin_fma(-k, 6.123233995736766e-17, r);
    const double r2 = r * r;
    double s = -7.6471637318198164759e-13; s = s * r2 + 1.6059043836821614599e-10; s = s * r2 - 2.5052108385441718775e-08; s = s * r2 + 2.7557319223985890653e-06;
    s = s * r2 - 1.9841269841269841270e-04; s = s * r2 + 8.3333333333333333333e-03; s = s * r2 - 1.6666666666666666667e-01; s = s * r2 * r + r;
    double c = 4.7794773323873852974e-14; c = c * r2 - 1.1470745597729724714e-11; c = c * r2 + 2.0876756987868098979e-09; c = c * r2 - 2.7557319223985890653e-07;
    c = c * r2 + 2.4801587301587301587e-05; c = c * r2 - 1.3888888888888888889e-03; c = c * r2 + 4.1666666666666666667e-02; c = c * r2 - 0.5; c = c * r2 + 1.0;
    const int q = ((int)k) & 3;
    const double cc = (q == 0) ? c : (q == 1) ? -s : (q == 2) ? -c : s;
    const double ss = (q == 0) ? s : (q == 1) ? c : (q == 2) ? -s : -c;
    co = (float)cc; si = (float)ss;
}
__device__ __forceinline__ double powi_d(double base, int e) { double r = 1.0, bb = base;
#pragma unroll
    for (int i = 0; i < 6; ++i) { if (e & (1 << i)) r *= bb; bb *= bb; }
    return r; }

__device__ __forceinline__ void unpack8(const h16x8 h, float (&v)[8]) {
#pragma unroll
    for (int e = 0; e < 8; ++e) v[e] = (float)h[e];
}
__device__ __forceinline__ v4u pack8h(const float (&o)[8]) { v4u w; w.x = pkh(o[0], o[1]); w.y = pkh(o[2], o[3]); w.z = pkh(o[4], o[5]); w.w = pkh(o[6], o[7]); return w; }
__device__ __forceinline__ float sum16(float s) { s += swz_xor<1>(s); s += swz_xor<2>(s); s += swz_xor<4>(s); s += swz_xor<8>(s); return s; }

__device__ __forceinline__ float max_xor16(float v) { auto r = __builtin_amdgcn_permlane16_swap(__float_as_uint(v), __float_as_uint(v), false, false); return fmaxf(__uint_as_float(r[0]), __uint_as_float(r[1])); }
__device__ __forceinline__ float max_xor32(float v) { auto r = __builtin_amdgcn_permlane32_swap(__float_as_uint(v), __float_as_uint(v), false, false); return fmaxf(__uint_as_float(r[0]), __uint_as_float(r[1])); }
__device__ __forceinline__ float wave_max(float v) {
    v = fmaxf(v, swz_xor<1>(v)); v = fmaxf(v, swz_xor<2>(v)); v = fmaxf(v, swz_xor<4>(v)); v = fmaxf(v, swz_xor<8>(v)); v = max_xor16(v);
    return max_xor32(v);
}
__device__ __forceinline__ unsigned pack4_i8(float a, float b, float c, float d) {
    const int ia = (int)__builtin_rintf(a), ib = (int)__builtin_rintf(b), ic = (int)__builtin_rintf(c), id = (int)__builtin_rintf(d);
    return ((unsigned)ia & 255u) | (((unsigned)ib & 255u) << 8) | (((unsigned)ic & 255u) << 16) | ((unsigned)id << 24);
}
template <bool IN32, bool XNOUT = false>
__device__ __forceinline__ void phase_quant(const float* x32, u16* xh, unsigned long long* xq, const float* scale, float* rf, int gw, int NGW, int lane, u16* xn = nullptr, float* ssq0 = nullptr) {
    constexpr int rpw = 16;
    for (int grp = gw; grp < MTOK / rpw; grp += NGW) {
    const int m0 = grp * rpw, b = m0 >> 13;
    f32x4 sc[4][2];
    { const f32x4* sp = (const f32x4*)(scale + (size_t)b * ADAW) + 2 * lane;
#pragma unroll
      for (int j = 0; j < 4; ++j) { sc[j][0] = sp[128 * j] + 1.0f; sc[j][1] = sp[128 * j + 1] + 1.0f; } }
    h16x8 v[4];
#define PQ_LOAD(m_) do { if constexpr (IN32) { const f32x4* xr = (const f32x4*)(x32 + (size_t)(m_) * DM) + 2 * lane; \
            _Pragma("unroll") for (int j = 0; j < 4; ++j) { const f32x4 a = xr[128 * j], c = xr[128 * j + 1]; \
                v[j] = (h16x8){(_Float16)a.x, (_Float16)a.y, (_Float16)a.z, (_Float16)a.w, (_Float16)c.x, (_Float16)c.y, (_Float16)c.z, (_Float16)c.w}; } } \
        else { const h16x8* xr = (const h16x8*)(xh + (size_t)(m_) * DM) + lane; _Pragma("unroll") for (int j = 0; j < 4; ++j) v[j] = xr[64 * j]; } } while (0)
    PQ_LOAD(m0);
    for (int i = 0; i < rpw; ++i) {
        const int m = m0 + i;
        f32x4 y[4][2]; float s = 0.f, am = 0.f;
#pragma unroll
        for (int j = 0; j < 4; ++j) {
            const f32x4 a = (f32x4){(float)v[j][0], (float)v[j][1], (float)v[j][2], (float)v[j][3]}, c = (f32x4){(float)v[j][4], (float)v[j][5], (float)v[j][6], (float)v[j][7]};
            s += (a.x * a.x + a.y * a.y) + (a.z * a.z + a.w * a.w) + (c.x * c.x + c.y * c.y) + (c.z * c.z + c.w * c.w);
            y[j][0] = a * sc[j][0]; y[j][1] = c * sc[j][1];
            am = fmaxf(am, fmaxf(fmaxf(fmaxf(__builtin_fabsf(y[j][0].x), __builtin_fabsf(y[j][0].y)), fmaxf(__builtin_fabsf(y[j][0].z), __builtin_fabsf(y[j][0].w))),
                                 fmaxf(fmaxf(__builtin_fabsf(y[j][1].x), __builtin_fabsf(y[j][1].y)), fmaxf(__builtin_fabsf(y[j][1].z), __builtin_fabsf(y[j][1].w)))));
        }
        if constexpr (IN32) { h16x8* xo = (h16x8*)(xh + (size_t)m * DM) + lane;
#pragma unroll
            for (int j = 0; j < 4; ++j) xo[64 * j] = v[j]; }
        if constexpr (XNOUT) { v4u* xo = (v4u*)(xn + (size_t)m * DM) + lane;
#pragma unroll
            for (int j = 0; j < 4; ++j) { v4u w; w.x = pkh(y[j][0].x, y[j][0].y); w.y = pkh(y[j][0].z, y[j][0].w); w.z = pkh(y[j][1].x, y[j][1].y); w.w = pkh(y[j][1].z, y[j][1].w); xo[64 * j] = w; } }
        if (i + 1 < rpw) PQ_LOAD(m + 1);
        s = wave_sum(s); am = wave_max(am);
        if constexpr (XNOUT) { if (lane == 0) ssq0[m] = s; }
        const float inv = am > 0.f ? 127.0f / am : 0.f;
        if (lane == 0) rf[m] = rsqrtf(s * (1.0f / DM) + NORM_EPS) * (am * (1.0f / 127.0f));
        unsigned long long* o = xq + (size_t)m * (DM / 8) + lane;
#pragma unroll
        for (int j = 0; j < 4; ++j) o[64 * j] = (unsigned long long)pack4_i8(y[j][0].x * inv, y[j][0].y * inv, y[j][0].z * inv, y[j][0].w * inv)
                                              | ((unsigned long long)pack4_i8(y[j][1].x * inv, y[j][1].y * inv, y[j][1].z * inv, y[j][1].w * inv) << 32);
    }
    }
#undef PQ_LOAD
}
__device__ __forceinline__ void phase_prepx(const u16* xh, u16* xn, const float* scale, float* ssq0, int gw, int NGW, int lane) {
    for (int m = gw; m < MTOK; m += NGW) {
        const int b = m >> 13;
        const h16x8* xr = (const h16x8*)(xh + (size_t)m * DM) + lane;
        h16x8 v[4];
#pragma unroll
        for (int j = 0; j < 4; ++j) v[j] = xr[64 * j];
        const f32x4* sp = (const f32x4*)(scale + (size_t)b * ADAW) + 2 * lane;
        v4u* o = (v4u*)(xn + (size_t)m * DM) + lane;
        float s = 0.f;
#pragma unroll
        for (int j = 0; j < 4; ++j) {
            const f32x4 a = (f32x4){(float)v[j][0], (float)v[j][1], (float)v[j][2], (float)v[j][3]}, c = (f32x4){(float)v[j][4], (float)v[j][5], (float)v[j][6], (float)v[j][7]};
            s += (a.x * a.x + a.y * a.y) + (a.z * a.z + a.w * a.w) + (c.x * c.x + c.y * c.y) + (c.z * c.z + c.w * c.w);
            const f32x4 ya = a * (sp[128 * j] + 1.0f), yc = c * (sp[128 * j + 1] + 1.0f);
            v4u w; w.x = pkh(ya.x, ya.y); w.y = pkh(ya.z, ya.w); w.z = pkh(yc.x, yc.y); w.w = pkh(yc.z, yc.w);
            o[64 * j] = w;
        }
        s = wave_sum(s);
        if (lane == 0) ssq0[m] = s;
    }
}
__device__ __forceinline__ void quant_row_dff(const u16* src, unsigned char* dst, float* scale, int lane) {
    h16x8 raw[11]; float am = 0.f;
#pragma unroll
    for (int j = 0; j < 11; ++j) raw[j] = *((const h16x8*)src + lane + 64 * j);
#pragma unroll
    for (int j = 0; j < 11; ++j) { float w[8]; unpack8(raw[j], w);
#pragma unroll
        for (int e = 0; e < 8; ++e) am = fmaxf(am, __builtin_fabsf(w[e])); }
    am = wave_max(am); const float inv = am > 0.f ? 127.0f / am : 0.f;
#pragma unroll
    for (int j = 0; j < 11; ++j) { float w[8]; unpack8(raw[j], w);
        *((unsigned long long*)dst + lane + 64 * j) = (unsigned long long)pack4_i8(w[0] * inv, w[1] * inv, w[2] * inv, w[3] * inv) | ((unsigned long long)pack4_i8(w[4] * inv, w[5] * inv, w[6] * inv, w[7] * inv) << 32); }
    if (lane == 0) *scale = am * (1.0f / 127.0f);
}
template <int K, int NC, bool BIAS, bool F8 = false>
__device__ __forceinline__ void p0w_strip(const float* W, int N, int n0, unsigned char* Wq0, float* tq0, const float* shift, float* bias0, int bstride, LAS unsigned char* L, int tid) {
    constexpr int LPR = NC / 4, RPW = 64 / LPR, RB = 8 * RPW * 4, NG = K / RB, TS = K + 16;
    constexpr int OFF_T = BIAS ? 4 * K * 4 : 0, OFF_RA = OFF_T + NC * TS, OFF_RB = OFF_RA + 8 * NC * 4;
    static_assert(K % RB == 0 && OFF_RB + 8 * 4 * NC * 4 <= RING_BYTES_P0W, "p0w_strip LDS map");
    asm volatile("" : "+v"(tid));
    const int w = __builtin_amdgcn_readfirstlane(tid >> 6), lane = tid & 63, c4 = lane % LPR, kr = lane / LPR;
    f32x4 v[NG][4];
    { const float* wp = W + (size_t)(RPW * 4 * w + 4 * kr) * N + n0 + 4 * c4;
#pragma unroll
      for (int g = 0; g < NG; ++g)
#pragma unroll
          for (int j = 0; j < 4; ++j) v[g][j] = *(const f32x4*)(wp + (size_t)(RB * g + j) * N); }
    if constexpr (BIAS) {
#pragma unroll
        for (int r = 0; r < (4 * K / 4) / 512; ++r) { const int idx = tid + 512 * r, b = idx / (K / 4), kk = idx % (K / 4);
            *(LAS f32x4*)(L + (size_t)(b * K + 4 * kk) * 4) = *(const f32x4*)(shift + (size_t)b * ADAW + 4 * kk); }
    }
    f32x4 am = {0.f, 0.f, 0.f, 0.f};
#pragma unroll
    for (int g = 0; g < NG; ++g)
#pragma unroll
        for (int j = 0; j < 4; ++j) am = __builtin_elementwise_max(am, __builtin_elementwise_abs(v[g][j]));
#pragma unroll
    for (int e = 0; e < 4; ++e) { float x = am[e];
        if constexpr (LPR == 4) x = fmaxf(x, swz_xor<4>(x));
        x = fmaxf(x, swz_xor<8>(x)); x = fmaxf(x, swz_xor<16>(x)); x = max_xor32(x); am[e] = x; }
    if (kr == 0) *(LAS f32x4*)(L + OFF_RA + (w * NC + 4 * c4) * 4) = am;
    __syncthreads();
    f32x4 amx = *(const LAS f32x4*)(L + OFF_RA + (4 * c4) * 4);
#pragma unroll
    for (int ww = 1; ww < 8; ++ww) amx = __builtin_elementwise_max(amx, *(const LAS f32x4*)(L + OFF_RA + (ww * NC + 4 * c4) * 4));
    f32x4 inv;
#pragma unroll
    for (int e = 0; e < 4; ++e) inv[e] = amx[e] > 0.f ? (F8 ? pg8::F8_WMAX : 127.0f) / amx[e] : 0.f;
    if (tid < LPR) *(f32x4*)(tq0 + 4 * c4) = amx * (F8 ? 1.0f / (pg8::F8_WMAX * pg8::HID_S) : 1.0f / 127.0f);
    if constexpr (BIAS) {
        f32x4 acc[4];
#pragma unroll
        for (int b = 0; b < 4; ++b) acc[b] = (f32x4){0.f, 0.f, 0.f, 0.f};
#pragma unroll
        for (int g = 0; g < NG; ++g) { const int k0 = RB * g + RPW * 4 * w + 4 * kr;
#pragma unroll
            for (int b = 0; b < 4; ++b) { const f32x4 sh = *(const LAS f32x4*)(L + (size_t)(b * K + k0) * 4);
                acc[b] += v[g][0] * sh[0] + v[g][1] * sh[1] + v[g][2] * sh[2] + v[g][3] * sh[3]; } }
#pragma unroll
        for (int b = 0; b < 4; ++b) {
#pragma unroll
            for (int e = 0; e < 4; ++e) { float x = acc[b][e];
                if constexpr (LPR == 4) x += swz_xor<4>(x);
                x += swz_xor<8>(x); x += swz_xor<16>(x); x = add_xor32(x); acc[b][e] = x; }
            if (kr == 0) *(LAS f32x4*)(L + OFF_RB + ((w * 4 + b) * NC + 4 * c4) * 4) = acc[b]; }
    }
#pragma unroll
    for (int g = 0; g < NG; ++g) { const int k0 = RB * g + RPW * 4 * w + 4 * kr;
#pragma unroll
        for (int e = 0; e < 4; ++e) *(LAS unsigned*)(L + OFF_T + (4 * c4 + e) * TS + k0) = F8 ? pg8::pack4_f8(v[g][0][e] * inv[e], v[g][1][e] * inv[e], v[g][2][e] * inv[e], v[g][3][e] * inv[e])
                                                                                              : pack4_i8(v[g][0][e] * inv[e], v[g][1][e] * inv[e], v[g][2][e] * inv[e], v[g][3][e] * inv[e]); }
    __syncthreads();
    if constexpr (BIAS) {
        if (tid < 4 * NC) { const int b = tid / NC, col = tid % NC; float sum = 0.f;
#pragma unroll
            for (int ww = 0; ww < 8; ++ww) sum += *(const LAS float*)(L + OFF_RB + ((ww * 4 + b) * NC + col) * 4);
            bias0[(size_t)b * bstride + col] = sum; }
    }
    if (tid < K / 16) {
#pragma unroll 4
        for (int col = 0; col < NC; ++col) *(v4u*)(Wq0 + (size_t)col * K + 16 * tid) = *(const LAS v4u*)(L + OFF_T + col * TS + 16 * tid);
    }
    __syncthreads();
}
__device__ __forceinline__ void phase_bias_bin(const float* mod, const u16* WBIN, float* bias, int gw, int NGW, int lane) {
    for (int r = gw; r < 2 * B_INP; r += NGW) {
        const int mj = r / B_INP, n = r % B_INP, li = 2 * mj + 1, q = 3 * li + 1;
        const u16* wrow = WBIN + ((size_t)mj * B_INP + n) * DM + 8 * lane;
        h16x8 raw[4];
#pragma unroll
        for (int j = 0; j < 4; ++j) raw[j] = *(const h16x8*)(wrow + 512 * j);
        float d[4] = {0.f, 0.f, 0.f, 0.f};
#pragma unroll
        for (int bb = 0; bb < 4; ++bb) { const float* sp = mod + ((size_t)li * NB + bb) * ADAW + 3 * DM + 8 * lane;
#pragma unroll
            for (int j = 0; j < 4; ++j) { float w[8]; unpack8(raw[j], w); const f32x4 a0 = *(const f32x4*)(sp + 512 * j), a1 = *(const f32x4*)(sp + 512 * j + 4);
                d[bb] += (w[0] * a0[0] + w[1] * a0[1]) + (w[2] * a0[2] + w[3] * a0[3]) + (w[4] * a1[0] + w[5] * a1[1]) + (w[6] * a1[2] + w[7] * a1[3]); } }
#pragma unroll
        for (int bb = 0; bb < 4; ++bb) d[bb] = wave_sum(d[bb]);
        if (lane == 0) { float* bp = bias + (size_t)(q * 4) * GU_N + n; bp[0] = d[0]; bp[GU_N] = d[1]; bp[2 * GU_N] = d[2]; bp[3 * GU_N] = d[3]; }
    }
}
__device__ __forceinline__ int bias_nq(int q) { const int li = q / 3, s = q - 3 * li; return (s != 1) ? GU_N : ((li & 1) == 0 ? A_IN : B_INP); }
__device__ __forceinline__ void phase_bias(const float* mod, const u16* WGU, const u16* WAIN, const u16* WBIN, float* bias, unsigned char* WQ, float* TQ, unsigned char* WQA, float* TQA, int gw, int NGW, int lane) {
    constexpr int R = 8 * GU_N + 2 * A_IN + 2 * B_INP;
    const int chunk = (R + NGW - 1) / NGW; int r = gw * chunk; const int rend = (r + chunk < R) ? r + chunk : R;
    if (r >= rend) return;
    int q = 0, base = 0;
    while (r >= base + bias_nq(q)) { base += bias_nq(q); ++q; }
    float sh[4][32]; const u16* wt = nullptr; int nq = 0;
    bool fresh = true;
    for (; r < rend; ++r) {
        if (r >= base + nq && !fresh) { base += nq; ++q; fresh = true; }
        if (fresh) { fresh = false; nq = bias_nq(q); const int li = q / 3, s = q - 3 * li;
            wt = (s != 1) ? WGU + (size_t)(li * 2 + (s >> 1)) * GU_N * DM : (((li & 1) == 0) ? WAIN + (size_t)(li >> 1) * A_IN * DM : WBIN + (size_t)(li >> 1) * B_INP * DM);
#pragma unroll
            for (int bb = 0; bb < 4; ++bb) { const float* sp = mod + ((size_t)li * NB + bb) * ADAW + (3 * s) * DM + 8 * lane;
#pragma unroll
                for (int j = 0; j < 4; ++j) { const f32x4 a0 = *(const f32x4*)(sp + 512 * j), a1 = *(const f32x4*)(sp + 512 * j + 4);
#pragma unroll
                    for (int e = 0; e < 4; ++e) { sh[bb][8 * j + e] = a0[e]; sh[bb][8 * j + 4 + e] = a1[e]; } } } }
        const int n = r - base; const u16* wrow = wt + (size_t)n * DM + 8 * lane;
        float d0 = 0.f, d1 = 0.f, d2 = 0.f, d3 = 0.f;
        h16x8 raw[4];
#pragma unroll
        for (int j = 0; j < 4; ++j) raw[j] = *(const h16x8*)(wrow + 512 * j);
        float am = 0.f;
#pragma unroll
        for (int j = 0; j < 4; ++j) { float w[8]; unpack8(raw[j], w);
#pragma unroll
            for (int e = 0; e < 8; ++e) { d0 += w[e] * sh[0][8 * j + e]; d1 += w[e] * sh[1][8 * j + e]; d2 += w[e] * sh[2][8 * j + e]; d3 += w[e] * sh[3][8 * j + e]; am = fmaxf(am, __builtin_fabsf(w[e])); } }
        d0 = wave_sum(d0); d1 = wave_sum(d1); d2 = wave_sum(d2); d3 = wave_sum(d3);
        { const int li = q / 3, s = q - 3 * li;
          if (s != 1 || (li & 1) == 0) {
              am = wave_max(am); const float inv = am > 0.f ? 127.0f / am : 0.f; const int gi = li * 2 + (s >> 1);
              unsigned char* qrow = ((s != 1) ? WQ + ((size_t)gi * GU_N + n) * DM : WQA + ((size_t)(li >> 1) * A_IN + n) * DM) + 8 * lane;
#pragma unroll
              for (int j = 0; j < 4; ++j) { float w[8]; unpack8(raw[j], w);
                  const unsigned lo = pack4_i8(w[0] * inv, w[1] * inv, w[2] * inv, w[3] * inv), hi = pack4_i8(w[4] * inv, w[5] * inv, w[6] * inv, w[7] * inv);
                  *(unsigned long long*)(qrow + 512 * j) = (unsigned long long)lo | ((unsigned long long)hi << 32); }
              if (lane == 0) { if (s != 1) TQ[(size_t)gi * GU_N + n] = am * (1.0f / 127.0f); else TQA[(size_t)(li >> 1) * A_IN + n] = am * (1.0f / 127.0f); }
          } }
        if (lane == 0) { float* bp = bias + (size_t)(q * 4) * GU_N + n; bp[0] = d0; bp[GU_N] = d1; bp[2 * GU_N] = d2; bp[3 * GU_N] = d3; }
    }
}

__device__ __forceinline__ void phase_normropeA(const u16* P, u16* Qh, u16* Kh, u16* Vh, const float* qg, const float* kg, const float* cost, const float* sint, int gw, int NGW, int lane) {
    const int d0 = 8 * (lane & 15), sub = lane >> 4; const bool hiHalf = (lane & 8) != 0;
    float gq[8], gk[8];
#pragma unroll
    for (int e = 0; e < 8; ++e) { gq[e] = qg[d0 + e]; gk[e] = kg[d0 + e]; }
    for (int m = gw; m < MTOK; m += NGW) {
        const int b = m >> 13, t = m & (SEQ - 1);
        const u16* row = P + (size_t)m * A_IN;
        float cs[8], sn[8];
        { const f32x4 c0 = *(const f32x4*)(cost + t * 64 + (d0 & 63)), c1 = *(const f32x4*)(cost + t * 64 + (d0 & 63) + 4);
          const f32x4 s0 = *(const f32x4*)(sint + t * 64 + (d0 & 63)), s1 = *(const f32x4*)(sint + t * 64 + (d0 & 63) + 4);
#pragma unroll
          for (int e = 0; e < 4; ++e) { cs[e] = c0[e]; cs[4 + e] = c1[e]; sn[e] = s0[e]; sn[4 + e] = s1[e]; } }
#pragma unroll
        for (int j = 0; j < 8; ++j) {
            float v[8]; unpack8(*(const h16x8*)(row + 512 * j + 8 * lane), v);
            float ss = 0.f;
#pragma unroll
            for (int e = 0; e < 8; ++e) ss += v[e] * v[e];
            const float rstd = rsqrtf(sum16(ss) * (1.0f / 128.0f) + NORM_EPS);
            float o[8];
#pragma unroll
            for (int e = 0; e < 8; ++e) { const float y = v[e] * rstd * (j < 4 ? gq[e] : gk[e]); const float p = swz_xor<8>(y);
                o[e] = hiHalf ? (y * cs[e] + p * sn[e]) : (y * cs[e] - p * sn[e]); }
            const int ch = (4 * j + sub) & 15;
            u16* dst = (j < 4 ? Qh : Kh) + (((size_t)(b * 16 + ch) * SEQ + t) * 128 + d0);
            *(v4u*)dst = pack8h(o);
        }
#pragma unroll
        for (int j = 0; j < 4; ++j) {
            const v4u raw = *(const v4u*)(row + 4096 + 512 * j + 8 * lane);
            *(v4u*)(Vh + (((size_t)(b * 16 + 4 * j + sub) * SEQ + t) * 128 + d0)) = raw;
        }
    }
}
__device__ __forceinline__ void phase_combineA(const u16* O, unsigned char* AOQ, float* RFO, const float* lq1, const float* lk1, const float* lq2, const float* lk2, const float* subln, float lam_init, int gw, int NGW, int lane) {
    const float s1 = wave_sum(lq1[lane] * lk1[lane] + lq1[lane + 64] * lk1[lane + 64]);
    const float s2 = wave_sum(lq2[lane] * lk2[lane] + lq2[lane + 64] * lk2[lane + 64]);
    const float lam = __expf(s1) - __expf(s2) + lam_init;
    const int half = lane >> 5, e0 = 8 * (lane & 31), vh = e0 >> 7, d = e0 & 127;
    float sg[8];
#pragma unroll
    for (int e = 0; e < 8; ++e) sg[e] = subln[e0 + e] * (1.0f - lam_init);
    for (int m = gw; m < MTOK; m += NGW) {
        const int b = m >> 13, t = m & (SEQ - 1);
        float av[4][8]; float am = 0.f;
#pragma unroll
        for (int hp = 0; hp < 4; ++hp) {
            const int h = 2 * hp + half;
            const size_t s0i = ((size_t)((b * 8 + h) * 2 + 0) * SEQ + t) * 256 + e0, s1i = ((size_t)((b * 8 + h) * 2 + 1) * SEQ + t) * 256 + e0;
            float a[8], c[8]; unpack8(*(const h16x8*)(O + s0i), a); unpack8(*(const h16x8*)(O + s1i), c);
            float ss = 0.f;
#pragma unroll
            for (int e = 0; e < 8; ++e) { a[e] = a[e] - lam * c[e]; ss += a[e] * a[e]; }
            ss = sum16(ss); ss = add_xor16(ss);
            const float rstd = rsqrtf(ss * (1.0f / 256.0f) + NORM_EPS);
#pragma unroll
            for (int e = 0; e < 8; ++e) { av[hp][e] = a[e] * rstd * sg[e]; am = fmaxf(am, __builtin_fabsf(av[hp][e])); }
        }
        am = wave_max(am); const float inv = am > 0.f ? 127.0f / am : 0.f;
        if (lane == 0) RFO[m] = am * (1.0f / 127.0f);
#pragma unroll
        for (int hp = 0; hp < 4; ++hp) {
            const int h = 2 * hp + half;
            *(unsigned long long*)(AOQ + (size_t)m * DM + h * 256 + e0) = (unsigned long long)pack4_i8(av[hp][0] * inv, av[hp][1] * inv, av[hp][2] * inv, av[hp][3] * inv)
                                                                        | ((unsigned long long)pack4_i8(av[hp][4] * inv, av[hp][5] * inv, av[hp][6] * inv, av[hp][7] * inv) << 32);
        }
    }
}
__device__ __forceinline__ void phase_normropeB(const u16* P, u16* QB, u16* KB, u16* VB, u16* QI, u16* KI, float* WI, const float* qg, const float* kg, const float* kig, const float* kib,
                                                const float* cost, const float* sint, const float* costi, const float* sinti, int gw, int NGW, int lane) {
    const int ll = lane & 15, d0 = 8 * ll, sub = lane >> 4; const bool hiHalf = (lane & 8) != 0;
    float gq[8], g2[8], b2[8];
#pragma unroll
    for (int e = 0; e < 8; ++e) { gq[e] = qg[d0 + e]; g2[e] = (sub == 0) ? kg[d0 + e] : (sub == 2) ? kig[d0 + e] : 1.0f; b2[e] = (sub == 2) ? kib[d0 + e] : 0.0f; }
    for (int m = gw; m < MTOK; m += NGW) {
        const int t = m & (SEQ - 1);
        const u16* row = P + (size_t)m * B_INP;
        float cs[8], sn[8], ci[8], si[8];
        { const f32x4 c0 = *(const f32x4*)(cost + t * 64 + (d0 & 63)), c1 = *(const f32x4*)(cost + t * 64 + (d0 & 63) + 4);
          const f32x4 s0 = *(const f32x4*)(sint + t * 64 + (d0 & 63)), s1 = *(const f32x4*)(sint + t * 64 + (d0 & 63) + 4);
          const f32x4 e0 = *(const f32x4*)(costi + t * 32 + (d0 & 31)), e1 = *(const f32x4*)(costi + t * 32 + (d0 & 31) + 4);
          const f32x4 f0 = *(const f32x4*)(sinti + t * 32 + (d0 & 31)), f1 = *(const f32x4*)(sinti + t * 32 + (d0 & 31) + 4);
#pragma unroll
          for (int e = 0; e < 4; ++e) { cs[e] = c0[e]; cs[4 + e] = c1[e]; sn[e] = s0[e]; sn[4 + e] = s1[e]; ci[e] = e0[e]; ci[4 + e] = e1[e]; si[e] = f0[e]; si[4 + e] = f1[e]; } }
#pragma unroll
        for (int j = 0; j < 4; ++j) {
            float v[8]; unpack8(*(const h16x8*)(row + 512 * j + 8 * lane), v);
            float ss = 0.f;
#pragma unroll
            for (int e = 0; e < 8; ++e) ss += v[e] * v[e];
            const float rstd = rsqrtf(sum16(ss) * (1.0f / 128.0f) + NORM_EPS);
            float o[8];
#pragma unroll
            for (int e = 0; e < 8; ++e) { const float y = v[e] * rstd * gq[e]; const float p = swz_xor<8>(y);
                o[e] = hiHalf ? (y * cs[e] + p * sn[e]) : (y * cs[e] - p * sn[e]); }
            *(v4u*)(QB + (size_t)m * DM + (4 * j + sub) * 128 + d0) = pack8h(o);
        }
#pragma unroll
        for (int j = 0; j < 4; ++j) {
            float v[8]; unpack8(*(const h16x8*)(row + 2304 + 512 * j + 8 * lane), v);
            float o[8];
#pragma unroll
            for (int e = 0; e < 8; ++e) { const float y = v[e]; const float p = swz_xor<4>(y);
                o[e] = (ll < 4) ? (y * ci[e] - p * si[e]) : (ll < 8) ? (y * ci[e] + p * si[e]) : y; }
            *(v4u*)(QI + (size_t)m * DM + (4 * j + sub) * 128 + d0) = pack8h(o);
        }
        {
            const int col = (sub < 2) ? (2048 + 8 * lane) : (4352 + d0);
            float v[8]; unpack8(*(const h16x8*)(row + col), v);
            float s = 0.f;
#pragma unroll
            for (int e = 0; e < 8; ++e) s += v[e];
            const float mean = (sub >= 2) ? sum16(s) * (1.0f / 128.0f) : (sum16(s) * 0.0f);
            float ss = 0.f;
#pragma unroll
            for (int e = 0; e < 8; ++e) { v[e] -= mean; ss += v[e] * v[e]; }
            const float rstd = rsqrtf(sum16(ss) * (1.0f / 128.0f) + NORM_EPS);
            float o[8];
#pragma unroll
            for (int e = 0; e < 8; ++e) { const float y = v[e] * rstd * g2[e] + b2[e]; const float p8 = swz_xor<8>(y), p4 = swz_xor<4>(y);
                const float rk = hiHalf ? (y * cs[e] + p8 * sn[e]) : (y * cs[e] - p8 * sn[e]);
                const float ri = (ll < 4) ? (y * ci[e] - p4 * si[e]) : (ll < 8) ? (y * ci[e] + p4 * si[e]) : y;
                o[e] = (sub == 0) ? rk : (sub == 1) ? v[e] : ri; }
            u16* dst = (sub == 0) ? KB : (sub == 1) ? VB : KI;
            if (sub < 3) *(v4u*)(dst + (size_t)m * 128 + d0) = pack8h(o);
        }
        if (lane < 16) { const _Float16 w = __builtin_bit_cast(_Float16, row[4480 + lane]); WI[(size_t)m * 16 + lane] = (float)w * (0.25f * 0.08838834764831845f); }
    }
}

#ifndef B3_REP_SC
#define B3_REP_SC 1
#define B3_REP_TK 1
#define B3_REP_SP 1
#endif
typedef short s16x8 __attribute__((ext_vector_type(8)));
typedef float f32x16v __attribute__((ext_vector_type(16)));
constexpr int B3_V_OFF = 65536, B3_IDX_OFF = 133120;
typedef short s16x4v __attribute__((ext_vector_type(4)));
__device__ __forceinline__ int kswz(int row, int colB) { return row * 256 + (colB ^ ((row & 7) << 4)); }
__device__ __forceinline__ unsigned f2key(float f) { const unsigned u = __float_as_uint(f); return u ^ ((unsigned)((int)u >> 31) | 0x80000000u); }

__device__ __forceinline__ int count_ge16(int cnt, unsigned c, unsigned k0, unsigned k1, unsigned k2, unsigned k3, unsigned k4, unsigned k5, unsigned k6, unsigned k7, unsigned k8, unsigned k9, unsigned k10, unsigned k11, unsigned k12, unsigned k13, unsigned k14, unsigned k15) {
    unsigned long long m0, m1, m2, m3; int t0, t1;
    asm volatile("v_cmp_ge_u32_e64 %[m0], %[k0], %[c]\n\tv_cmp_ge_u32_e64 %[m1], %[k1], %[c]\n\tv_cmp_ge_u32_e64 %[m2], %[k2], %[c]\n\tv_cmp_ge_u32_e64 %[m3], %[k3], %[c]\n\ts_bcnt1_i32_b64 %[t0], %[m0]\n\tv_cmp_ge_u32_e64 %[m0], %[k4], %[c]\n\ts_add_i32 %[cnt], %[cnt], %[t0]\n\ts_bcnt1_i32_b64 %[t1], %[m1]\n\tv_cmp_ge_u32_e64 %[m1], %[k5], %[c]\n\ts_add_i32 %[cnt], %[cnt], %[t1]\n\ts_bcnt1_i32_b64 %[t0], %[m2]\n\tv_cmp_ge_u32_e64 %[m2], %[k6], %[c]\n\ts_add_i32 %[cnt], %[cnt], %[t0]\n\ts_bcnt1_i32_b64 %[t1], %[m3]\n\tv_cmp_ge_u32_e64 %[m3], %[k7], %[c]\n\ts_add_i32 %[cnt], %[cnt], %[t1]\n\ts_bcnt1_i32_b64 %[t0], %[m0]\n\tv_cmp_ge_u32_e64 %[m0], %[k8], %[c]\n\ts_add_i32 %[cnt], %[cnt], %[t0]\n\ts_bcnt1_i32_b64 %[t1], %[m1]\n\tv_cmp_ge_u32_e64 %[m1], %[k9], %[c]\n\ts_add_i32 %[cnt], %[cnt], %[t1]\n\ts_bcnt1_i32_b64 %[t0], %[m2]\n\tv_cmp_ge_u32_e64 %[m2], %[k10], %[c]\n\ts_add_i32 %[cnt], %[cnt], %[t0]\n\ts_bcnt1_i32_b64 %[t1], %[m3]\n\tv_cmp_ge_u32_e64 %[m3], %[k11], %[c]\n\ts_add_i32 %[cnt], %[cnt], %[t1]\n\ts_bcnt1_i32_b64 %[t0], %[m0]\n\tv_cmp_ge_u32_e64 %[m0], %[k12], %[c]\n\ts_add_i32 %[cnt], %[cnt], %[t0]\n\ts_bcnt1_i32_b64 %[t1], %[m1]\n\tv_cmp_ge_u32_e64 %[m1], %[k13], %[c]\n\ts_add_i32 %[cnt], %[cnt], %[t1]\n\ts_bcnt1_i32_b64 %[t0], %[m2]\n\tv_cmp_ge_u32_e64 %[m2], %[k14], %[c]\n\ts_add_i32 %[cnt], %[cnt], %[t0]\n\ts_bcnt1_i32_b64 %[t1], %[m3]\n\tv_cmp_ge_u32_e64 %[m3], %[k15], %[c]\n\ts_add_i32 %[cnt], %[cnt], %[t1]\n\ts_bcnt1_i32_b64 %[t0], %[m0]\n\ts_add_i32 %[cnt], %[cnt], %[t0]\n\ts_bcnt1_i32_b64 %[t1], %[m1]\n\ts_add_i32 %[cnt], %[cnt], %[t1]\n\ts_bcnt1_i32_b64 %[t0], %[m2]\n\ts_add_i32 %[cnt], %[cnt], %[t0]\n\ts_bcnt1_i32_b64 %[t1], %[m3]\n\ts_add_i32 %[cnt], %[cnt], %[t1]"
        : [cnt] "+s"(cnt), [m0] "=&s"(m0), [m1] "=&s"(m1), [m2] "=&s"(m2), [m3] "=&s"(m3), [t0] "=&s"(t0), [t1] "=&s"(t1)
        : [c] "s"(c), [k0] "v"(k0), [k1] "v"(k1), [k2] "v"(k2), [k3] "v"(k3), [k4] "v"(k4), [k5] "v"(k5), [k6] "v"(k6), [k7] "v"(k7), [k8] "v"(k8), [k9] "v"(k9), [k10] "v"(k10), [k11] "v"(k11), [k12] "v"(k12), [k13] "v"(k13), [k14] "v"(k14), [k15] "v"(k15)
        : "scc");
    return cnt;
}
__device__ __forceinline__ int count_gef16(int cnt, unsigned c, float k0, float k1, float k2, float k3, float k4, float k5, float k6, float k7, float k8, float k9, float k10, float k11, float k12, float k13, float k14, float k15) {
    unsigned long long m0, m1, m2, m3; int t0, t1;
    asm volatile("v_cmp_ge_f32_e64 %[m0], %[k0], %[c]\n\tv_cmp_ge_f32_e64 %[m1], %[k1], %[c]\n\tv_cmp_ge_f32_e64 %[m2], %[k2], %[c]\n\tv_cmp_ge_f32_e64 %[m3], %[k3], %[c]\n\ts_bcnt1_i32_b64 %[t0], %[m0]\n\tv_cmp_ge_f32_e64 %[m0], %[k4], %[c]\n\ts_add_i32 %[cnt], %[cnt], %[t0]\n\ts_bcnt1_i32_b64 %[t1], %[m1]\n\tv_cmp_ge_f32_e64 %[m1], %[k5], %[c]\n\ts_add_i32 %[cnt], %[cnt], %[t1]\n\ts_bcnt1_i32_b64 %[t0], %[m2]\n\tv_cmp_ge_f32_e64 %[m2], %[k6], %[c]\n\ts_add_i32 %[cnt], %[cnt], %[t0]\n\ts_bcnt1_i32_b64 %[t1], %[m3]\n\tv_cmp_ge_f32_e64 %[m3], %[k7], %[c]\n\ts_add_i32 %[cnt], %[cnt], %[t1]\n\ts_bcnt1_i32_b64 %[t0], %[m0]\n\tv_cmp_ge_f32_e64 %[m0], %[k8], %[c]\n\ts_add_i32 %[cnt], %[cnt], %[t0]\n\ts_bcnt1_i32_b64 %[t1], %[m1]\n\tv_cmp_ge_f32_e64 %[m1], %[k9], %[c]\n\ts_add_i32 %[cnt], %[cnt], %[t1]\n\ts_bcnt1_i32_b64 %[t0], %[m2]\n\tv_cmp_ge_f32_e64 %[m2], %[k10], %[c]\n\ts_add_i32 %[cnt], %[cnt], %[t0]\n\ts_bcnt1_i32_b64 %[t1], %[m3]\n\tv_cmp_ge_f32_e64 %[m3], %[k11], %[c]\n\ts_add_i32 %[cnt], %[cnt], %[t1]\n\ts_bcnt1_i32_b64 %[t0], %[m0]\n\tv_cmp_ge_f32_e64 %[m0], %[k12], %[c]\n\ts_add_i32 %[cnt], %[cnt], %[t0]\n\ts_bcnt1_i32_b64 %[t1], %[m1]\n\tv_cmp_ge_f32_e64 %[m1], %[k13], %[c]\n\ts_add_i32 %[cnt], %[cnt], %[t1]\n\ts_bcnt1_i32_b64 %[t0], %[m2]\n\tv_cmp_ge_f32_e64 %[m2], %[k14], %[c]\n\ts_add_i32 %[cnt], %[cnt], %[t0]\n\ts_bcnt1_i32_b64 %[t1], %[m3]\n\tv_cmp_ge_f32_e64 %[m3], %[k15], %[c]\n\ts_add_i32 %[cnt], %[cnt], %[t1]\n\ts_bcnt1_i32_b64 %[t0], %[m0]\n\ts_add_i32 %[cnt], %[cnt], %[t0]\n\ts_bcnt1_i32_b64 %[t1], %[m1]\n\ts_add_i32 %[cnt], %[cnt], %[t1]\n\ts_bcnt1_i32_b64 %[t0], %[m2]\n\ts_add_i32 %[cnt], %[cnt], %[t0]\n\ts_bcnt1_i32_b64 %[t1], %[m3]\n\ts_add_i32 %[cnt], %[cnt], %[t1]"
        : [cnt] "+s"(cnt), [m0] "=&s"(m0), [m1] "=&s"(m1), [m2] "=&s"(m2), [m3] "=&s"(m3), [t0] "=&s"(t0), [t1] "=&s"(t1)
        : [c] "s"(c), [k0] "v"(k0), [k1] "v"(k1), [k2] "v"(k2), [k3] "v"(k3), [k4] "v"(k4), [k5] "v"(k5), [k6] "v"(k6), [k7] "v"(k7), [k8] "v"(k8), [k9] "v"(k9), [k10] "v"(k10), [k11] "v"(k11), [k12] "v"(k12), [k13] "v"(k13), [k14] "v"(k14), [k15] "v"(k15)
        : "scc");
    return cnt;
}
__device__ __forceinline__ unsigned key2f(unsigned k) { return (k & 0x80000000u) ? (k ^ 0x80000000u) : ~k; }
constexpr unsigned B3_KLO = 0x00800000u, B3_KHI = 0xFF800000u;
template <int NBITS> __device__ __forceinline__ int wave_total_u8(unsigned v) {
    int t = 0;
#pragma unroll
    for (int b = 0; b < NBITS; ++b) t += __popcll(__ballot(((v >> b) & 1u) != 0u)) << b;
    return t;
}
template <int NBITS> __device__ __forceinline__ unsigned wave_excl_prefix(unsigned v, int) {
    unsigned s = 0u;
#pragma unroll
    for (int b = 0; b < NBITS; ++b) { const unsigned long long m = __ballot(((v >> b) & 1u) != 0u);
        s += __builtin_amdgcn_mbcnt_hi((unsigned)(m >> 32), __builtin_amdgcn_mbcnt_lo((unsigned)m, 0u)) << b; }
    return s;
}

__device__ __forceinline__ void phase_B3(char* lds, const u16* QB, const u16* KB, const u16* VB, const u16* QI, const u16* KI, const float* WI, float* SCR, unsigned char* AOQ, float* RFO, int vcu, int G) {
    constexpr int r_sc = B3_REP_SC, r_tk = B3_REP_TK, r_sp = B3_REP_SP;
    const int wid = __builtin_amdgcn_readfirstlane(opaque_tid() >> 6);
    float* myscr = SCR + (size_t)((vcu * NWAVES + wid) * 4) * SEQ;
    for (int U = vcu; U < NB * 256; U += G) {
        const int b = U >> 8, tt = U & 255, t = (b & 1) ? 255 - tt : tt, q0 = 32 * t;
        const size_t brow = (size_t)b * SEQ;
        const size_t mrow0 = brow + q0 + 4 * wid;
#pragma unroll 1
        for (int rsc_ = 0; rsc_ < r_sc; ++rsc_) {
            const int tid = opaque_tid(), lane = tid & 63, r32 = lane & 31, hi = lane >> 5;
            const int sr = tid >> 4, sc = (tid & 15) * 8, kws = kswz(sr, sc * 2);
            s16x8 af[2][8]; float wr[2][16];
#pragma unroll
            for (int rb = 0; rb < 2; ++rb) {
#pragma unroll
                for (int ks = 0; ks < 8; ++ks) af[rb][ks] = *(const s16x8*)(QI + (mrow0 + 2 * rb + (r32 >> 4)) * DM + (r32 & 15) * 128 + 16 * ks + 8 * hi);
#pragma unroll
                for (int i = 0; i < 16; ++i) wr[rb][i] = WI[(mrow0 + 2 * rb + (i >> 3)) * 16 + (i & 3) + 8 * ((i >> 2) & 1) + 4 * hi];
            }
            const int nkt = (q0 + 32 + 127) >> 7;
            const u16* kip = KI + (brow + sr) * 128 + sc;
            s16x8 st0 = *(const s16x8*)kip, st1 = *(const s16x8*)(kip + 32 * 128), st2 = *(const s16x8*)(kip + 64 * 128), st3 = *(const s16x8*)(kip + 96 * 128);
            *(s16x8*)(lds + kws) = st0; *(s16x8*)(lds + kws + 32 * 256) = st1; *(s16x8*)(lds + kws + 64 * 256) = st2; *(s16x8*)(lds + kws + 96 * 256) = st3;
            __syncthreads();
            for (int kt = 0; kt < nkt; ++kt) {
                const char* buf = lds + (kt & 1) * 32768;
                if (kt + 1 < nkt) { const u16* kn = kip + (size_t)(kt + 1) * 128 * 128;
                    st0 = *(const s16x8*)kn; st1 = *(const s16x8*)(kn + 32 * 128); st2 = *(const s16x8*)(kn + 64 * 128); st3 = *(const s16x8*)(kn + 96 * 128); }
                s16x8 bf[8];
#pragma unroll
                for (int ks = 0; ks < 8; ++ks) bf[ks] = *(const s16x8*)(buf + kswz(r32, (16 * ks + 8 * hi) * 2));
                f32x16v aA0, aA1, aB0, aB1; float s00 = 0.f, s01 = 0.f, s10 = 0.f, s11 = 0.f;
#define B3_MM(a0_, a1_, ks_) do { a0_ = __builtin_amdgcn_mfma_f32_32x32x16_f16(__builtin_bit_cast(h16x8, af[0][ks_]), __builtin_bit_cast(h16x8, bf[ks_]), a0_, 0, 0, 0); \
                                   a1_ = __builtin_amdgcn_mfma_f32_32x32x16_f16(__builtin_bit_cast(h16x8, af[1][ks_]), __builtin_bit_cast(h16x8, bf[ks_]), a1_, 0, 0, 0); } while (0)
#define B3_RELU(x_) __builtin_amdgcn_fmed3f((x_), 0.f, __builtin_inff())
#define B3_SLICE(a0_, a1_, ks_, kbn_, REFILL, e0_, e1_, DOEPI) do { B3_MM(a0_, a1_, ks_); \
                    if (REFILL) bf[ks_] = *(const s16x8*)(buf + kswz(32 * (kbn_) + r32, (16 * (ks_) + 8 * hi) * 2)); \
                    if (DOEPI) { s00 += wr[0][ks_] * B3_RELU(e0_[ks_]); s01 += wr[0][8 + (ks_)] * B3_RELU(e0_[8 + (ks_)]); s10 += wr[1][ks_] * B3_RELU(e1_[ks_]); s11 += wr[1][8 + (ks_)] * B3_RELU(e1_[8 + (ks_)]); } \
                    __builtin_amdgcn_sched_barrier(0); } while (0)
#define B3_FIN(kb2_) do { const auto x0 = __builtin_amdgcn_permlane32_swap(__float_as_uint(s00), __float_as_uint(s01), false, false); \
                    const auto x1 = __builtin_amdgcn_permlane32_swap(__float_as_uint(s10), __float_as_uint(s11), false, false); \
                    const int kcol = kt * 128 + (kb2_) * 32 + r32; \
                    myscr[(size_t)(0 + hi) * SEQ + kcol] = __uint_as_float(x0[0]) + __uint_as_float(x0[1]);     \
                    myscr[(size_t)(2 + hi) * SEQ + kcol] = __uint_as_float(x1[0]) + __uint_as_float(x1[1]); s00 = 0.f; s01 = 0.f; s10 = 0.f; s11 = 0.f; } while (0)
#define B3_BLOCK(a0_, a1_, kb_, REFILL, e0_, e1_, DOEPI) do { a0_ = (f32x16v){}; a1_ = (f32x16v){}; \
                    B3_SLICE(a0_, a1_, 0, (kb_) + 1, REFILL, e0_, e1_, DOEPI); B3_SLICE(a0_, a1_, 1, (kb_) + 1, REFILL, e0_, e1_, DOEPI); B3_SLICE(a0_, a1_, 2, (kb_) + 1, REFILL, e0_, e1_, DOEPI); B3_SLICE(a0_, a1_, 3, (kb_) + 1, REFILL, e0_, e1_, DOEPI); \
                    B3_SLICE(a0_, a1_, 4, (kb_) + 1, REFILL, e0_, e1_, DOEPI); B3_SLICE(a0_, a1_, 5, (kb_) + 1, REFILL, e0_, e1_, DOEPI); B3_SLICE(a0_, a1_, 6, (kb_) + 1, REFILL, e0_, e1_, DOEPI); B3_SLICE(a0_, a1_, 7, (kb_) + 1, REFILL, e0_, e1_, DOEPI); \
                    if (DOEPI) { B3_FIN((kb_) - 1); __builtin_amdgcn_sched_barrier(0); } } while (0)
                __builtin_amdgcn_sched_barrier(0);
                B3_BLOCK(aA0, aA1, 0, true, aA0, aA1, false);
                B3_BLOCK(aB0, aB1, 1, true, aA0, aA1, true);
                B3_BLOCK(aA0, aA1, 2, true, aB0, aB1, true);
                B3_BLOCK(aB0, aB1, 3, false, aA0, aA1, true);
#pragma unroll
                for (int i = 0; i < 8; ++i) { s00 += wr[0][i] * B3_RELU(aB0[i]); s01 += wr[0][8 + i] * B3_RELU(aB0[8 + i]); s10 += wr[1][i] * B3_RELU(aB1[i]); s11 += wr[1][8 + i] * B3_RELU(aB1[8 + i]); }
                B3_FIN(3);
#undef B3_SLICE
#undef B3_FIN
#undef B3_RELU
#undef B3_MM
#undef B3_EPI
#undef B3_BLOCK
                if (kt + 1 < nkt) { char* nb = lds + ((kt + 1) & 1) * 32768; *(s16x8*)(nb + kws) = st0; *(s16x8*)(nb + kws + 32 * 256) = st1; *(s16x8*)(nb + kws + 64 * 256) = st2; *(s16x8*)(nb + kws + 96 * 256) = st3; }
                __syncthreads();
            }
        }
        VM_WAIT();
        unsigned fprev = 0xBF800000u;
        unsigned tprev = 0xBF800000u;
#pragma unroll 1
        for (int qq = 0; qq < 4; ++qq) {
            const int lane = opaque_tid() & 63, l15 = lane & 15, kq = lane >> 4;
            unsigned* idxl = (unsigned*)(lds + B3_IDX_OFF + wid * 2048);
#pragma unroll
            for (int j = 0; j < 4; ++j) idxl[lane + 64 * j] = 0u;
            asm volatile("" ::: "memory");
            const int qpos = q0 + 4 * wid + qq, n = qpos + 1;
            const size_t token = brow + qpos;
            const float* srow = myscr + (size_t)qq * SEQ;
            h16x8 qb[4];
#define B3_QLOAD() do { int qp_ = qpos; asm volatile("" : "+s"(qp_)); const int ln_ = opaque_lane(); const u16* qa_ = QB + (brow + (size_t)qp_) * DM + (ln_ & 15) * 128 + 8 * (ln_ >> 4);     \
        _Pragma("unroll") for (int ks_ = 0; ks_ < 4; ++ks_) qb[ks_] = *(const h16x8*)(qa_ + 32 * ks_); } while (0)
            int count = 0;
#pragma unroll 1
            for (int rtk_ = 0; rtk_ < r_tk; ++rtk_) {
            if (n <= 256) {
                { const int ln_ = opaque_lane();
#pragma unroll
                for (int j = 0; j < 4; ++j) idxl[ln_ + 64 * j] = (ln_ + 64 * j < n) ? (unsigned)(ln_ + 64 * j) : 0u; }
                count = n; B3_QLOAD();
            } else {
                unsigned lo = 0u, hi = 0u; bool have_lo = false, have_hi = false;
                bool done = false; int C = 0;
                float* ks = (float*)(lds + B3_V_OFF + wid * 8192); unsigned* ps = (unsigned*)(lds + B3_V_OFF + wid * 8192 + 4096);
                if (n > 1024) {
                    float kf[128];
#pragma unroll
                    for (int g = 0; g < 8; ++g) {
                        if (1024 * g < n) {
#pragma unroll
                            for (int i4 = 4 * g; i4 < 4 * g + 4; ++i4) { const f32x4 t = *(const f32x4*)(srow + 256 * i4 + 4 * lane); kf[4 * i4] = t.x; kf[4 * i4 + 1] = t.y; kf[4 * i4 + 2] = t.z; kf[4 * i4 + 3] = t.w; }
                        } else {
#pragma unroll
                            for (int i = 16 * g; i < 16 * g + 16; ++i) kf[i] = -__builtin_inff();
                        }
                    }
                    __builtin_amdgcn_sched_barrier(0);
#pragma unroll
                    for (int g = 0; g < 8; ++g) {
                        if (1024 * g < n && n < 1024 * (g + 1)) {
#pragma unroll
                            for (int i = 16 * g; i < 16 * g + 16; ++i) kf[i] = (256 * (i >> 2) + (i & 3) + 4 * lane < n) ? kf[i] : -__builtin_inff();
                        }
                    }
                    unsigned F = 0u, probe = fprev, step = 1u << 17;
#pragma unroll 1
                    for (;;) {
                        const unsigned cand = __builtin_amdgcn_readfirstlane(probe), cf = key2f(cand); int c = 0;
#pragma unroll
                        for (int g = 0; g < 8; ++g) {
                            if (1024 * g < n) c = count_gef16(c, cf, kf[16 * g + 0], kf[16 * g + 1], kf[16 * g + 2], kf[16 * g + 3], kf[16 * g + 4], kf[16 * g + 5], kf[16 * g + 6], kf[16 * g + 7], kf[16 * g + 8], kf[16 * g + 9], kf[16 * g + 10], kf[16 * g + 11], kf[16 * g + 12], kf[16 * g + 13], kf[16 * g + 14], kf[16 * g + 15]);
                        }
                        if (c >= 256 && c <= 960) { F = cand; C = c; break; }
                        if (c > 960) { lo = cand; have_lo = true; } else { hi = cand; have_hi = true; }
                        if (!have_hi) { if (lo >= B3_KHI - step) { hi = B3_KHI; have_hi = true; } else { probe = lo + step; step = (step < (1u << 29)) ? step << 2 : step; continue; } }
                        if (!have_lo) { if (hi <= B3_KLO + step) { lo = B3_KLO; have_lo = true; } else { probe = hi - step; step = (step < (1u << 29)) ? step << 2 : step; continue; } }
                        if (hi - lo <= 1u) break;
                        probe = lo + ((hi - lo) >> 1);
                    }
                    if (C > 0) {
                        unsigned base = 0u; const float Ff = __uint_as_float(key2f(F));
                        unsigned Fs = __builtin_amdgcn_readfirstlane(__float_as_uint(Ff));
#pragma unroll
                        for (int g = 0; g < 8; ++g) {
                            if (1024 * g < n) {
#pragma unroll
                                for (int i = 16 * g; i < 16 * g + 16; ++i) {
                                    asm volatile("" : "+s"(Fs), "+s"(base));
                                    const bool take = kf[i] >= __uint_as_float(Fs);
                                    const unsigned long long m = __ballot(take);
                                    const unsigned slot = base + __builtin_amdgcn_mbcnt_hi((unsigned)(m >> 32), __builtin_amdgcn_mbcnt_lo((unsigned)m, 0u));
                                    const unsigned a = take ? slot : (960u + (unsigned)lane);
                                    ks[a] = kf[i]; ps[a] = (unsigned)(256 * (i >> 2) + (i & 3) + 4 * lane);
                                    base += (unsigned)__popcll(m);
                                }
                            }
                        }
                        if (C == 256) { have_lo = false; have_hi = false; lo = F; }
                        else { lo = F; have_lo = true; }
                        tprev = F; fprev = F;
                    } else {
                        unsigned base = 0u;
#pragma unroll 1
                        for (int pass = 0; pass < 2; ++pass) {
                            unsigned As = __builtin_amdgcn_readfirstlane(key2f(pass == 0 ? hi : lo)), Bs = __builtin_amdgcn_readfirstlane(pass == 0 ? 0x7F800000u : key2f(lo));
#pragma unroll
                            for (int g = 0; g < 8; ++g) {
                                if (1024 * g < n) {
#pragma unroll
                                    for (int i = 16 * g; i < 16 * g + 16; ++i) {
                                        asm volatile("" : "+s"(As), "+s"(Bs), "+s"(base));
                                        const bool in = kf[i] >= __uint_as_float(As) && kf[i] <= __uint_as_float(Bs);
                                        const unsigned long long m = __ballot(in);
                                        const unsigned slot = base + __builtin_amdgcn_mbcnt_hi((unsigned)(m >> 32), __builtin_amdgcn_mbcnt_lo((unsigned)m, 0u));
                                        idxl[(in && slot < 256u) ? slot : (256u + (unsigned)lane)] = (unsigned)(256 * (i >> 2) + (i & 3) + 4 * lane);
                                        base += (unsigned)__popcll(m);
                                    }
                                }
                            }
                        }
                        tprev = lo; done = true;
                    }
                } else {
#pragma unroll
                    for (int i4 = 0; i4 < 4; ++i4) { const f32x4 t = *(const f32x4*)(srow + 256 * i4 + 4 * lane); const unsigned pos = (unsigned)(256 * i4 + 4 * lane);
                        *(f32x4*)(ks + pos) = t; *(v4u*)(ps + pos) = (v4u){pos, pos + 1u, pos + 2u, pos + 3u}; }
                    C = n;
                }
                B3_QLOAD();
                if (!done) {
                    LDS_WAIT(); asm volatile("" ::: "memory");
                    float ck[16]; unsigned cp[16];
#pragma unroll
                    for (int j = 0; j < 16; ++j) { const bool v = 64 * j + lane < C; ck[j] = v ? ks[64 * j + lane] : -__builtin_inff(); cp[j] = ps[64 * j + lane]; }
                    unsigned T = 0u, probe = tprev, step = 1u << 14;
                    if (have_lo) { if (have_hi) probe = lo + ((hi - lo) >> 1); else probe = lo + step; }
#pragma unroll 1
                    for (;;) {
                        if (have_lo && have_hi && hi - lo <= 1u) { T = lo; break; }
                        const unsigned cand = __builtin_amdgcn_readfirstlane(probe), cf = key2f(cand);
                        const int c = count_gef16(0, cf, ck[0], ck[1], ck[2], ck[3], ck[4], ck[5], ck[6], ck[7], ck[8], ck[9], ck[10], ck[11], ck[12], ck[13], ck[14], ck[15]);
                        if (c == 256) { T = cand; break; }
                        if (c > 256) { lo = cand; have_lo = true; } else { hi = cand; have_hi = true; }
                        if (!have_hi) { if (lo >= B3_KHI - step) { hi = B3_KHI; have_hi = true; } else { probe = lo + step; step = (step < (1u << 29)) ? step << 2 : step; continue; } }
                        if (!have_lo) { if (hi <= B3_KLO + step) { lo = B3_KLO; have_lo = true; } else { probe = hi - step; step = (step < (1u << 29)) ? step << 2 : step; continue; } }
                        probe = lo + ((hi - lo) >> 1);
                    }
                    tprev = T;
                    const float Tf = __uint_as_float(key2f(T));
                    unsigned cg = 0u, ce = 0u;
#pragma unroll
                    for (int j = 0; j < 16; ++j) { cg += (ck[j] > Tf) ? 1u : 0u; ce += (ck[j] == Tf) ? 1u : 0u; }
                    const int need_eq = 256 - wave_total_u8<5>(cg);
                    const int eq_room = need_eq - (int)wave_excl_prefix<5>(ce, lane);
                    unsigned erem = (eq_room <= 0) ? 0u : ((unsigned)eq_room < ce ? (unsigned)eq_room : ce);
                    unsigned off = wave_excl_prefix<5>(cg, lane) + wave_excl_prefix<5>(erem, lane);
                    const unsigned dl_ = 256u + (unsigned)opaque_lane();
#pragma unroll
                    for (int j = 0; j < 16; ++j) {
                        const bool gt = ck[j] > Tf, eqk = (ck[j] == Tf) && (erem > 0u), take = gt || eqk;
                        erem -= eqk ? 1u : 0u;
                        idxl[take ? off : dl_] = cp[j];
                        off += take ? 1u : 0u;
                    }
                }
                count = 256;
            }
            LDS_WAIT(); asm volatile("" ::: "memory");
            }
#pragma unroll 1
            for (int rsp_ = 0; rsp_ < r_sp; ++rsp_) {
            f32x4 St[16];
#define B3_KLOAD(dst, gb_) do { _Pragma("unroll") for (int g4 = 0; g4 < 4; ++g4) { const unsigned krow_ = idxl[16 * (4 * (gb_) + g4) + l15]; const u16* kp_ = KB + (brow + krow_) * 128 + 8 * kq; \
                _Pragma("unroll") for (int ks = 0; ks < 4; ++ks) dst[g4][ks] = *(const h16x8*)(kp_ + 32 * ks); } } while (0)
#define B3_KMMA(src, gb_) do { _Pragma("unroll") for (int g4 = 0; g4 < 4; ++g4) { f32x4 a_ = {0.f, 0.f, 0.f, 0.f}; \
                _Pragma("unroll") for (int ks = 0; ks < 4; ++ks) a_ = __builtin_amdgcn_mfma_f32_16x16x32_f16(src[g4][ks], qb[ks], a_, 0, 0, 0); St[4 * (gb_) + g4] = a_; } } while (0)
            {
                h16x8 kfA[4][4], kfB[4][4];
                B3_KLOAD(kfA, 0); B3_KLOAD(kfB, 1);
                B3_KMMA(kfA, 0); B3_KLOAD(kfA, 2);
                B3_KMMA(kfB, 1); B3_KLOAD(kfB, 3);
                B3_KMMA(kfA, 2); B3_KMMA(kfB, 3);
            }
#undef B3_KLOAD
#undef B3_QLOAD
#undef B3_KMMA
            char* vbuf = lds + B3_V_OFF + wid * 8192;
            h16x8 vsA[8], vsB[8], vsC[8], vsD[8];
#define B3_VLOAD(dst, c) do { _Pragma("unroll") for (int i_ = 0; i_ < 8; ++i_) { const unsigned kr_ = idxl[32 * (c) + 4 * i_ + kq]; dst[i_] = *(const h16x8*)(VB + (brow + kr_) * 128 + 8 * l15); } } while (0)
            B3_VLOAD(vsA, 0); B3_VLOAD(vsB, 1); B3_VLOAD(vsC, 2); B3_VLOAD(vsD, 3);
            float mx = -__builtin_inff();
#pragma unroll
            for (int g = 0; g < 16; ++g)
#pragma unroll
                for (int i = 0; i < 4; ++i) { const float s = (16 * g + 4 * kq + i < count) ? St[g][i] * 0.08838834764831845f : -__builtin_inff(); St[g][i] = s; mx = fmaxf(mx, s); }
            mx = fmaxf(mx, swz_xor<16>(mx));
            { auto r = __builtin_amdgcn_permlane32_swap(__float_as_uint(mx), __float_as_uint(mx), false, false); mx = fmaxf(__uint_as_float(r[0]), __uint_as_float(r[1])); }
            float sm = 0.f;
#pragma unroll
            for (int g = 0; g < 16; ++g)
#pragma unroll
                for (int i = 0; i < 4; ++i) { const float p = __expf(St[g][i] - mx); St[g][i] = p; sm += p; }
            sm += swz_xor<16>(sm); sm = add_xor32(sm);
            const float inv = 1.0f / sm;
            h16x8 pb[8];
#pragma unroll
            for (int c = 0; c < 8; ++c) { h16x8 t;
#pragma unroll
                for (int i = 0; i < 4; ++i) { t[i] = (_Float16)(St[2 * c][i] * inv); t[4 + i] = (_Float16)(St[2 * c + 1][i] * inv); }
                pb[c] = t; }
            f32x4 o[8];
#pragma unroll
            for (int db = 0; db < 8; ++db) o[db] = (f32x4){0.f, 0.f, 0.f, 0.f};
            const int wrow = kq, wf = ((wrow & 3) << 2);
            const int rq = l15 >> 2, rp = l15 & 3, rf = (rq << 2) | kq;
            const int vb0 = (int)(uintptr_t)vbuf;
            int traddr[8];
#pragma unroll
            for (int db = 0; db < 8; ++db) traddr[db] = vb0 + 256 * (4 * kq + rq) + 16 * ((2 * db + (rp >> 1)) ^ rf) + 8 * (rp & 1);
#define B3_VWRITE(src) do { _Pragma("unroll") for (int i_ = 0; i_ < 8; ++i_) *(h16x8*)(vbuf + 256 * (4 * i_ + kq) + 16 * (l15 ^ (wf | (i_ & 3)))) = src[i_]; } while (0)
#define B3_TRRD(dst, addr, off) asm volatile("ds_read_b64_tr_b16 %0, %1 offset:%2" : "=&v"(dst) : "v"(addr), "i"(off) : "memory")
#define B3_PVCHUNK(c) do { _Pragma("unroll") for (int dh = 0; dh < 2; ++dh) { s16x4v a0[4], a1[4]; \
                _Pragma("unroll") for (int d4 = 0; d4 < 4; ++d4) { B3_TRRD(a0[d4], traddr[4 * dh + d4], 0); B3_TRRD(a1[d4], traddr[4 * dh + d4], 4096); } \
                asm volatile("s_waitcnt lgkmcnt(0)" ::: "memory"); __builtin_amdgcn_sched_barrier(0); \
                _Pragma("unroll") for (int d4 = 0; d4 < 4; ++d4) { const s16x8 av = {a0[d4][0], a0[d4][1], a0[d4][2], a0[d4][3], a1[d4][0], a1[d4][1], a1[d4][2], a1[d4][3]}; \
                    o[4 * dh + d4] = __builtin_amdgcn_mfma_f32_16x16x32_f16(__builtin_bit_cast(h16x8, av), pb[c], o[4 * dh + d4], 0, 0, 0); } } } while (0)
            B3_VWRITE(vsA); B3_VLOAD(vsA, 4); B3_PVCHUNK(0);
            B3_VWRITE(vsB); B3_VLOAD(vsB, 5); B3_PVCHUNK(1);
            B3_VWRITE(vsC); B3_VLOAD(vsC, 6); B3_PVCHUNK(2);
            B3_VWRITE(vsD); B3_VLOAD(vsD, 7); B3_PVCHUNK(3);
            B3_VWRITE(vsA); B3_PVCHUNK(4);
            B3_VWRITE(vsB); B3_PVCHUNK(5);
            B3_VWRITE(vsC); B3_PVCHUNK(6);
            B3_VWRITE(vsD); B3_PVCHUNK(7);
#undef B3_VLOAD
#undef B3_VWRITE
#undef B3_TRRD
#undef B3_PVCHUNK
            { float am = 0.f;
#pragma unroll
              for (int db = 0; db < 8; ++db) am = fmaxf(am, fmaxf(fmaxf(__builtin_fabsf(o[db][0]), __builtin_fabsf(o[db][1])), fmaxf(__builtin_fabsf(o[db][2]), __builtin_fabsf(o[db][3]))));
              am = wave_max(am); const float inv = am > 0.f ? 127.0f / am : 0.f;
              if (lane == 0) RFO[token] = am * (1.0f / 127.0f);
#pragma unroll
              for (int db = 0; db < 8; ++db) *(unsigned*)(AOQ + token * DM + l15 * 128 + 16 * db + 4 * kq) = pack4_i8(o[db][0] * inv, o[db][1] * inv, o[db][2] * inv, o[db][3] * inv); }
            }
        }
    }
}

__device__ __forceinline__ att::BlockRef<u16, u16> attA_ref(int stream, int qb, const u16* Qh, const u16* Kh, const u16* Vh, u16* O) {
    const int vh = stream & 1, c = (stream >> 1) & 1, bh = stream >> 2;
    const int qk = (bh * 2 + c), vv = (bh * 2 + vh);
    att::BlockRef<u16, u16> r;
    r.Q = Qh + ((size_t)qk * SEQ + (size_t)qb * 256) * 128; r.K = Kh + (size_t)qk * SEQ * 128; r.V = Vh + (size_t)vv * SEQ * 128;
    r.O = O + ((size_t)stream * SEQ + (size_t)qb * 256) * 128; r.P0 = qb * 256;
    return r;
}
__device__ __forceinline__ void phase_attnA(char* lds, const u16* Qh, const u16* Kh, const u16* Vh, u16* O, int vcu, int G) {
    constexpr int total = NB * 8 * 4 * 16;
    int L = vcu; if (L >= total) return;
    int pass = 0;
    att::BlockRef<u16, u16> cur = attA_ref(L >> 4, (L & 15), Qh, Kh, Vh, O);
    att::Seam<u16> S;
    att::causal_swa_prime<u16, u16>(cur, SEQ, lds, S);
    for (;;) {
        const bool more_pass = pass == 0, more_item = L + G < total, last = !more_pass && !more_item;
        int passn = pass + 1, Ln = L;
        if (!more_pass) { passn = 0; Ln = more_item ? L + G : L; }
        const int xn = Ln & 15;
        const att::BlockRef<u16, u16> nxt = last ? cur : attA_ref(Ln >> 4, passn ? 31 - xn : xn, Qh, Kh, Vh, O);
        att::causal_swa_block<u16, u16>(cur, nxt, SEQ, SEQ, lds, S);
        if (last) break;
        cur = nxt; pass = passn; L = Ln;
    }
}


namespace att {
constexpr int A2_K = 0, A2_V0 = 32768, A2_V1 = 65536, A2_P01 = 114688, A2_X = 132096, A2_P23 = 136192;

__device__ __forceinline__ void pv_tile2(f32x16* o, int vb, bf16x8 pa0, bf16x8 pa1, bf16x8 pa2, bf16x8 pa3) {
#define TRRD2(dst, off) asm volatile("ds_read_b64_tr_b16 %0, %1 offset:%2" : "=&v"(dst) : "v"(vb), "i"(off) : "memory")
#define PV_LD(S, ks) do { TRRD2(S##l0, v_rd_off(0, ks, 0)); TRRD2(S##h0, v_rd_off(0, ks, 1)); TRRD2(S##l1, v_rd_off(1, ks, 0)); TRRD2(S##h1, v_rd_off(1, ks, 1)); \
        TRRD2(S##l2, v_rd_off(2, ks, 0)); TRRD2(S##h2, v_rd_off(2, ks, 1)); TRRD2(S##l3, v_rd_off(3, ks, 0)); TRRD2(S##h3, v_rd_off(3, ks, 1)); } while (0)
#define PV_MM(S, pa) do { \
        o[0] = mfma32h(pa, (bf16x8){S##l0[0], S##l0[1], S##l0[2], S##l0[3], S##h0[0], S##h0[1], S##h0[2], S##h0[3]}, o[0], 0, 0, 0); \
        o[1] = mfma32h(pa, (bf16x8){S##l1[0], S##l1[1], S##l1[2], S##l1[3], S##h1[0], S##h1[1], S##h1[2], S##h1[3]}, o[1], 0, 0, 0); \
        o[2] = mfma32h(pa, (bf16x8){S##l2[0], S##l2[1], S##l2[2], S##l2[3], S##h2[0], S##h2[1], S##h2[2], S##h2[3]}, o[2], 0, 0, 0); \
        o[3] = mfma32h(pa, (bf16x8){S##l3[0], S##l3[1], S##l3[2], S##l3[3], S##h3[0], S##h3[1], S##h3[2], S##h3[3]}, o[3], 0, 0, 0); } while (0)
    s16x4 Al0, Ah0, Al1, Ah1, Al2, Ah2, Al3, Ah3, Bl0, Bh0, Bl1, Bh1, Bl2, Bh2, Bl3, Bh3;
    PV_LD(A, 0); PV_LD(B, 1);
    asm volatile("s_waitcnt lgkmcnt(8)" ::: "memory"); SBAR(); PV_MM(A, pa0); SBAR();
    PV_LD(A, 2);
    asm volatile("s_waitcnt lgkmcnt(8)" ::: "memory"); SBAR(); PV_MM(B, pa1); SBAR();
    PV_LD(B, 3);
    asm volatile("s_waitcnt lgkmcnt(8)" ::: "memory"); SBAR(); PV_MM(A, pa2); SBAR();
    asm volatile("s_waitcnt lgkmcnt(0)" ::: "memory"); SBAR(); PV_MM(B, pa3);
#undef PV_MM
#undef PV_LD
#undef TRRD2
}
__device__ __forceinline__ void qkt2(f32x16& p0, f32x16& p1, const char* Kt, int r32, int hi, const bf16x8* qr) {
    p0 = f32x16{}; p1 = f32x16{};
    const char* kb[4];
#pragma unroll
    for (int dd = 0; dd < 4; ++dd) kb[dd] = Kt + KSWZ(r32, (dd * 16 + hi * 8) * 2);
    bf16x8 c0 = *reinterpret_cast<const bf16x8*>(kb[0]), c1 = *reinterpret_cast<const bf16x8*>(kb[0] + 32 * 256);
#pragma unroll
    for (int d0 = 0; d0 < 8; ++d0) {
        bf16x8 n0 = c0, n1 = c1;
        if (d0 < 7) { const char* a = kb[(d0 + 1) & 3] + ((d0 + 1) >> 2) * 128; n0 = *reinterpret_cast<const bf16x8*>(a); n1 = *reinterpret_cast<const bf16x8*>(a + 32 * 256); }
        SBAR();
        p0 = mfma32h(c0, qr[d0], p0, 0, 0, 0);
        p1 = mfma32h(c1, qr[d0], p1, 0, 0, 0);
        SBAR();
        c0 = n0; c1 = n1;
    }
}
__device__ __forceinline__ void qkt3(f32x16& p0, f32x16& p1, const char* Kt, int r32, int hi, const bf16x8* qr) {
    p0 = f32x16{}; p1 = f32x16{};
    const char* kb[4];
#pragma unroll
    for (int dd = 0; dd < 4; ++dd) kb[dd] = Kt + KSWZ(r32, (dd * 16 + hi * 8) * 2);
#pragma unroll
    for (int d0 = 0; d0 < 8; ++d0) { const char* a = kb[d0 & 3] + (d0 >> 2) * 128;
        const bf16x8 b0 = *reinterpret_cast<const bf16x8*>(a), b1 = *reinterpret_cast<const bf16x8*>(a + 32 * 256);
        p0 = mfma32h(b0, qr[d0], p0, 0, 0, 0);
        p1 = mfma32h(b1, qr[d0], p1, 0, 0, 0); }
}
#define A2_BAR() do { asm volatile("s_waitcnt lgkmcnt(0)" ::: "memory"); __builtin_amdgcn_s_barrier(); asm volatile("" ::: "memory"); } while (0)
__device__ __forceinline__ void attnA2_block(const u16* Q, const u16* K, const u16* V0, const u16* V1, u16* O, int P0, char* lds) {
    const int tid = opaque_tid(), wid = __builtin_amdgcn_readfirstlane(tid >> 6), lane = tid & 63, r32 = lane & 31, hi = lane >> 5;
    const bool heavy = wid < 4; const int w4 = wid & 3;
    const int NT = P0 / KVBLK + 2;
    char* K_lds = lds + A2_K; char* Va = lds + A2_V0; char* Vb = lds + A2_V1;
    char* Pw = lds + (w4 < 2 ? A2_P01 + w4 * 8192 : A2_P23 + (w4 - 2) * 8192);
    float* al = (float*)(lds + A2_X + w4 * 512); unsigned* fl = (unsigned*)(al + 64); float* lf = al + 96;
    const int vb0 = (int)(uintptr_t)(heavy ? Va : Vb) + v_rd_base(lane);
    bf16x8 qr[8];
    if (heavy) {
#pragma unroll
        for (int d0 = 0; d0 < 8; ++d0) qr[d0] = load8<u16>(Q + (size_t)(w4 * QBLK + r32) * D + d0 * 16 + hi * 8);
    }
    const int lt = tid & 255, sc = (lt & 15) * 8;
    bf16x8 sk[4], sa[4], sb[4];
#define A2_LOADK(k0) do { _Pragma("unroll") for (int i_ = 0; i_ < 4; ++i_) sk[i_] = load8<u16>(K + (size_t)((k0) + (lt >> 4) + 16 * i_) * D + sc); } while (0)
#define A2_LOADV(k0) do { _Pragma("unroll") for (int i_ = 0; i_ < 4; ++i_) { const size_t ro_ = (size_t)((k0) + (lt >> 4) + 16 * i_) * D + sc; sa[i_] = load8<u16>(V0 + ro_); sb[i_] = load8<u16>(V1 + ro_); } } while (0)
#define A2_WRITEK(bf) do { _Pragma("unroll") for (int i_ = 0; i_ < 4; ++i_) { const int row_ = (lt >> 4) + 16 * i_; *(bf16x8*)(K_lds + (bf) * SHM_K + KSWZ(row_, sc * 2)) = sk[i_]; } } while (0)
#define A2_WRITEV(bf, bf3) do { _Pragma("unroll") for (int i_ = 0; i_ < 4; ++i_) { const int vs_ = v_st((lt >> 4) + 16 * i_, sc); *(bf16x8*)(Va + (bf) * SHM_V + vs_) = sa[i_]; *(bf16x8*)(Vb + (bf3) * SHM_V + vs_) = sb[i_]; } } while (0)
    if (!heavy) { A2_LOADK(0); A2_LOADV(0); asm volatile("s_waitcnt vmcnt(0)" ::: "memory"); A2_WRITEK(0); A2_WRITEV(0, 0); A2_LOADK(KVBLK); asm volatile("s_waitcnt vmcnt(0)" ::: "memory"); A2_WRITEK(1);
        if (2 < NT) A2_LOADK(2 * KVBLK); A2_LOADV(KVBLK); }
    A2_BAR();
    f32x16 o[4] = {};
    if (heavy) {
        float m_reg = -1e30f, l_reg = 0.f;
        const int qlo = P0 + w4 * QBLK, qm = qlo + r32 - 4 * hi;
        f32x16 pc0, pc1;
        qkt2(pc0, pc1, K_lds, r32, hi, qr);
        A2_BAR();
#pragma unroll 1
        for (int t = 0; t <= NT; ++t) {
            if (t < NT) {
                const int bf = t & 1; f32x16 pn0, pn1; float mn, alpha; bf16x8 pa0, pa1, pa2, pa3;
                { const int kb = t * KVBLK; if (kb + KVBLK - 1 > qlo) mask_tile(pc0, pc1, qm - kb, (unsigned)SEQ); }
                partialSM(pc0, pc1, m_reg, mn, alpha);
                qkt3(pn0, pn1, K_lds + ((t + 1) & 1) * SHM_K, r32, hi, qr);
                finishSM(pc0, pc1, alpha, l_reg, pa0, pa1, pa2, pa3);
#pragma unroll
                for (int g_ = 0; g_ < 16; ++g_) { __builtin_amdgcn_sched_group_barrier(0x100, 1, 0); __builtin_amdgcn_sched_group_barrier(0x008, 1, 0); __builtin_amdgcn_sched_group_barrier(0x002, 8, 0); }
                SBAR();
                const bool rs = __any(alpha < 1.f);
                if (rs) { if (hi == 0) al[bf * 32 + r32] = alpha; asm volatile("s_waitcnt lgkmcnt(0)" ::: "memory");
#pragma unroll
                    for (int d_ = 0; d_ < 4; ++d_)
#pragma unroll
                        for (int r = 0; r < 16; ++r) o[d_][r] *= al[bf * 32 + crow(r, hi)]; }
                if (lane == 0) fl[bf] = rs ? 1u : 0u;
                *(bf16x8*)(Pw + bf * 4096 + lane * 16) = pa0; *(bf16x8*)(Pw + bf * 4096 + 1024 + lane * 16) = pa1; *(bf16x8*)(Pw + bf * 4096 + 2048 + lane * 16) = pa2; *(bf16x8*)(Pw + bf * 4096 + 3072 + lane * 16) = pa3;
                if (t == NT - 1 && hi == 0) lf[r32] = l_reg;
                SBAR();
                pv_tile2(o, vb0 + bf * SHM_V, pa0, pa1, pa2, pa3);
                pc0 = pn0; pc1 = pn1;
            }
            A2_BAR();
        }
    } else {
        A2_BAR();
#pragma unroll 1
        for (int t = 0; t <= NT; ++t) {
            asm volatile("s_waitcnt vmcnt(0)" ::: "memory");
            if (t + 2 < NT) A2_WRITEK(t & 1);
            if (t + 1 < NT) A2_WRITEV((t + 1) & 1, (t + 1) % 3);
            if (t + 3 < NT) A2_LOADK((t + 3) * KVBLK);
            if (t + 2 < NT) A2_LOADV((t + 2) * KVBLK);
            SBAR();
            if (t >= 1) {
                const int bf = (t - 1) & 1, bf3 = (t - 1) % 3;
                const unsigned f = __builtin_amdgcn_readfirstlane(fl[bf]);
                if (f) {
#pragma unroll
                    for (int d_ = 0; d_ < 4; ++d_)
#pragma unroll
                        for (int r = 0; r < 16; ++r) o[d_][r] *= al[bf * 32 + crow(r, hi)]; }
                const bf16x8 pa0 = *(const bf16x8*)(Pw + bf * 4096 + lane * 16), pa1 = *(const bf16x8*)(Pw + bf * 4096 + 1024 + lane * 16), pa2 = *(const bf16x8*)(Pw + bf * 4096 + 2048 + lane * 16), pa3 = *(const bf16x8*)(Pw + bf * 4096 + 3072 + lane * 16);
                asm volatile("s_waitcnt lgkmcnt(0)" ::: "memory"); SBAR();
                pv_tile2(o, vb0 + bf3 * SHM_V, pa0, pa1, pa2, pa3);
            }
            A2_BAR();
        }
    }
#undef A2_LOADK
#undef A2_LOADV
#undef A2_WRITEK
#undef A2_WRITEV
    float rli[16];
#pragma unroll
    for (int r = 0; r < 16; ++r) rli[r] = __builtin_amdgcn_rcpf(lf[crow(r, hi)]);
    u16* Ow = O + (size_t)(w4 * QBLK) * 256 + (heavy ? 0 : 128);
#pragma unroll
    for (int r = 0; r < 16; ++r) { const int orow = crow(r, hi);
#pragma unroll
        for (int d0 = 0; d0 < 4; ++d0) { const float v = o[d0][r] * rli[r]; const float vn = swz_xor<1>(v);
            if ((r32 & 1) == 0) *(unsigned*)(Ow + (size_t)orow * 256 + d0 * 32 + r32) = cvtpk(v, vn); } }
    A2_BAR();
}
#undef A2_BAR
}
__device__ __forceinline__ void phase_attnA2(char* lds, const u16* Qh, const u16* Kh, const u16* Vh, u16* O, int vcu, int G) {
    for (int L = vcu; L < NB * 8 * 2 * 32; L += G) {
        const int s = L >> 5, y = L & 31, bh = s >> 1;
        const u16* Kp = Kh + (size_t)s * SEQ * 128; const u16* V0 = Vh + (size_t)(bh * 2) * SEQ * 128; const u16* V1 = Vh + (size_t)(bh * 2 + 1) * SEQ * 128;
#pragma unroll 1
        for (int pass = 0; pass < 2; ++pass) { const int P0 = (pass ? 63 - y : y) * 128;
            att::attnA2_block(Qh + ((size_t)s * SEQ + P0) * 128, Kp, V0, V1, O + ((size_t)s * SEQ + P0) * 256, P0, lds); }
    }
}
struct Args { const float* in[22]; float* out; unsigned char* ws; int ph_lo, ph_hi; int rep[8]; };
typedef const __attribute__((address_space(4))) unsigned long long* kargp_t;
__device__ __forceinline__ unsigned long long karg_u64(int idx) { asm volatile("" : "+s"(idx)); return ((kargp_t)__builtin_amdgcn_kernarg_segment_ptr())[idx]; }
#define KIN(i) ((const float*)(const __attribute__((address_space(1))) float*)karg_u64(i))
#define KOUT() ((float*)(__attribute__((address_space(1))) float*)karg_u64(22))
#define KREP(i) ((int)(karg_u64(25 + ((i) >> 1)) >> (32 * ((i) & 1))))
#define KWS() ((unsigned char*)(__attribute__((address_space(1))) unsigned char*)karg_u64(23))
#define FRAME() const int tid = opaque_tid(), lane = tid & 63, wave = __builtin_amdgcn_readfirstlane(tid >> 6); const int G = gridDim.x, bx = blockIdx.x; \
    const int vcu = (G % 8 == 0) ? (bx % 8) * (G / 8) + bx / 8 : bx; const int gw = vcu * NWAVES + wave, NGW = G * NWAVES; (void)lane; (void)gw; (void)NGW; (void)vcu; (void)bx
__global__ void __launch_bounds__(NWAVES * 64, 2) fwd_kernel(Args args) {
    extern __shared__ __attribute__((aligned(16))) unsigned char lds[];
    LAS unsigned char* L3 = (LAS unsigned char*)lds;
    volatile LAS unsigned* MISC = (volatile LAS unsigned*)(L3 + MISC_OFF);
    if (threadIdx.x < 32) MISC[threadIdx.x] = 0u;
    if ((threadIdx.x & 63) == 0) ((volatile LAS int*)(L3 + TIDTAB_OFF))[hw_wave_slot()] = (int)(threadIdx.x >> 6);
    __syncthreads();
    { XcdBarrier b0 = xcd_barrier_post((unsigned*)(KWS() + WS_CTL) + CW_BAR, MISC + 8); (void)b0; }
    int ph = 0; const int lo = args.ph_lo, hi = args.ph_hi;
#define IN() (lo <= ph && ph < hi)
#define OPQ_LS() int li = li0, s = s0; asm volatile("" : "+s"(li), "+s"(s)); (void)li; (void)s
#define SEAM() do { if (lo <= ph && ph + 1 < hi) { XcdBarrier b_; b_.bar = (unsigned*)(KWS() + WS_CTL) + CW_BAR; b_.x = xb_xcc_id(); b_.st = MISC + 8; xcd_barrier(b_); } ++ph; } while (0)

    if (IN()) {
        FRAME(); unsigned char* ws = KWS();
        LAS float* scr = (LAS float*)(L3 + wave * 16384);
        { const float* cin = KIN(1); const float* adaw = KIN(2); float* modp = (float*)(ws + WS_MODP);
          for (int it = gw; it < 4 * 72 * 8; it += NGW) p0_ada_item(cin, adaw, modp, it, scr, lane); }
        constexpr int I_BIN = 32 * 144;
        for (int it = gw; it < 2 * I_BIN; it += NGW) { const int mj = it / I_BIN, q = it % I_BIN, kb = q / 144, nb = q % 144;
            p0_transpose_item(KIN(16) + (size_t)mj * DM * B_IN, DM, B_IN, (u16*)(ws + WS_WBIN) + (size_t)mj * B_INP * DM, 32 * nb, 64 * kb, 32 * nb, scr, lane); }
        { float* cost = (float*)(ws + WS_COS); float* sint = (float*)(ws + WS_SIN); float* costi = (float*)(ws + WS_COSI); float* sinti = (float*)(ws + WS_SINI);
          for (int e = gw * 64 + lane; e < SEQ * 64; e += NGW * 64) { float co, si; sincos_d((double)(e >> 6) * powi_d(0.8659643233600653, e & 63), co, si); cost[e] = co; sint[e] = si; }
          for (int e = gw * 64 + lane; e < SEQ * 32; e += NGW * 64) { float co, si; sincos_d((double)(e >> 5) * powi_d(0.7498942093324559, e & 31), co, si); costi[e] = co; sinti[e] = si; } }
    }
    SEAM();
    if (IN()) {
        FRAME(); unsigned char* ws = KWS(); const float* adab = KIN(3); const float* modp = (const float*)(ws + WS_MODP); float* mod = (float*)(ws + WS_MOD);
        for (int e = gw * 64 + lane; e < DEPTH * NB * ADAW; e += NGW * 64) {
            const int layer = e / (NB * ADAW), col = e % ADAW;
            float s = adab[layer * ADAW + col];
#pragma unroll
            for (int kc = 0; kc < 8; ++kc) s += modp[(size_t)kc * DEPTH * NB * ADAW + e];
            const int slot = col / DM; mod[e] = (slot == 2 || slot == 8) ? 0.5f * s : s;
        }
    }
    SEAM();
    if (IN()) {
        FRAME(); unsigned char* ws = KWS(); const float* mod = (const float*)(ws + WS_MOD); float* bias = (float*)(ws + WS_BIAS);
        constexpr int S_GU = 16 * 176, S_AIN = 2 * 192, S_OUT = 4 * 64, S_DN = 8 * 128, S_BQ = 2 * (B_QKV / 32);
        for (int st = bx; st < S_GU + S_AIN + S_OUT + S_DN + S_BQ; st += G) {
            if (st >= S_GU + S_AIN + S_OUT + S_DN) { const int r = st - (S_GU + S_AIN + S_OUT + S_DN), mj = r / (B_QKV / 32), n0 = 32 * (r % (B_QKV / 32));
                p0w_strip<DM, 32, false>(KIN(16) + (size_t)mj * DM * B_IN, B_IN, n0, ws + WS_WQB + ((size_t)mj * B_QKV + n0) * DM, (float*)(ws + WS_TQB) + (size_t)mj * B_QKV + n0, nullptr, nullptr, 0, L3, tid);
            } else if (st < S_GU) { const int mi = st / 176, nb = st % 176, lj = mi >> 1, isup = mi & 1, n0 = 32 * nb, li = lj >> 1, sl = (lj & 1) * 2, q = 3 * li + sl;
                const int drow0 = 256 * (n0 >> 7) + (n0 & 127) + 128 * isup;
                p0w_strip<DM, 32, true>(KIN(4 + isup) + (size_t)lj * DM * DFF, DFF, n0, ws + WS_WQ + ((size_t)lj * GU_N + drow0) * DM, (float*)(ws + WS_TQ) + (size_t)lj * GU_N + drow0,
                                        mod + (size_t)li * NB * ADAW + (3 * sl) * DM, bias + (size_t)(q * 4) * GU_N + drow0, GU_N, L3, tid);
            } else if (st < S_GU + S_AIN) { const int r = st - S_GU, mj = r / 192, nb = r % 192, n0 = 32 * nb, li = 2 * mj, q = 3 * li + 1;
                const int chunk = n0 >> 7, d = n0 & 127, drow0 = (n0 < 4096) ? 256 * (chunk >> 1) + 128 * (d >> 6) + 64 * (chunk & 1) + 32 * ((d >> 5) & 1) : n0;
                p0w_strip<DM, 32, true>(KIN(7) + (size_t)mj * DM * A_IN, A_IN, n0, ws + WS_WQA + ((size_t)mj * A_IN + drow0) * DM, (float*)(ws + WS_TQA) + (size_t)mj * A_IN + drow0,
                                        mod + (size_t)li * NB * ADAW + 3 * DM, bias + (size_t)(q * 4) * GU_N + drow0, GU_N, L3, tid);
            } else if (st < S_GU + S_AIN + S_OUT) { const int r = st - S_GU - S_AIN, mi = r / 64, nb = r % 64, n0 = 32 * nb;
                const float* Wsrc = (mi < 2) ? KIN(8) + (size_t)mi * DM * DM : KIN(17) + (size_t)(mi - 2) * DM * DM;
                p0w_strip<DM, 32, false>(Wsrc, DM, n0, ws + WS_WOQ + ((size_t)mi * DM + n0) * DM, (float*)(ws + WS_TQO) + (size_t)mi * DM + n0, nullptr, nullptr, 0, L3, tid);
            } else { const int r = st - S_GU - S_AIN - S_OUT, gi = r / 128, nb = r % 128, n0 = 16 * nb;
                p0w_strip<DFF, 16, false, true>(KIN(6) + (size_t)gi * DFF * DM, DM, n0, ws + WS_WQD + ((size_t)gi * DM + n0) * DFF, (float*)(ws + WS_TQD) + (size_t)gi * DM + n0, nullptr, nullptr, 0, L3, tid);
            }
        }
        phase_bias_bin(mod, (const u16*)(ws + WS_WBIN), bias, gw, NGW, lane);
    }
    SEAM();

#pragma unroll 1
    for (int li0 = 0; li0 < DEPTH; ++li0) {
#pragma unroll 1
        for (int s0 = 0; s0 < 3; ++s0) {
            if (s0 != 1) {
                if (IN()) { OPQ_LS();
                    FRAME(); unsigned char* ws = KWS(); const float* modl = (const float*)(ws + WS_MOD) + (size_t)li * NB * ADAW;
                    if (li == 0 && s == 0) { phase_quant<true>(KIN(0), (u16*)(ws + WS_XH), (unsigned long long*)(ws + WS_XQ), modl + (3 * s + 1) * DM, (float*)(ws + WS_RF), gw, NGW, lane);
                    }
                    else phase_quant<false>(nullptr, (u16*)(ws + WS_XH), (unsigned long long*)(ws + WS_XQ), modl + (3 * s + 1) * DM, (float*)(ws + WS_RF), gw, NGW, lane);
                }
                SEAM();
                if (IN()) { OPQ_LS();
                    unsigned char* ws = KWS(); const int G = gridDim.x, bx = blockIdx.x; const int gi = li * 2 + (s >> 1);
                    pg8::Gemm g{(const u16*)(ws + WS_XQ), (const u16*)(ws + WS_WQ + (size_t)gi * GU_N * DM), MTOK, GU_N, DM / 2}; pg8::StaticOrder S; S.init(MTOK, GU_N, G, bx);
                    const int q = 3 * li + s; pg8::EpiSwiglu8 E{ws + WS_HQ, DFF, (const float*)(ws + WS_RF), (const float*)(ws + WS_TQ) + (size_t)gi * GU_N, (const float*)(ws + WS_BIAS) + (size_t)q * 4 * GU_N, GU_N};
                    pg8::gemm_phase<pg8::EpiSwiglu8, pg8::StaticOrder, true, true, 1>(L3, g, S, E);
                }
                SEAM();
            } else {
                const bool isA = (li0 & 1) == 0;
                if (IN()) { OPQ_LS();
                    FRAME(); unsigned char* ws = KWS(); const float* modl = (const float*)(ws + WS_MOD) + (size_t)li * NB * ADAW; const int q = 3 * li + s;
                    if ((li & 1) == 0) phase_quant<false>(nullptr, (u16*)(ws + WS_XH), (unsigned long long*)(ws + WS_XQ), modl + (3 * s + 1) * DM, (float*)(ws + WS_RF), gw, NGW, lane);
                    else phase_quant<false, true>(nullptr, (u16*)(ws + WS_XH), (unsigned long long*)(ws + WS_XQ), modl + (3 * s + 1) * DM, (float*)(ws + WS_RF), gw, NGW, lane, (u16*)(ws + WS_XN), (float*)(ws + WS_SSQ) + (q & 1) * MTOK);
                }
                SEAM();
                if (IN()) { OPQ_LS();
                    unsigned char* ws = KWS(); const int G = gridDim.x, bx = blockIdx.x; const int mj = li >> 1; const int q = 3 * li + s;
                    const pg8::RowCol rc{(const float*)(ws + WS_SSQ) + (q & 1) * MTOK, (const float*)(ws + WS_BIAS) + (size_t)q * 4 * GU_N, GU_N};
                    if ((li & 1) == 0) {
                        pg8::Gemm g{(const u16*)(ws + WS_XQ), (const u16*)(ws + WS_WQA + (size_t)mj * A_IN * DM), MTOK, A_IN, DM / 2}; pg8::StaticOrder S; S.init(MTOK, A_IN, G, bx);
                        const pg8::RowCol rcq{(const float*)(ws + WS_RF), rc.bias, rc.bstride};
                        pg8::EpiQkvA E{(u16*)(ws + WS_Q), (u16*)(ws + WS_K), (u16*)(ws + WS_V), rcq, (const float*)(ws + WS_TQA) + (size_t)mj * A_IN, KIN(9) + mj * 128, KIN(10) + mj * 128, (const float*)(ws + WS_COS), (const float*)(ws + WS_SIN), (LAS float*)(L3 + 132096)};
                        pg8::gemm_phase<pg8::EpiQkvA, pg8::StaticOrder, true, true, 1>(L3, g, S, E);
                    } else {
                        { pg8::Gemm g{(const u16*)(ws + WS_XQ), (const u16*)(ws + WS_WQB + (size_t)mj * B_QKV * DM), MTOK, B_QKV, DM / 2}; pg8::StaticOrder S; S.init(MTOK, B_QKV, G, bx);
                          pg8::EpiF16Q E{(u16*)(ws + WS_BIG), B_INP, (const float*)(ws + WS_RF), (const float*)(ws + WS_TQB) + (size_t)mj * B_QKV, rc.bias, rc.bstride};
                          pg8::gemm_phase<pg8::EpiF16Q, pg8::StaticOrder, true, true, 1>(L3, g, S, E); }
                        asm volatile("s_waitcnt vmcnt(0)" ::: "memory"); __syncthreads();
                        { pg8::Gemm g{(const u16*)(ws + WS_XN), (const u16*)(ws + WS_WBIN) + ((size_t)mj * B_INP + B_QKV) * DM, MTOK, B_INP - B_QKV, DM}; pg8::StaticOrder S; S.init(MTOK, B_INP - B_QKV, G, (bx + G / 2) % G);
                          const pg8::RowCol rc2{rc.ssq, rc.bias + B_QKV, rc.bstride};
                          pg8::EpiF16 E{(u16*)(ws + WS_BIG) + B_QKV, B_INP, rc2};
                          pg8::gemm_phase<pg8::EpiF16, pg8::StaticOrder, true, true>(L3, g, S, E); }
                    }
                }
                SEAM();
                if (isA) {
                    if (IN()) { OPQ_LS(); unsigned char* ws = KWS(); const int G = gridDim.x, bx = blockIdx.x; const int vcu = (G % 8 == 0) ? (bx % 8) * (G / 8) + bx / 8 : bx;
                        phase_attnA2((char*)lds, (const u16*)(ws + WS_Q), (const u16*)(ws + WS_K), (const u16*)(ws + WS_V), (u16*)(ws + WS_O), vcu, G); __syncthreads(); }
                    SEAM();
                    if (IN()) { OPQ_LS(); FRAME(); unsigned char* ws = KWS(); const int mj = li >> 1;
                        phase_combineA((const u16*)(ws + WS_O), ws + WS_AO, (float*)(ws + WS_RFO), KIN(11) + mj * 128, KIN(12) + mj * 128, KIN(13) + mj * 128, KIN(14) + mj * 128, KIN(15) + mj * 256,
                                       li == 0 ? 0.2f : 0.47071301834358414f, gw, NGW, lane); }
                    SEAM();
                } else {
                    if (IN()) { OPQ_LS(); FRAME(); unsigned char* ws = KWS(); const int mj = li >> 1;
                        phase_normropeB((const u16*)(ws + WS_BIG), (u16*)(ws + WS_Q), (u16*)(ws + WS_V), (u16*)(ws + WS_V + 8 * MiB), (u16*)(ws + WS_K), (u16*)(ws + WS_V + 16 * MiB), (float*)(ws + WS_V + 24 * MiB),
                                        KIN(18) + mj * 128, KIN(19) + mj * 128, KIN(20) + mj * 128, KIN(21) + mj * 128,
                                        (const float*)(ws + WS_COS), (const float*)(ws + WS_SIN), (const float*)(ws + WS_COSI), (const float*)(ws + WS_SINI), gw, NGW, lane); }
                    SEAM();
                    if (IN()) { OPQ_LS(); unsigned char* ws = KWS(); const int G = gridDim.x, bx = blockIdx.x; const int vcu = (G % 8 == 0) ? (bx % 8) * (G / 8) + bx / 8 : bx;
                        phase_B3((char*)lds, (const u16*)(ws + WS_Q), (const u16*)(ws + WS_V), (const u16*)(ws + WS_V + 8 * MiB), (const u16*)(ws + WS_K), (const u16*)(ws + WS_V + 16 * MiB),
                                 (const float*)(ws + WS_V + 24 * MiB), (float*)(ws + WS_O), ws + WS_AO, (float*)(ws + WS_RFO), vcu, G); __syncthreads(); }
                    SEAM();
                }
            }
            if (IN()) { OPQ_LS();
                unsigned char* ws = KWS(); const int G = gridDim.x, bx = blockIdx.x;
                const float* gate = (const float*)(ws + WS_MOD) + (size_t)li * NB * ADAW + (3 * s + 2) * DM;
                const int mi = (li & 1) * 2 + (li >> 1), gi = li * 2 + (s >> 1);
                pg8::StaticOrder S; S.init(MTOK, DM, G, bx);
                if (s != 1) {
                    pg8::Gemm g{(const u16*)(ws + WS_HQ), (const u16*)(ws + WS_WQD + (size_t)gi * DM * DFF), MTOK, DM, DFF / 2};
                    pg8::EpiResidQ E{(const u16*)(ws + WS_XH), (u16*)(ws + WS_XH), KOUT(), gate, nullptr, (const float*)(ws + WS_TQD) + (size_t)gi * DM, (li == DEPTH - 1 && s == 2) ? 1 : 0};
                    pg8::gemm_phase<pg8::EpiResidQ, pg8::StaticOrder, true, true, 2>(L3, g, S, E);
                } else {
                    pg8::Gemm g{(const u16*)(ws + WS_AO), (const u16*)(ws + WS_WOQ + (size_t)mi * DM * DM), MTOK, DM, DM / 2};
                    pg8::EpiResidQ E{(const u16*)(ws + WS_XH), (u16*)(ws + WS_XH), KOUT(), gate, (const float*)(ws + WS_RFO), (const float*)(ws + WS_TQO) + (size_t)mi * DM, 0};
                    pg8::gemm_phase<pg8::EpiResidQ, pg8::StaticOrder, true, true, 1>(L3, g, S, E);
                }
            }
            SEAM();
        }
    }
#undef IN
#undef SEAM
}

#ifndef MK_PER_PHASE
#define MK_PER_PHASE 0
#endif
extern "C" void kernel_launch(void* const* d_in, const int* in_sizes, int n_in, void* d_out, int out_size, void* d_ws, size_t ws_size, hipStream_t stream) {
    static int grid = 0;
    if (grid == 0) {
        if (n_in != 22 || out_size != MTOK * DM || ws_size < WS_END) { fprintf(stderr, "kernel_launch: unexpected shapes (n_in %d out %d ws %zu)\n", n_in, out_size, ws_size); grid = -1; return; }
        int dev = 0, cus = 0, per_cu = 0;
        if (hipGetDevice(&dev) != hipSuccess || hipDeviceGetAttribute(&cus, hipDeviceAttributeMultiprocessorCount, dev) != hipSuccess) { grid = -1; return; }
        if (hipFuncSetAttribute((const void*)fwd_kernel, hipFuncAttributeMaxDynamicSharedMemorySize, LDS_BYTES) != hipSuccess) { fprintf(stderr, "kernel_launch: hipFuncSetAttribute failed\n"); grid = -1; return; }
        if (hipOccupancyMaxActiveBlocksPerMultiprocessor(&per_cu, (const void*)fwd_kernel, NWAVES * 64, LDS_BYTES) != hipSuccess || per_cu < 1) { fprintf(stderr, "kernel_launch: occupancy query says %d\n", per_cu); grid = -1; (void)hipGetLastError(); return; }
        (void)hipGetLastError();
        grid = cus;
    }
    if (grid < 0) return;
    if (hipMemsetAsync((char*)d_ws + WS_CTL, 0, CTL_ZERO_BYTES, stream) != hipSuccess) return;
    Args a{};
    for (int i = 0; i < 22; ++i) a.in[i] = (const float*)d_in[i];
    a.out = (float*)d_out; a.ws = (unsigned char*)d_ws;
#ifndef PROBE_REP0
#define PROBE_REP0 1
#define PROBE_REP1 1
#define PROBE_REP2 1
#define PROBE_REP3 1
#define PROBE_REP4 1
#define PROBE_REP5 1
#define PROBE_REP6 1
#endif
    a.rep[0] = PROBE_REP0; a.rep[1] = PROBE_REP1; a.rep[2] = PROBE_REP2; a.rep[3] = PROBE_REP3; a.rep[4] = PROBE_REP4; a.rep[5] = PROBE_REP5; a.rep[6] = PROBE_REP6; a.rep[7] = 1;
#if MK_PER_PHASE
    for (int p = 0; p < 40; ++p) { a.ph_lo = p; a.ph_hi = p + 1; hipLaunchKernelGGL(fwd_kernel, dim3(grid), dim3(NWAVES * 64), LDS_BYTES, stream, a); }
#else
    a.ph_lo = 0; a.ph_hi = 1 << 20;
    hipLaunchKernelGGL(fwd_kernel, dim3(grid), dim3(NWAVES * 64), LDS_BYTES, stream, a);
#endif
}
```

```cpp
#include <hip/hip_runtime.h>
#include <cstdio>
#include <cstdint>

typedef unsigned short u16;
typedef _Float16 h16x8 __attribute__((ext_vector_type(8)));
typedef _Float16 h16x4 __attribute__((ext_vector_type(4)));
typedef _Float16 h16x2 __attribute__((ext_vector_type(2)));

constexpr int DM = 2048, NB = 4, SEQ = 8192, DEPTH = 4, DFF = 5632, MTOK = NB * SEQ;
constexpr int NADA = 9, ADAW = NADA * DM;
constexpr int A_IN = 6144, B_IN = 4496, B_INP = 4608;
constexpr int GU_N = 2 * DFF;
constexpr float NORM_EPS = 1e-6f;

constexpr int TIDTAB_OFF = 131072 + 320 + 128;
__device__ __forceinline__ int hw_wave_slot() { return (int)(__builtin_amdgcn_s_getreg((5 << 11) | 4) & 63u); }
__device__ __forceinline__ int opaque_lane() { int ln; asm volatile("v_mbcnt_lo_u32_b32 %0, -1, 0\n\tv_mbcnt_hi_u32_b32 %0, -1, %0" : "=v"(ln)); return ln; }
__device__ __forceinline__ int opaque_tid() {
    extern __shared__ __attribute__((aligned(16))) unsigned char lds_tid_[];
    const int w = ((volatile __attribute__((address_space(3))) int*)((__attribute__((address_space(3))) unsigned char*)lds_tid_ + TIDTAB_OFF))[hw_wave_slot()];
    int ln; asm volatile("v_mbcnt_lo_u32_b32 %0, -1, 0\n\tv_mbcnt_hi_u32_b32 %0, -1, %0" : "=v"(ln));
    int t = (w << 6) | ln;
    asm volatile("" : "+v"(t)); return t;
}

template <int K> __device__ __forceinline__ float swz_xor(float v) { static_assert(K > 0 && K < 32, "swz_xor"); return __builtin_bit_cast(float, __builtin_amdgcn_ds_swizzle(__builtin_bit_cast(int, v), (K << 10) | 0x1F)); }
__device__ __forceinline__ float add_xor16(float v) { auto r = __builtin_amdgcn_permlane16_swap(__float_as_uint(v), __float_as_uint(v), false, false); return __uint_as_float(r[0]) + __uint_as_float(r[1]); }
__device__ __forceinline__ float add_xor32(float v) { auto r = __builtin_amdgcn_permlane32_swap(__float_as_uint(v), __float_as_uint(v), false, false); return __uint_as_float(r[0]) + __uint_as_float(r[1]); }

namespace pg8 {
#define PG8_LAS __attribute__((address_space(3)))
typedef unsigned short bf16_t;
typedef short bf16x8 __attribute__((ext_vector_type(8)));
typedef float f32x4 __attribute__((ext_vector_type(4)));
typedef unsigned u32x4 __attribute__((ext_vector_type(4)));
typedef int i32x4 __attribute__((ext_vector_type(4)));
constexpr int BM = 256, BK = 64, HALF = 128, HTB = HALF * BK * 2  , STAGE_BYTES = 8 * HTB, NXCD = 8, WGM = 4;

__host__ __device__ __forceinline__ int lds_byte(int r, int c) { const int st = (r >> 4) * 2 + (c >> 5), rr = r & 15, cc = c & 31, ob = rr * 64 + cc * 2; return st * 1024 + (ob ^ (((ob >> 9) & 1) << 5)); }
__host__ __device__ __forceinline__ void stage_rc(int b, int& R, int& C) { const int st = b / 1024, sb = b % 1024, swz = sb ^ (((sb >> 9) & 1) << 5); R = (st >> 1) * 16 + swz / 64; C = (st & 1) * 32 + (swz % 64) / 2; }
__host__ __device__ __forceinline__ int perm32(int rho) { const int n = rho >> 4, i = rho & 15; return 8 * (i >> 2) + 4 * n + (i & 3); }

struct Unit { int pm, pn; };
struct Gemm { const bf16_t* A; const bf16_t* Bt; int M, N, K; };

struct StaticOrder {
    int nM, nN, nwg, G, c;
    __host__ __device__ void init(int M, int N, int G_, int c_) { nM = M / BM; nN = N / BM; nwg = nM * nN; G = G_; c = c_; }
    __host__ __device__ bool next(int i, Unit& u) const {
        const long L = (long)i * G + c; if (L >= nwg) return false;
        int wgid = (int)L; { const int q = nwg / NXCD, r = nwg % NXCD, xcd = wgid % NXCD, off = wgid / NXCD; wgid = (xcd < r ? xcd * (q + 1) : r * (q + 1) + (xcd - r) * q) + off; }
        const int nig = WGM * nN, gid = wgid / nig, fm = gid * WGM, gsz = (nM - fm) < WGM ? (nM - fm) : WGM;
        u.pm = fm + ((wgid % nig) % gsz); u.pn = (wgid % nig) / gsz; return true;
    }
    __device__ __forceinline__ void a_ready(const Unit&) const {}
    __device__ __forceinline__ void done(const Unit&) const {}
};

__device__ __forceinline__ unsigned cvt_pk_h(float lo, float hi) { h16x2 v = {(_Float16)lo, (_Float16)hi}; return __builtin_bit_cast(unsigned, v); }
__device__ __forceinline__ float silu_f(float g) { return g * __builtin_amdgcn_rcpf(1.0f + __builtin_amdgcn_exp2f(g * -1.4426950408889634f)); }

struct RowCol { const float* ssq; const float* bias; int bstride; };
__device__ __forceinline__ float rstd_of(const float* ssq, int row) { return rsqrtf(ssq[row] * (1.0f / DM) + NORM_EPS); }

struct EpiSwiglu {
    static constexpr bool PERM = true, AFTER_DRAIN = false;
    u16* O; int ldc; const float* rf; const float* tq; const float* bias; int bstride;
    __device__ __forceinline__ void operator()(const f32x4 (&acc)[2][2][4][2], const Unit& u, int wr, int wc, int fr, int fq) const {
        const int row0 = u.pm * BM + wr * 64 + fr, col0 = u.pn * HALF + wc * 32 + 8 * fq;
        const float* bp = bias + (size_t)(u.pm >> 5) * bstride + u.pn * BM + wc * 32 + 8 * fq;
        const float* tp = tq + u.pn * BM + wc * 32 + 8 * fq;
        const f32x4 bg0 = *(const f32x4*)bp, bg1 = *(const f32x4*)(bp + 4), bu0 = *(const f32x4*)(bp + HALF), bu1 = *(const f32x4*)(bp + HALF + 4);
        const f32x4 tg0 = *(const f32x4*)tp, tg1 = *(const f32x4*)(tp + 4), tu0 = *(const f32x4*)(tp + HALF), tu1 = *(const f32x4*)(tp + HALF + 4);
#pragma unroll
        for (int ai = 0; ai < 2; ++ai)
#pragma unroll
            for (int m = 0; m < 4; ++m) {
                const int row = row0 + ai * HALF + m * 16; const float rs = rf[row];
                u16* rowp = O + (size_t)row * ldc + col0;
                const f32x4 g0 = (acc[ai][0][m][0] * rs) * tg0 + bg0, g1 = (acc[ai][0][m][1] * rs) * tg1 + bg1, u0 = (acc[ai][1][m][0] * rs) * tu0 + bu0, u1 = (acc[ai][1][m][1] * rs) * tu1 + bu1;
                u32x4 w;
                w.x = cvt_pk_h(silu_f(g0[0]) * u0[0], silu_f(g0[1]) * u0[1]); w.y = cvt_pk_h(silu_f(g0[2]) * u0[2], silu_f(g0[3]) * u0[3]);
                w.z = cvt_pk_h(silu_f(g1[0]) * u1[0], silu_f(g1[1]) * u1[1]); w.w = cvt_pk_h(silu_f(g1[2]) * u1[2], silu_f(g1[3]) * u1[3]);
                *(u32x4*)rowp = w;
            }
    }
};
constexpr float HID_S = 4.0f, F8_MAX = 448.0f, F8_WMAX = 440.0f;
__device__ __forceinline__ unsigned pack4_f8(float a, float b, float c, float d) { int w = __builtin_amdgcn_cvt_pk_fp8_f32(a, b, 0, false); w = __builtin_amdgcn_cvt_pk_fp8_f32(c, d, w, true); return (unsigned)w; }
__device__ __forceinline__ float clamp_f8(float x) { return __builtin_amdgcn_fmed3f(x, -F8_MAX, F8_MAX); }
struct EpiSwiglu8 {
    static constexpr bool PERM = true, AFTER_DRAIN = false;
    unsigned char* O; int ldc; const float* rf; const float* tq; const float* bias; int bstride;
    static __device__ __forceinline__ unsigned swi4(const f32x4 gs, const f32x4 u) {
        const f32x4 d = (f32x4){__builtin_amdgcn_exp2f(-gs[0]), __builtin_amdgcn_exp2f(-gs[1]), __builtin_amdgcn_exp2f(-gs[2]), __builtin_amdgcn_exp2f(-gs[3])} + 1.0f;
        const f32x4 r = {__builtin_amdgcn_rcpf(d[0]), __builtin_amdgcn_rcpf(d[1]), __builtin_amdgcn_rcpf(d[2]), __builtin_amdgcn_rcpf(d[3])};
        const f32x4 h = (gs * u) * r;
        return pack4_f8(clamp_f8(h[0]), clamp_f8(h[1]), clamp_f8(h[2]), clamp_f8(h[3])); }
    __device__ __forceinline__ void operator()(const f32x4 (&acc)[2][2][4][2], const Unit& u, int wr, int wc, int fr, int fq) const {
        constexpr float L2E = 1.4426950408889634f, US = HID_S / L2E;
        const int row0 = u.pm * BM + wr * 64 + fr, col0 = u.pn * HALF + wc * 32 + 8 * fq;
        const float* bp = bias + (size_t)(u.pm >> 5) * bstride + u.pn * BM + wc * 32 + 8 * fq;
        const float* tp = tq + u.pn * BM + wc * 32 + 8 * fq;
        const f32x4 bg0 = *(const f32x4*)bp * L2E, bg1 = *(const f32x4*)(bp + 4) * L2E, bu0 = *(const f32x4*)(bp + HALF) * US, bu1 = *(const f32x4*)(bp + HALF + 4) * US;
        const f32x4 tg0 = *(const f32x4*)tp * L2E, tg1 = *(const f32x4*)(tp + 4) * L2E, tu0 = *(const f32x4*)(tp + HALF) * US, tu1 = *(const f32x4*)(tp + HALF + 4) * US;
#pragma unroll
        for (int ai = 0; ai < 2; ++ai)
#pragma unroll
            for (int m = 0; m < 4; ++m) {
                const int row = row0 + ai * HALF + m * 16; const float rs = rf[row]; const f32x4 rs4 = {rs, rs, rs, rs};
                unsigned char* rowp = O + (size_t)row * ldc + col0;
                const f32x4 g0 = (acc[ai][0][m][0] * rs4) * tg0 + bg0, g1 = (acc[ai][0][m][1] * rs4) * tg1 + bg1, u0 = (acc[ai][1][m][0] * rs4) * tu0 + bu0, u1 = (acc[ai][1][m][1] * rs4) * tu1 + bu1;
                const unsigned wlo = swi4(g0, u0), whi = swi4(g1, u1);
                *(unsigned long long*)rowp = (unsigned long long)wlo | ((unsigned long long)whi << 32);
            }
    }
};
struct EpiResid {
    static constexpr bool PERM = true, AFTER_DRAIN = false;
    const u16* xin; u16* xout16; float* xout32; const float* gate; int out32;
    __device__ __forceinline__ void operator()(const f32x4 (&acc)[2][2][4][2], const Unit& u, int wr, int wc, int fr, int fq) const {
        const int row0 = u.pm * BM + wr * 64 + fr, col0 = u.pn * BM + wc * 32 + 8 * fq;
        const float* gp = gate + (size_t)(u.pm >> 5) * ADAW + col0;
        f32x4 gv[2][2];
#pragma unroll
        for (int bj = 0; bj < 2; ++bj)
#pragma unroll
            for (int n = 0; n < 2; ++n) gv[bj][n] = *(const f32x4*)(gp + bj * HALF + n * 4);
#pragma unroll
        for (int ai = 0; ai < 2; ++ai)
#pragma unroll
            for (int m = 0; m < 4; ++m) {
                const int row = row0 + ai * HALF + m * 16;
                const size_t ro = (size_t)row * DM + col0;
#pragma unroll
                for (int bj = 0; bj < 2; ++bj) {
                    const h16x8 xi = *(const h16x8*)(xin + ro + bj * HALF);
                    const f32x4 x0 = (f32x4){(float)xi[0], (float)xi[1], (float)xi[2], (float)xi[3]} + gv[bj][0] * acc[ai][bj][m][0], x1 = (f32x4){(float)xi[4], (float)xi[5], (float)xi[6], (float)xi[7]} + gv[bj][1] * acc[ai][bj][m][1];
                    if (out32) { *(f32x4*)(xout32 + ro + bj * HALF) = x0; *(f32x4*)(xout32 + ro + bj * HALF + 4) = x1; }
                    else { u32x4 w; w.x = cvt_pk_h(x0[0], x0[1]); w.y = cvt_pk_h(x0[2], x0[3]); w.z = cvt_pk_h(x1[0], x1[1]); w.w = cvt_pk_h(x1[2], x1[3]); *(u32x4*)(xout16 + ro + bj * HALF) = w; }
                }
            }
    }
};
struct EpiResidQ {
    static constexpr bool PERM = true, AFTER_DRAIN = false;
    const u16* xin; u16* xout16; float* xout32; const float* gate; const float* rfo; const float* tqo; int out32;
    __device__ __forceinline__ void operator()(const f32x4 (&acc)[2][2][4][2], const Unit& u, int wr, int wc, int fr, int fq) const {
        const int row0 = u.pm * BM + wr * 64 + fr, col0 = u.pn * BM + wc * 32 + 8 * fq;
        const float* gp = gate + (size_t)(u.pm >> 5) * ADAW + col0;
        f32x4 gv[2][2];
#pragma unroll
        for (int bj = 0; bj < 2; ++bj)
#pragma unroll
            for (int n = 0; n < 2; ++n) gv[bj][n] = *(const f32x4*)(gp + bj * HALF + n * 4) * *(const f32x4*)(tqo + col0 + bj * HALF + n * 4);
#pragma unroll
        for (int ai = 0; ai < 2; ++ai)
#pragma unroll
            for (int m = 0; m < 4; ++m) {
                const int row = row0 + ai * HALF + m * 16; const float rs = rfo ? rfo[row] : 1.0f;
                const size_t ro = (size_t)row * DM + col0;
#pragma unroll
                for (int bj = 0; bj < 2; ++bj) {
                    const h16x8 xi = *(const h16x8*)(xin + ro + bj * HALF);
                    const f32x4 x0 = (f32x4){(float)xi[0], (float)xi[1], (float)xi[2], (float)xi[3]} + gv[bj][0] * (acc[ai][bj][m][0] * rs), x1 = (f32x4){(float)xi[4], (float)xi[5], (float)xi[6], (float)xi[7]} + gv[bj][1] * (acc[ai][bj][m][1] * rs);
                    if (out32) { *(f32x4*)(xout32 + ro + bj * HALF) = x0; *(f32x4*)(xout32 + ro + bj * HALF + 4) = x1; }
                    else { u32x4 w; w.x = cvt_pk_h(x0[0], x0[1]); w.y = cvt_pk_h(x0[2], x0[3]); w.z = cvt_pk_h(x1[0], x1[1]); w.w = cvt_pk_h(x1[2], x1[3]); *(u32x4*)(xout16 + ro + bj * HALF) = w; }
                }
            }
    }
};
struct EpiF16 {
    static constexpr bool PERM = true, AFTER_DRAIN = false;
    u16* O; int ldc; RowCol rc;
    __device__ __forceinline__ void operator()(const f32x4 (&acc)[2][2][4][2], const Unit& u, int wr, int wc, int fr, int fq) const {
        const int row0 = u.pm * BM + wr * 64 + fr, col0 = u.pn * BM + wc * 32 + 8 * fq;
        const float* bp = rc.bias + (size_t)(u.pm >> 5) * rc.bstride + col0;
        f32x4 bv[2][2];
#pragma unroll
        for (int bj = 0; bj < 2; ++bj)
#pragma unroll
            for (int n = 0; n < 2; ++n) bv[bj][n] = *(const f32x4*)(bp + bj * HALF + n * 4);
#pragma unroll
        for (int ai = 0; ai < 2; ++ai)
#pragma unroll
            for (int m = 0; m < 4; ++m) {
                const int row = row0 + ai * HALF + m * 16; const float rs = rstd_of(rc.ssq, row);
                u16* rowp = O + (size_t)row * ldc + col0;
#pragma unroll
                for (int bj = 0; bj < 2; ++bj) {
                    const f32x4 v0 = acc[ai][bj][m][0] * rs + bv[bj][0], v1 = acc[ai][bj][m][1] * rs + bv[bj][1];
                    u32x4 w; w.x = cvt_pk_h(v0[0], v0[1]); w.y = cvt_pk_h(v0[2], v0[3]); w.z = cvt_pk_h(v1[0], v1[1]); w.w = cvt_pk_h(v1[2], v1[3]);
                    *(u32x4*)(rowp + bj * HALF) = w;
                }
            }
    }
};

struct EpiF16Q {
    static constexpr bool PERM = true, AFTER_DRAIN = false;
    u16* O; int ldc; const float* rf; const float* tq; const float* bias; int bstride;
    __device__ __forceinline__ void operator()(const f32x4 (&acc)[2][2][4][2], const Unit& u, int wr, int wc, int fr, int fq) const {
        const int row0 = u.pm * BM + wr * 64 + fr, col0 = u.pn * BM + wc * 32 + 8 * fq;
        const float* bp = bias + (size_t)(u.pm >> 5) * bstride + col0;
        f32x4 bv[2][2], tv[2][2];
#pragma unroll
        for (int bj = 0; bj < 2; ++bj)
#pragma unroll
            for (int n = 0; n < 2; ++n) { bv[bj][n] = *(const f32x4*)(bp + bj * HALF + n * 4); tv[bj][n] = *(const f32x4*)(tq + col0 + bj * HALF + n * 4); }
#pragma unroll
        for (int ai = 0; ai < 2; ++ai)
#pragma unroll
            for (int m = 0; m < 4; ++m) {
                const int row = row0 + ai * HALF + m * 16; const float rs = rf[row];
                u16* rowp = O + (size_t)row * ldc + col0;
#pragma unroll
                for (int bj = 0; bj < 2; ++bj) {
                    const f32x4 v0 = (acc[ai][bj][m][0] * rs) * tv[bj][0] + bv[bj][0], v1 = (acc[ai][bj][m][1] * rs) * tv[bj][1] + bv[bj][1];
                    u32x4 w; w.x = cvt_pk_h(v0[0], v0[1]); w.y = cvt_pk_h(v0[2], v0[3]); w.z = cvt_pk_h(v1[0], v1[1]); w.w = cvt_pk_h(v1[2], v1[3]);
                    *(u32x4*)(rowp + bj * HALF) = w;
                }
            }
    }
};

struct EpiQkvA {
    static constexpr bool PERM = true, AFTER_DRAIN = false;
    u16* Qh; u16* Kh; u16* Vh; RowCol rc; const float* tq; const float* qgain; const float* kgain; const float* cost; const float* sint; PG8_LAS float* xch;
    __device__ __forceinline__ void operator()(const f32x4 (&acc)[2][2][4][2], const Unit& u, int wr, int wc, int fr, int fq) const {
        const int row0 = u.pm * BM + wr * 64 + fr, b = u.pm >> 5;
        {
            f32x4 (&a)[2][2][4][2] = const_cast<f32x4 (&)[2][2][4][2]>(acc);
            const float* tp = tq + u.pn * BM + wc * 32 + 8 * fq;
#pragma unroll
            for (int bj = 0; bj < 2; ++bj)
#pragma unroll
                for (int n = 0; n < 2; ++n) { const f32x4 tv = *(const f32x4*)(tp + bj * HALF + n * 4);
#pragma unroll
                    for (int ai = 0; ai < 2; ++ai)
#pragma unroll
                        for (int m = 0; m < 4; ++m) a[ai][bj][m][n] = a[ai][bj][m][n] * tv; }
        }
        const float* bp = rc.bias + (size_t)b * rc.bstride + u.pn * BM + wc * 32 + 8 * fq;
        f32x4 bv[2][2];
#pragma unroll
        for (int bj = 0; bj < 2; ++bj)
#pragma unroll
            for (int n = 0; n < 2; ++n) bv[bj][n] = *(const f32x4*)(bp + bj * HALF + n * 4);
        if (u.pn >= 16) {
#pragma unroll
            for (int ai = 0; ai < 2; ++ai)
#pragma unroll
                for (int m = 0; m < 4; ++m) {
                    const int row = row0 + ai * HALF + m * 16, t = row & (SEQ - 1); const float rs = rc.ssq[row];
#pragma unroll
                    for (int bj = 0; bj < 2; ++bj) {
                        const f32x4 v0 = acc[ai][bj][m][0] * rs + bv[bj][0], v1 = acc[ai][bj][m][1] * rs + bv[bj][1];
                        u32x4 w; w.x = cvt_pk_h(v0[0], v0[1]); w.y = cvt_pk_h(v0[2], v0[3]); w.z = cvt_pk_h(v1[0], v1[1]); w.w = cvt_pk_h(v1[2], v1[3]);
                        *(u32x4*)(Vh + ((size_t)(b * 16 + 2 * (u.pn - 16) + bj) * SEQ + t) * 128 + wc * 32 + 8 * fq) = w;
                    }
                }
            return;
        }
        int frx = fr; asm volatile("" : "+v"(frx));
        const int wid = wr * 4 + wc, dlo = 32 * (wc & 1) + 8 * fq;
        const float* gp = (u.pn < 8 ? qgain : kgain) + dlo;
        f32x4 gn[2][2];
#pragma unroll
        for (int bj = 0; bj < 2; ++bj)
#pragma unroll
            for (int n = 0; n < 2; ++n) gn[bj][n] = *(const f32x4*)(gp + 64 * bj + 4 * n);
#pragma unroll
        for (int ai = 0; ai < 2; ++ai)
#pragma unroll
            for (int m = 0; m < 4; ++m) {
                const int row = row0 + ai * HALF + m * 16; const float rs = rc.ssq[row];
                float ss = 0.f;
#pragma unroll
                for (int bj = 0; bj < 2; ++bj)
#pragma unroll
                    for (int n = 0; n < 2; ++n) { const f32x4 v = acc[ai][bj][m][n] * rs + bv[bj][n]; ss += (v[0] * v[0] + v[1] * v[1]) + (v[2] * v[2] + v[3] * v[3]); }
                ss += swz_xor<16>(ss); ss = add_xor32(ss);
                if (fq == 0) xch[wid * 128 + ai * 64 + m * 16 + frx] = ss;
            }
        asm volatile("s_waitcnt lgkmcnt(0)" ::: "memory"); __builtin_amdgcn_s_barrier(); asm volatile("" ::: "memory");
        u16* dstb = (u.pn < 8 ? Qh : Kh) + ((size_t)(b * 16 + 2 * (u.pn & 7) + (wc >> 1)) * SEQ) * 128 + dlo;
#pragma unroll
        for (int ai = 0; ai < 2; ++ai)
#pragma unroll
            for (int m = 0; m < 4; ++m) {
                const int rl = ai * 64 + m * 16 + frx, row = row0 + ai * HALF + m * 16, t = row & (SEQ - 1);
                const float tot = xch[wid * 128 + rl] + xch[(wid ^ 1) * 128 + rl];
                const float rs = rc.ssq[row], rn = rsqrtf(tot * (1.0f / 128.0f) + NORM_EPS);
                const f32x4 c0 = *(const f32x4*)(cost + t * 64 + dlo), c1 = *(const f32x4*)(cost + t * 64 + dlo + 4), s0 = *(const f32x4*)(sint + t * 64 + dlo), s1 = *(const f32x4*)(sint + t * 64 + dlo + 4);
                const f32x4 a0 = (acc[ai][0][m][0] * rs + bv[0][0]) * rn * gn[0][0], a1 = (acc[ai][0][m][1] * rs + bv[0][1]) * rn * gn[0][1], b0 = (acc[ai][1][m][0] * rs + bv[1][0]) * rn * gn[1][0], b1 = (acc[ai][1][m][1] * rs + bv[1][1]) * rn * gn[1][1];
                const f32x4 lo0 = a0 * c0 - b0 * s0, lo1 = a1 * c1 - b1 * s1, hi0 = b0 * c0 + a0 * s0, hi1 = b1 * c1 + a1 * s1;
                u16* dp = dstb + (size_t)t * 128;
                u32x4 w; w.x = cvt_pk_h(lo0[0], lo0[1]); w.y = cvt_pk_h(lo0[2], lo0[3]); w.z = cvt_pk_h(lo1[0], lo1[1]); w.w = cvt_pk_h(lo1[2], lo1[3]);
                *(u32x4*)dp = w;
                w.x = cvt_pk_h(hi0[0], hi0[1]); w.y = cvt_pk_h(hi0[2], hi0[3]); w.z = cvt_pk_h(hi1[0], hi1[1]); w.w = cvt_pk_h(hi1[2], hi1[3]);
                *(u32x4*)(dp + 64) = w;
            }
        asm volatile("s_waitcnt lgkmcnt(0)" ::: "memory"); __builtin_amdgcn_s_barrier(); asm volatile("" ::: "memory");
    }
};
typedef int i32x8 __attribute__((ext_vector_type(8)));
__device__ __forceinline__ void mfma_f8_tied(f32x4& c, i32x8 a, i32x8 b) { asm volatile("v_mfma_f32_16x16x128_f8f6f4 %0, %1, %2, %0" : "+v"(c) : "v"(a), "v"(b)); }
template <class Epi, class Sched, bool ALIGN_EPI = false, bool SP2 = false, int I8 = 0>
__device__ __forceinline__ void gemm_phase(PG8_LAS unsigned char* lds, const Gemm g, const Sched& S, const Epi& E) {
    const int tid = opaque_tid(), wid = __builtin_amdgcn_readfirstlane(tid >> 6), lane = tid & 63, wr = wid >> 2, wc = wid & 3, fr = lane & 15, fq = lane >> 4;
    const int K = g.K, nt = K / BK;
    unsigned voffA[2], voffB[2];
#pragma unroll
    for (int i = 0; i < 2; ++i) { int R, C; stage_rc(tid * 16 + i * 8192, R, C); const int Rb = Epi::PERM ? ((R & ~31) + perm32(R & 31)) : R;
        voffA[i] = (unsigned)(R * K + C) * 2u; voffB[i] = (unsigned)(Rb * K + C) * 2u; }
    const size_t kstep = (size_t)(BK * 2);
    const size_t hstep = (size_t)HALF * K * 2;
    const size_t tstep = 2 * hstep;
    const unsigned ldsw = (unsigned)wid * 1024u;
    const int aoff = lds_byte(wr * 64 + fr, fq * 8), boff = lds_byte(wc * 32 + fr, fq * 8);
#define PG8_SA(b, h) (((b) * 2 + (h)) * HTB)
#define PG8_SB(b, h) ((4 + (b) * 2 + (h)) * HTB)
#define PG8_STAGE(bufoff, gbase, voff) do { _Pragma("unroll") for (int _i = 0; _i < 2; ++_i) \
        __builtin_amdgcn_global_load_lds((const unsigned*)((const char*)(gbase) + (voff)[_i]), (PG8_LAS unsigned*)(lds + (bufoff) + ldsw + _i * 8192), 16, 0, 0); } while (0)
#define PG8_LDA(dst, b, h) do { _Pragma("unroll") for (int m = 0; m < 4; ++m) _Pragma("unroll") for (int k = 0; k < 2; ++k) dst[m][k] = *(const PG8_LAS bf16x8*)(lds + PG8_SA(b, h) + aoff + m * 2048 + k * 1024); } while (0)
#define PG8_LDB(dst, b, h) do { _Pragma("unroll") for (int n = 0; n < 2; ++n) _Pragma("unroll") for (int k = 0; k < 2; ++k) dst[n][k] = *(const PG8_LAS bf16x8*)(lds + PG8_SB(b, h) + boff + n * 2048 + k * 1024); } while (0)
#define PG8_MMA(ai, bj, At, Bt) do { __builtin_amdgcn_s_setprio(1); _Pragma("unroll") for (int m = 0; m < 4; ++m) _Pragma("unroll") for (int n = 0; n < 2; ++n) _Pragma("unroll") for (int k = 0; k < (I8 == 2 ? 1 : 2); ++k) { \
        if constexpr (I8 == 2) mfma_f8_tied(acc[ai][bj][m][n], __builtin_shufflevector(__builtin_bit_cast(i32x4, Bt[n][0]), __builtin_bit_cast(i32x4, Bt[n][1]), 0, 1, 2, 3, 4, 5, 6, 7), \
                __builtin_shufflevector(__builtin_bit_cast(i32x4, At[m][0]), __builtin_bit_cast(i32x4, At[m][1]), 0, 1, 2, 3, 4, 5, 6, 7)); \
        else if constexpr (I8 == 1) acc[ai][bj][m][n] = __builtin_bit_cast(f32x4, __builtin_amdgcn_mfma_i32_16x16x64_i8(__builtin_bit_cast(i32x4, Bt[n][k]), __builtin_bit_cast(i32x4, At[m][k]), __builtin_bit_cast(i32x4, acc[ai][bj][m][n]), 0, 0, 0)); \
        else acc[ai][bj][m][n] = __builtin_amdgcn_mfma_f32_16x16x32_f16(__builtin_bit_cast(h16x8, Bt[n][k]), __builtin_bit_cast(h16x8, At[m][k]), acc[ai][bj][m][n], 0, 0, 0); } __builtin_amdgcn_s_setprio(0); } while (0)
#define PG8_WAIT_V(n) asm volatile("s_waitcnt vmcnt(" #n ")" ::: "memory")
#define PG8_WAIT_L(n) asm volatile("s_waitcnt lgkmcnt(" #n ")" ::: "memory")
#define PG8_BAR __builtin_amdgcn_s_barrier()
#define PG8_SCHED __builtin_amdgcn_sched_barrier(0)
    Unit cur, nxt; int ui = 0;
    if (!S.next(0, cur)) return;
    f32x4 acc[2][2][4][2];
#pragma unroll
    for (int a = 0; a < 2; ++a)
#pragma unroll
        for (int b = 0; b < 2; ++b)
#pragma unroll
            for (int m = 0; m < 4; ++m)
#pragma unroll
                for (int n = 0; n < 2; ++n) acc[a][b][m][n] = (f32x4){0.f, 0.f, 0.f, 0.f};
    bf16x8 At[4][2], B0[2][2], B1[2][2];
    const char* cA = (const char*)g.A + (size_t)cur.pm * tstep; const char* cB = (const char*)g.Bt + (size_t)cur.pn * tstep;
    S.a_ready(cur);
    if constexpr (SP2) {
        PG8_STAGE(PG8_SB(0, 0), cB, voffB); PG8_STAGE(PG8_SB(0, 1), cB + hstep, voffB); PG8_STAGE(PG8_SA(0, 0), cA, voffA); PG8_STAGE(PG8_SA(0, 1), cA + hstep, voffA);
        if (wr == 1) PG8_BAR;
        PG8_WAIT_V(2); PG8_BAR;
        PG8_STAGE(PG8_SB(1, 0), cB + kstep, voffB); PG8_STAGE(PG8_SA(1, 0), cA + kstep, voffA); PG8_STAGE(PG8_SB(1, 1), cB + hstep + kstep, voffB);
        PG8_WAIT_V(6); PG8_BAR;
    } else {
        PG8_STAGE(PG8_SB(0, 0), cB, voffB); PG8_STAGE(PG8_SA(0, 0), cA, voffA); PG8_STAGE(PG8_SB(0, 1), cB + hstep, voffB); PG8_STAGE(PG8_SA(0, 1), cA + hstep, voffA);
        if (wr == 1) PG8_BAR;
        PG8_WAIT_V(4); PG8_BAR;
        PG8_STAGE(PG8_SB(1, 0), cB + kstep, voffB); PG8_STAGE(PG8_SA(1, 0), cA + kstep, voffA); PG8_STAGE(PG8_SB(1, 1), cB + hstep + kstep, voffB);
        PG8_WAIT_V(6); PG8_BAR;
    }
    for (;;) {
        const bool has_next = S.next(ui + 1, nxt);
        const char* nA = has_next ? (const char*)g.A + (size_t)nxt.pm * tstep : cA; const char* nB = has_next ? (const char*)g.Bt + (size_t)nxt.pn * tstep : cB;
        for (int t = 0; t < nt; t += 2) {
            const bool last = (t == nt - 2);
            const char* a1 = cA + (size_t)(t + 1) * kstep;
            const char* a2 = last ? nA : cA + (size_t)(t + 2) * kstep; const char* b2 = last ? nB : cB + (size_t)(t + 2) * kstep;
            const char* a3 = a2 + kstep; const char* b3 = b2 + kstep;
            if (last && has_next) S.a_ready(nxt);
            if constexpr (SP2) {
            PG8_LDB(B0, 0, 0); PG8_LDB(B1, 0, 1); PG8_SCHED; PG8_LDA(At, 0, 0); PG8_STAGE(PG8_SA(1, 1), a1 + hstep, voffA);
            PG8_WAIT_V(8); PG8_WAIT_L(0); PG8_BAR; PG8_MMA(0, 0, At, B0); PG8_MMA(0, 1, At, B1); PG8_BAR; PG8_SCHED;
            PG8_LDA(At, 0, 1); PG8_STAGE(PG8_SB(0, 0), b2, voffB); PG8_STAGE(PG8_SB(0, 1), b2 + hstep, voffB); PG8_STAGE(PG8_SA(0, 0), a2, voffA);
            PG8_WAIT_V(8); PG8_WAIT_L(0); PG8_BAR; PG8_MMA(1, 0, At, B0); PG8_MMA(1, 1, At, B1); PG8_BAR; PG8_SCHED;
            PG8_LDB(B0, 1, 0); PG8_LDB(B1, 1, 1); PG8_SCHED; PG8_LDA(At, 1, 0); PG8_STAGE(PG8_SA(0, 1), a2 + hstep, voffA);
            PG8_WAIT_V(8); PG8_WAIT_L(0); PG8_BAR; PG8_MMA(0, 0, At, B0); PG8_MMA(0, 1, At, B1); PG8_BAR; PG8_SCHED;
            PG8_LDA(At, 1, 1); PG8_STAGE(PG8_SB(1, 0), b3, voffB); PG8_STAGE(PG8_SB(1, 1), b3 + hstep, voffB); PG8_STAGE(PG8_SA(1, 0), a3, voffA);
            PG8_WAIT_V(8); PG8_WAIT_L(0); PG8_BAR; PG8_MMA(1, 0, At, B0); PG8_MMA(1, 1, At, B1); PG8_BAR; PG8_SCHED;
            } else {
            PG8_LDB(B0, 0, 0); PG8_SCHED; PG8_LDA(At, 0, 0); PG8_STAGE(PG8_SA(1, 1), a1 + hstep, voffA);
            PG8_WAIT_L(8); PG8_BAR; PG8_WAIT_L(0); PG8_MMA(0, 0, At, B0); PG8_BAR; PG8_SCHED;
            PG8_LDB(B1, 0, 1); PG8_STAGE(PG8_SB(0, 0), b2, voffB);
            PG8_BAR; PG8_WAIT_L(0); PG8_MMA(0, 1, At, B1); PG8_BAR;
            PG8_LDA(At, 0, 1); PG8_STAGE(PG8_SA(0, 0), a2, voffA);
            PG8_BAR; PG8_WAIT_L(0); PG8_MMA(1, 0, At, B0); PG8_BAR; PG8_SCHED;
            PG8_STAGE(PG8_SB(0, 1), b2 + hstep, voffB);
            PG8_WAIT_V(6); PG8_BAR; PG8_MMA(1, 1, At, B1); PG8_BAR;
            PG8_LDB(B0, 1, 0); PG8_SCHED; PG8_LDA(At, 1, 0); PG8_STAGE(PG8_SA(0, 1), a2 + hstep, voffA);
            PG8_WAIT_L(8); PG8_BAR; PG8_WAIT_L(0); PG8_MMA(0, 0, At, B0); PG8_BAR; PG8_SCHED;
            PG8_LDB(B1, 1, 1); PG8_STAGE(PG8_SB(1, 0), b3, voffB);
            PG8_BAR; PG8_WAIT_L(0); PG8_MMA(0, 1, At, B1); PG8_BAR;
            PG8_LDA(At, 1, 1); PG8_STAGE(PG8_SA(1, 0), a3, voffA);
            PG8_BAR; PG8_WAIT_L(0); PG8_MMA(1, 0, At, B0); PG8_BAR; PG8_SCHED;
            PG8_STAGE(PG8_SB(1, 1), b3 + hstep, voffB);
            PG8_WAIT_V(6); PG8_BAR; PG8_MMA(1, 1, At, B1); PG8_BAR;
            }
        }
        if constexpr (ALIGN_EPI) { if (wr == 0) PG8_BAR; }
        if constexpr (I8 == 2) asm volatile("s_nop 15\n\ts_nop 15" ::: "memory");
        if constexpr (I8 == 1) {
#pragma unroll
            for (int a = 0; a < 2; ++a)
#pragma unroll
                for (int b = 0; b < 2; ++b)
#pragma unroll
                    for (int m = 0; m < 4; ++m)
#pragma unroll
                        for (int n = 0; n < 2; ++n) { const i32x4 iv = __builtin_bit_cast(i32x4, acc[a][b][m][n]); acc[a][b][m][n] = (f32x4){(float)iv[0], (float)iv[1], (float)iv[2], (float)iv[3]}; }
        }
        if constexpr (!Epi::AFTER_DRAIN) { E(acc, cur, wr, wc, fr, fq); S.done(cur); }
        if (!has_next) break;
#pragma unroll
        for (int a = 0; a < 2; ++a)
#pragma unroll
            for (int b = 0; b < 2; ++b)
#pragma unroll
                for (int m = 0; m < 4; ++m)
#pragma unroll
                    for (int n = 0; n < 2; ++n) acc[a][b][m][n] = (f32x4){0.f, 0.f, 0.f, 0.f};
        cur = nxt; cA = nA; cB = nB; ++ui;
        if constexpr (ALIGN_EPI) { if (wr == 1) PG8_BAR; }
    }
    PG8_WAIT_V(0);
    if constexpr (!ALIGN_EPI) { if (wr == 0) PG8_BAR; }
    PG8_BAR;
    if constexpr (Epi::AFTER_DRAIN) { E.fused(acc, cur, wr, wc, fr, fq, lds, wid, lane); S.done(cur); }
#undef PG8_SA
#undef PG8_SB
#undef PG8_STAGE
#undef PG8_LDA
#undef PG8_LDB
#undef PG8_MMA
#undef PG8_WAIT_V
#undef PG8_WAIT_L
#undef PG8_BAR
#undef PG8_SCHED
}
}

namespace att {
typedef short bf16x8 __attribute__((ext_vector_type(8)));
typedef short s16x4 __attribute__((ext_vector_type(4)));
typedef float f32x16 __attribute__((ext_vector_type(16)));
typedef float f32x4 __attribute__((ext_vector_type(4)));
typedef unsigned u32x4 __attribute__((ext_vector_type(4)));
template <class A, class Bt> struct same_t { static constexpr bool v = false; };
template <class A> struct same_t<A, A> { static constexpr bool v = true; };
constexpr int D = 128;
constexpr float THR = 8.f;
constexpr bool WSKIP = false;
constexpr float SCALE = 0.08838834764831845f;
constexpr int NW = 8, QBLK = 32, KVBLK = 64, QB = NW * QBLK;
constexpr int SHM_V = KVBLK * D * 2, SHM_K = KVBLK * D * 2;
constexpr int LDS_BYTES = 2 * SHM_V + 2 * SHM_K + NW * 64 * 4;
__device__ __forceinline__ f32x16 mfma32h(bf16x8 a, bf16x8 b, f32x16 c, int, int, int) {
    return __builtin_amdgcn_mfma_f32_32x32x16_f16(__builtin_bit_cast(h16x8, a), __builtin_bit_cast(h16x8, b), c, 0, 0, 0);
}
#define KSWZ(row, colB) ((row) * 256 + ((colB) ^ (((row) & 7) << 4)))
#define SBAR() __builtin_amdgcn_sched_barrier(0)
__device__ __forceinline__ int v_st(int k, int c) { const int kk = (k & ~0xC) | ((k & 4) << 1) | ((k & 8) >> 1); return ((kk >> 3) * 4 + (c >> 5)) * 512 + ((kk & 7) * 32 + (c & 31)) * 2; }
__device__ __forceinline__ int v_rd_base(int lane) { return ((lane & 3) << 3) | (((lane >> 2) & 3) << 6) | (((lane >> 4) & 1) << 5) | (((lane >> 5) & 1) << 8); }
constexpr int v_rd_off(int d0, int ks, int half) { return d0 * 512 + ks * 4096 + half * 2048; }
__device__ __forceinline__ int crow(int r, int hi) { return (r & 3) + 8 * (r >> 2) + 4 * hi; }
__device__ __forceinline__ unsigned cvtpk(float lo, float hi) {
    unsigned r; asm volatile("v_cvt_pk_f16_f32 %0, %1, %2" : "=v"(r) : "v"(lo), "v"(hi)); return r;
}
__device__ __forceinline__ bf16x8 pack8(f32x4 a, f32x4 b) {
    u32x4 w = {cvtpk(a[0], a[1]), cvtpk(a[2], a[3]), cvtpk(b[0], b[1]), cvtpk(b[2], b[3])};
    return *reinterpret_cast<bf16x8*>(&w);
}
template <class T> __device__ __forceinline__ bf16x8 load8(const T* p) {
    if constexpr (same_t<T, float>::v) { return pack8(*(const f32x4*)p, *(const f32x4*)(p + 4)); }
    else { return *reinterpret_cast<const bf16x8*>(p); }
}
__device__ __forceinline__ void mask_tile(f32x16& p0, f32x16& p1, int dq, unsigned W) {
    const float NEG = -__builtin_inff();
#pragma unroll
    for (int r = 0; r < 16; ++r) {
        const int c = (r & 3) + 8 * (r >> 2);
        if ((unsigned)(dq - c) >= W) p0[r] = NEG;
        if ((unsigned)(dq - c - 32) >= W) p1[r] = NEG;
    }
}
__device__ __forceinline__ void partialSM(f32x16& p0, f32x16& p1, float& m_reg, float& mn, float& alpha) {
    float pmax = p0[0]; for (int r = 1; r < 16; ++r) pmax = fmaxf(pmax, p0[r]); for (int r = 0; r < 16; ++r) pmax = fmaxf(pmax, p1[r]);
    { auto rr = __builtin_amdgcn_permlane32_swap(__float_as_uint(pmax), __float_as_uint(pmax), false, false);
      pmax = fmaxf(__uint_as_float(rr[0]), __uint_as_float(rr[1])); }
    constexpr float C2 = 1.4426950408889634f * SCALE;
    if (__builtin_expect(__all((pmax - m_reg) * SCALE <= THR), 1)) { mn = m_reg; alpha = 1.f; }
    else { mn = fmaxf(m_reg, pmax); alpha = __builtin_amdgcn_exp2f((m_reg - mn) * C2); m_reg = mn; }
    const float mnL = -mn * C2;
    for (int r = 0; r < 16; ++r) p0[r] = fmaf(p0[r], C2, mnL); for (int r = 0; r < 16; ++r) p1[r] = fmaf(p1[r], C2, mnL);
    for (int r = 0; r < 16; ++r) p0[r] = __builtin_amdgcn_exp2f(p0[r]);
}
__device__ __forceinline__ void finishSM(f32x16& p0, f32x16& p1, float alpha, float& l_reg, bf16x8& pa0, bf16x8& pa1, bf16x8& pa2, bf16x8& pa3) {
    for (int r = 0; r < 16; ++r) p1[r] = __builtin_amdgcn_exp2f(p1[r]);
    float ps = 0; for (int r = 0; r < 16; ++r) ps += p0[r]; for (int r = 0; r < 16; ++r) ps += p1[r];
    { auto rr = __builtin_amdgcn_permlane32_swap(__float_as_uint(ps), __float_as_uint(ps), false, false);
      ps = __uint_as_float(rr[0]) + __uint_as_float(rr[1]); }
    l_reg = l_reg * alpha + ps;
#define PK4(P, B_, OUT) do { unsigned a0 = cvtpk(P[B_+0], P[B_+1]), a1 = cvtpk(P[B_+2], P[B_+3]);                          \
        unsigned b0 = cvtpk(P[B_+4], P[B_+5]), b1 = cvtpk(P[B_+6], P[B_+7]);                                             \
        auto r0 = __builtin_amdgcn_permlane32_swap(a0, b0, false, false); auto r1 = __builtin_amdgcn_permlane32_swap(a1, b1, false, false); \
        u32x4 w = {r0[0], r1[0], r0[1], r1[1]}; OUT = *reinterpret_cast<bf16x8*>(&w); } while (0)
    PK4(p0, 0, pa0); PK4(p0, 8, pa1); PK4(p1, 0, pa2); PK4(p1, 8, pa3);
#undef PK4
}
template <int KB, bool SK>
__device__ __forceinline__ void qkt(f32x16& p0, f32x16& p1, const char* K_lds, int r32, int hi, const bf16x8* qr, bool act) {
    if (SK && !act) { const float NEG = -__builtin_inff();
#pragma unroll
        for (int r = 0; r < 16; ++r) { p0[r] = NEG; p1[r] = NEG; } return; }
    p0 = f32x16{}; p1 = f32x16{};
    const char* kb[4];
#pragma unroll
    for (int dd = 0; dd < 4; ++dd) kb[dd] = K_lds + KB * SHM_K + KSWZ(r32, (dd * 16 + hi * 8) * 2);
#pragma unroll
    for (int d0 = 0; d0 < 8; ++d0) { const char* a = kb[d0 & 3] + (d0 >> 2) * 128;
        bf16x8 b0 = *reinterpret_cast<const bf16x8*>(a);
        bf16x8 b1 = *reinterpret_cast<const bf16x8*>(a + 32 * 256);
        p0 = mfma32h(b0, qr[d0], p0, 0, 0, 0);
        p1 = mfma32h(b1, qr[d0], p1, 0, 0, 0); }
}
template <int VB, bool SK>
__device__ __forceinline__ void pv_tile(f32x16* o, int vb0, bf16x8 pa0, bf16x8 pa1, bf16x8 pa2, bf16x8 pa3, bool act) {
    if (SK && !act) return;
#define TRRD(dst, off) asm volatile("ds_read_b64_tr_b16 %0, %1 offset:%2" : "=&v"(dst) : "v"(vb0), "i"(off) : "memory")
#define PV_D0(d0) do { s16x4 l0, l1, l2, l3, h0, h1, h2, h3; constexpr int b_ = VB * SHM_V + v_rd_off(d0, 0, 0);     \
        TRRD(l0, b_); TRRD(h0, b_ + 2048); TRRD(l1, b_ + 4096); TRRD(h1, b_ + 6144); TRRD(l2, b_ + 8192); TRRD(h2, b_ + 10240); TRRD(l3, b_ + 12288); TRRD(h3, b_ + 14336); \
        asm volatile("s_waitcnt lgkmcnt(0)" ::: "memory"); SBAR();                 \
        o[d0] = mfma32h(pa0, (bf16x8){l0[0], l0[1], l0[2], l0[3], h0[0], h0[1], h0[2], h0[3]}, o[d0], 0, 0, 0);   \
        o[d0] = mfma32h(pa1, (bf16x8){l1[0], l1[1], l1[2], l1[3], h1[0], h1[1], h1[2], h1[3]}, o[d0], 0, 0, 0);   \
        o[d0] = mfma32h(pa2, (bf16x8){l2[0], l2[1], l2[2], l2[3], h2[0], h2[1], h2[2], h2[3]}, o[d0], 0, 0, 0);   \
        o[d0] = mfma32h(pa3, (bf16x8){l3[0], l3[1], l3[2], l3[3], h3[0], h3[1], h3[2], h3[3]}, o[d0], 0, 0, 0); } while (0)
    PV_D0(0); PV_D0(1); PV_D0(2); PV_D0(3);
#undef PV_D0
#undef TRRD
}

template <class TIn, class TOut> struct BlockRef { const TIn* Q; const TIn* K; const TIn* V; TOut* O; int P0; };
template <class TIn> struct Seam {
    bf16x8 qr[8];
    bf16x8 st_v0, st_v1, st_k0, st_k1; f32x4 sf0, sf1, sf2, sf3;
    f32x4 tq[16];
};
__device__ __forceinline__ int swa_jlo(int P0, int W) { const int lowk = P0 - W + 1; return lowk > 0 ? lowk / KVBLK : 0; }
#define ROW(p, k0, rr) ((p) + (size_t)((k0) + (rr)) * D + sc)
#define VMW() asm volatile("s_waitcnt vmcnt(0)" ::: "memory")
#define VMWN(n) asm volatile("s_waitcnt vmcnt(%0)" :: "i"(n) : "memory")
#define SLOAD_H(Kp, Vp, k0) do { S.st_v0 = load8<TIn>(ROW(Vp, k0, sr)); S.st_v1 = load8<TIn>(ROW(Vp, k0, 32 + sr));              \
                         S.st_k0 = load8<TIn>(ROW(Kp, k0, sr)); S.st_k1 = load8<TIn>(ROW(Kp, k0, 32 + sr)); } while (0)
#define SWRITE_HK(bf) do { *(bf16x8*)(K_lds + (bf) * SHM_K + kws) = S.st_k0; *(bf16x8*)(K_lds + (bf) * SHM_K + kws + 32 * 256) = S.st_k1; } while (0)
#define SWRITE_HV(bf) do { *(bf16x8*)(V_lds + (bf) * SHM_V + vst0) = S.st_v0; *(bf16x8*)(V_lds + (bf) * SHM_V + vst1) = S.st_v1; } while (0)
#define SWRITE_H(bf) do { SWRITE_HV(bf); SWRITE_HK(bf); } while (0)
#define SLOAD_F(p, k0) do { S.sf0 = *(const f32x4*)ROW(p, k0, sr); S.sf1 = *(const f32x4*)(ROW(p, k0, sr) + 4);                \
                            S.sf2 = *(const f32x4*)ROW(p, k0, 32 + sr); S.sf3 = *(const f32x4*)(ROW(p, k0, 32 + sr) + 4); } while (0)
#define SWRITE_KF(bf) do { *(bf16x8*)(K_lds + (bf) * SHM_K + kws) = pack8(S.sf0, S.sf1); *(bf16x8*)(K_lds + (bf) * SHM_K + kws + 32 * 256) = pack8(S.sf2, S.sf3); } while (0)
#define SWRITE_VF(bf) do { *(bf16x8*)(V_lds + (bf) * SHM_V + vst0) = pack8(S.sf0, S.sf1); *(bf16x8*)(V_lds + (bf) * SHM_V + vst1) = pack8(S.sf2, S.sf3); } while (0)
template <class TIn, class TOut>
__device__ __forceinline__ void causal_swa_prime(const BlockRef<TIn, TOut>& cur, int W, char* lds, Seam<TIn>& S) {
    constexpr bool F32 = same_t<TIn, float>::v;
    const int tid = opaque_tid(), wid = __builtin_amdgcn_readfirstlane(tid >> 6), lane = tid & 63, r32 = lane & 31, hi = lane >> 5;
    const int sr = tid >> 4, sc = (tid & 15) * 8, kws = KSWZ(sr, sc * 2); char* K_lds = lds + 2 * SHM_V;
    const int kb0 = swa_jlo(cur.P0, W) * KVBLK;
    for (int d0 = 0; d0 < 8; ++d0) S.qr[d0] = load8<TIn>(cur.Q + (size_t)(wid * QBLK + r32) * D + d0 * 16 + hi * 8);
    if constexpr (F32) { SLOAD_F((const float*)cur.K, kb0); VMW(); SWRITE_KF(0); SBAR(); SLOAD_F((const float*)cur.V, kb0); }
    else { SLOAD_H(cur.K, cur.V, kb0); VMW(); SWRITE_HK(0); }
    __syncthreads();
}
template <class TIn, class TOut>
__device__ __forceinline__ void causal_swa_block(const BlockRef<TIn, TOut>& cur, const BlockRef<TIn, TOut>& nxt, int skv, int W, char* lds, Seam<TIn>& S) {
    constexpr bool F32 = same_t<TIn, float>::v;
    const int tid = opaque_tid(), wid = __builtin_amdgcn_readfirstlane(tid >> 6), lane = tid & 63, r32 = lane & 31, hi = lane >> 5;
    const int j_lo = swa_jlo(cur.P0, W);
    int j_hi = (cur.P0 + QB - 1) / KVBLK + 1; if (j_hi > skv / KVBLK) j_hi = skv / KVBLK;
    const int NT = j_hi - j_lo;
    const int kbn = swa_jlo(nxt.P0, W) * KVBLK;
    const int qlo = cur.P0 + wid * QBLK, qm = qlo + r32 - 4 * hi;
    char* V_lds = lds; char* K_lds = lds + 2 * SHM_V;
    float* ws = (float*)(lds + 2 * SHM_V + 2 * SHM_K) + wid * 64; float* li_l = ws, * al_l = ws + 32;
    float m_reg = -1e30f, l_reg = 0; f32x16 o[4] = {};
    const int sr = tid >> 4, sc = (tid & 15) * 8, vst0 = v_st(sr, sc), vst1 = v_st(32 + sr, sc), kws = KSWZ(sr, sc * 2);
    const int vb0 = (int)(uintptr_t)V_lds + v_rd_base(lane);
    const TIn* Kh = cur.K; const TIn* Vh = cur.V;
#define RESC(a) do { if (__any((a) < 1.f)) { if (hi == 0) al_l[r32] = (a); asm volatile("s_waitcnt lgkmcnt(0)" ::: "memory");              \
                     for (int d_ = 0; d_ < 4; ++d_) for (int r = 0; r < 16; ++r) o[d_][r] *= al_l[crow(r, hi)]; } } while (0)
#define KBASE(t) ((j_lo + (t)) * KVBLK)
#define ACT(t) (KBASE(t) <= qlo + QBLK - 1 && KBASE(t) + KVBLK - 1 >= qlo - W + 1)
#define MASKT(P0_, P1_, t) do { const int kb_ = KBASE(t); if ((!SK || ACT(t)) && (kb_ + KVBLK - 1 > qlo || kb_ <= qlo + QBLK - 1 - W)) mask_tile(P0_, P1_, qm - kb_, (unsigned)W); } while (0)
    constexpr int NQL = F32 ? 16 : 8;
    constexpr bool SK = WSKIP && !F32;
#define SEAM_K0() do { VMWN(NQL); if constexpr (F32) { SWRITE_KF(0); SBAR(); SLOAD_F((const float*)nxt.V, kbn); } else { SWRITE_HK(0); } SBAR(); } while (0)
    f32x16 pA0, pA1, pB0, pB1; float mnA, mnB, alA, alB; bf16x8 pa0, pa1, pa2, pa3;
    if constexpr (F32) { VMW(); SWRITE_VF(0); SBAR(); } else { SWRITE_HV(0); SBAR(); }
    if (NT > 1) { if constexpr (F32) SLOAD_F((const float*)Kh, KBASE(1)); else SLOAD_H(Kh, Vh, KBASE(1)); }
    SBAR(); qkt<0, SK>(pA0, pA1, K_lds, r32, hi, S.qr, ACT(0));
    if constexpr (F32) { if (NT > 1) { VMW(); SWRITE_KF(1); SBAR(); SLOAD_F((const float*)Vh, KBASE(1)); } }
    MASKT(pA0, pA1, 0); partialSM(pA0, pA1, m_reg, mnA, alA);
    if (NT > 1) { VMW(); if constexpr (F32) { SWRITE_VF(1); SBAR(); if (NT > 2) SLOAD_F((const float*)Kh, KBASE(2)); } else SWRITE_H(1); }
    __syncthreads();
#define HALF_STEP(PX0, PX1, mnX, alX, PY0, PY1, alY, t, KB, VB, SB) do {                                                      \
        SBAR(); qkt<KB, SK>(PX0, PX1, K_lds, r32, hi, S.qr, ACT(t));                                             \
        finishSM(PY0, PY1, alY, l_reg, pa0, pa1, pa2, pa3); SBAR();                                                           \
        if ((t) + 1 < NT) { if constexpr (F32) { VMW(); SWRITE_KF(SB); SBAR(); SLOAD_F((const float*)Vh, KBASE((t) + 1)); }  \
                            else { SLOAD_H(Kh, Vh, KBASE((t) + 1)); } SBAR(); }                                               \
        pv_tile<VB, SK>(o, vb0, pa0, pa1, pa2, pa3, ACT((t) - 1)); MASKT(PX0, PX1, (t)); partialSM(PX0, PX1, m_reg, mnX, alX);                                        \
        __syncthreads();                                                                                                      \
        if ((t) + 1 < NT) { VMW(); if constexpr (F32) { SWRITE_VF(SB); SBAR(); if ((t) + 2 < NT) SLOAD_F((const float*)Kh, KBASE((t) + 2)); } \
                            else { SWRITE_H(SB); } }                                                                          \
        RESC(alX); __syncthreads(); } while (0)
    for (int t = 1; t + 1 < NT; t += 2) {
        HALF_STEP(pB0, pB1, mnB, alB, pA0, pA1, alA, t, 1, 0, 0);
        HALF_STEP(pA0, pA1, mnA, alA, pB0, pB1, alB, t + 1, 0, 1, 1);
    }
    const bool even = (NT & 1) == 0;
    if (even) { SBAR(); qkt<1, SK>(pB0, pB1, K_lds, r32, hi, S.qr, ACT(NT - 1)); SBAR(); }
#define QROW(e) (nxt.Q + (size_t)(wid * QBLK + r32) * D + ((e) >> 1) * 16 + hi * 8 + ((e) & 1) * 4)
    if constexpr (F32) { SLOAD_F((const float*)nxt.K, kbn); SBAR();
#pragma unroll
        for (int e = 0; e < 8; ++e) S.tq[e] = *(const f32x4*)QROW(e); }
    else { SLOAD_H(nxt.K, nxt.V, kbn); SBAR();
#pragma unroll
        for (int d0 = 0; d0 < 8; ++d0) S.qr[d0] = load8<TIn>(nxt.Q + (size_t)(wid * QBLK + r32) * D + d0 * 16 + hi * 8); }
    SBAR();
    finishSM(pA0, pA1, alA, l_reg, pa0, pa1, pa2, pa3); SBAR();
    if constexpr (F32) {
#pragma unroll
        for (int e = 8; e < 16; ++e) S.tq[e] = *(const f32x4*)QROW(e); SBAR(); }
#undef QROW
    pv_tile<0, SK>(o, vb0, pa0, pa1, pa2, pa3, ACT(even ? NT - 2 : NT - 1));
    if (even) { MASKT(pB0, pB1, NT - 1); partialSM(pB0, pB1, m_reg, mnB, alB); __syncthreads(); RESC(alB);
        finishSM(pB0, pB1, alB, l_reg, pa0, pa1, pa2, pa3); SBAR(); pv_tile<1, SK>(o, vb0, pa0, pa1, pa2, pa3, ACT(NT - 1)); }
    SBAR(); SEAM_K0();
    if (hi == 0) li_l[r32] = l_reg; asm volatile("s_waitcnt lgkmcnt(0)" ::: "memory");
    float rli[16];
#pragma unroll
    for (int r = 0; r < 16; ++r) rli[r] = __builtin_amdgcn_rcpf(li_l[crow(r, hi)]);
    TOut* Ow = cur.O + (size_t)(wid * QBLK) * D;
#pragma unroll
    for (int r = 0; r < 16; ++r) { const int orow = crow(r, hi);
#pragma unroll
        for (int d0 = 0; d0 < 4; ++d0) { const float v = o[d0][r] * rli[r];
            if constexpr (same_t<TOut, float>::v) { Ow[(size_t)orow * D + d0 * 32 + r32] = v; }
            else { const float vn = swz_xor<1>(v);
                   if ((r32 & 1) == 0) *(unsigned*)(Ow + (size_t)orow * D + d0 * 32 + r32) = cvtpk(v, vn); } } }
    if constexpr (F32) {
#pragma unroll
        for (int d0 = 0; d0 < 8; ++d0) S.qr[d0] = pack8(S.tq[2 * d0], S.tq[2 * d0 + 1]); }
    __syncthreads();
#undef RESC
#undef KBASE
#undef ACT
#undef MASKT
#undef SEAM_K0
#undef HALF_STEP
}
#undef ROW
#undef VMW
#undef VMWN
#undef SLOAD_H
#undef SWRITE_HK
#undef SWRITE_HV
#undef SWRITE_H
#undef SLOAD_F
#undef SWRITE_KF
#undef SWRITE_VF

}

constexpr size_t MiB = 1u << 20;
constexpr size_t WS_CTL = 0, CTL_ZERO_BYTES = 64 * 1024;
constexpr size_t WS_MODP = 2 * MiB;
constexpr size_t WS_MOD = 12 * MiB;
constexpr size_t WS_SSQ = 13 * MiB + 256 * 1024;
constexpr size_t WS_BIAS = 20 * MiB;
constexpr size_t WS_COS = 14 * MiB, WS_SIN = 16 * MiB;
constexpr size_t WS_COSI = 18 * MiB, WS_SINI = 19 * MiB;
constexpr size_t WS_WGU = 32 * MiB;
constexpr size_t WS_WDN = WS_WGU + 8 * 44 * MiB;
constexpr size_t WS_WAIN = WS_WDN + 8 * 22 * MiB;
constexpr size_t WS_WAOUT = WS_WAIN + 2 * 24 * MiB;
constexpr size_t WS_WBIN = WS_WAOUT + 2 * 8 * MiB;
constexpr size_t WS_WBOUT = WS_WBIN + 2 * 18 * MiB;
constexpr size_t WS_XN = WS_WBOUT + 2 * 8 * MiB;
constexpr size_t WS_AO = WS_XN + 128 * MiB;
constexpr size_t WS_BIG = WS_AO + 128 * MiB;
constexpr size_t WS_Q = WS_BIG + 384 * MiB, WS_K = WS_Q + 128 * MiB, WS_V = WS_K + 128 * MiB;
constexpr size_t WS_O = WS_V + 128 * MiB;
constexpr size_t WS_WQ = WS_O + 256 * MiB;
constexpr size_t WS_XQ = WS_WQ + 8 * 22 * MiB;
constexpr size_t WS_WOQ = WS_XQ + 64 * MiB;
constexpr size_t WS_WQA = WS_WOQ + 16 * MiB;
constexpr size_t WS_END = WS_WQA + 24 * MiB;
constexpr size_t WS_XH = WS_WGU;
constexpr size_t WS_TQ = 24 * MiB;
constexpr size_t WS_WQD = WS_WGU + 128 * MiB;
constexpr size_t WS_WQB = WS_WGU + 224 * MiB;
constexpr size_t WS_TQB = 30 * MiB;
constexpr int B_QKV = 2304;
constexpr size_t WS_HQ = WS_Q;
constexpr size_t WS_TQD = 29 * MiB;
constexpr size_t WS_RFH = 30 * MiB;
constexpr unsigned DN_I8_MASK = 0xFFFu;
constexpr size_t WS_TQA = 28 * MiB;
constexpr size_t WS_TQO = 26 * MiB;
constexpr size_t WS_RFO = 27 * MiB;
constexpr size_t WS_RF = 25 * MiB;
static_assert(WS_XN == 676 * MiB && WS_WQ == 1956 * MiB && WS_END == 2236 * MiB, "d_ws map");
constexpr int CW_BAR = 4096;

constexpr int RING_BYTES = 131072;
constexpr int RING_BYTES_P0W = 131072;
constexpr int MISC_OFF = RING_BYTES + 320;
static_assert(TIDTAB_OFF == MISC_OFF + 128, "LDS map");
constexpr int LDS_BYTES = 155648;
constexpr int NWAVES = 8;

#define GAS __attribute__((address_space(1)))
#define LAS __attribute__((address_space(3)))
typedef unsigned v4u __attribute__((ext_vector_type(4)));
typedef float f32x4 __attribute__((ext_vector_type(4)));
typedef float f32x2 __attribute__((ext_vector_type(2)));
#define LDS_WAIT() asm volatile("s_waitcnt lgkmcnt(0)" ::: "memory")
#define VM_WAIT() asm volatile("s_waitcnt vmcnt(0)" ::: "memory")
__device__ __forceinline__ unsigned pkh(float lo, float hi) { h16x2 v = {(_Float16)lo, (_Float16)hi}; return __builtin_bit_cast(unsigned, v); }
__device__ __forceinline__ float wave_sum(float v) {
    v += swz_xor<1>(v); v += swz_xor<2>(v); v += swz_xor<4>(v); v += swz_xor<8>(v); v = add_xor16(v);
    return add_xor32(v);
}

#define XB_TMO      128
#define XB_XCNT(j)  (256  + 64 * (j))
#define XB_XSUB(j)  (1280 + 64 * (j))
#define XB_XGEN(j)  (2304 + 64 * (j))
#define XB_TOP      3328
#define XB_TOPGEN   3392
#define XCD_BAR_WORDS 3456
#define XB_SPIN_CAP (1u << 21)

__device__ __forceinline__ unsigned xb_ld(unsigned* p)              { return __hip_atomic_load(p, __ATOMIC_RELAXED, __HIP_MEMORY_SCOPE_AGENT); }
__device__ __forceinline__ unsigned xb_add(unsigned* p, unsigned v) { return __hip_atomic_fetch_add(p, v, __ATOMIC_RELAXED, __HIP_MEMORY_SCOPE_AGENT); }
__device__ __forceinline__ unsigned xb_xcc_id() { return (unsigned)__builtin_amdgcn_s_getreg((3 << 11) | 20) & 0xFu; }
#define XB_SPIN(cond, bar) do { unsigned _sp = 0; while (cond) { __builtin_amdgcn_s_sleep(1); \
    if ((++_sp & 255u) == 0u) { if (xb_ld(&(bar)[XB_TMO])) break; if (_sp > XB_SPIN_CAP) { atomicAdd(&(bar)[XB_TMO], 1u); break; } } } } while (0)

struct XcdBarrier { unsigned* bar; unsigned x; volatile LAS unsigned* st; };

__device__ __forceinline__ XcdBarrier xcd_barrier_post(unsigned* bar, volatile LAS unsigned* st) {
    XcdBarrier b; b.bar = bar; b.x = xb_xcc_id(); b.st = st;
    if (opaque_tid() == 0) (void)xb_add(&bar[XB_XCNT(b.x)], 1u);
    return b;
}
__device__ __forceinline__ void xcd_barrier_complete(unsigned* bar, unsigned x, unsigned& nloc, unsigned& nx) {
    const unsigned G = gridDim.x * gridDim.y * gridDim.z;
    unsigned sum, cnt, mine, sp = 0u;
    for (;;) {
        sum = 0u; cnt = 0u; mine = 0u;
#pragma unroll
        for (unsigned j = 0; j < 16; ++j) { const unsigned c = xb_ld(&bar[XB_XCNT(j)]); sum += c; cnt += (c > 0u) ? 1u : 0u; mine = (j == x) ? c : mine; }
        if (sum == G) break;
        __builtin_amdgcn_s_sleep(1);
        if ((++sp & 255u) == 0u) { if (xb_ld(&bar[XB_TMO])) break; if (sp > XB_SPIN_CAP) { atomicAdd(&bar[XB_TMO], 1u); break; } }
    }
    nloc = mine > 0u ? mine : 1u; nx = cnt > 0u ? cnt : 1u;
}
__device__ __forceinline__ void xcd_barrier(const XcdBarrier& b) {
    asm volatile("s_waitcnt vmcnt(0)" ::: "memory");
    __syncthreads();
    if (opaque_tid() == 0) {
        unsigned* bar = b.bar;
        __builtin_amdgcn_s_waitcnt(0);
        unsigned nloc = b.st[0], nx = b.st[1];
        if (nloc == 0u) { xcd_barrier_complete(bar, b.x, nloc, nx); b.st[0] = nloc; b.st[1] = nx; }
        const unsigned old = xb_add(&bar[XB_XSUB(b.x)], 1u);
        const unsigned gen = old / nloc;
        if (old + 1u == (gen + 1u) * nloc) {
            __builtin_amdgcn_fence(__ATOMIC_RELEASE, "agent");
            asm volatile("s_waitcnt vmcnt(0)" ::: "memory");
            const unsigned og = xb_add(&bar[XB_TOP], 1u);
            const unsigned tg = og / nx;
            if (og + 1u == (tg + 1u) * nx) xb_add(&bar[XB_TOPGEN], 1u);
            else XB_SPIN(xb_ld(&bar[XB_TOPGEN]) == tg, bar);
            __builtin_amdgcn_fence(__ATOMIC_ACQUIRE, "agent");
            xb_add(&bar[XB_XGEN(b.x)], 1u);
            asm volatile("s_waitcnt vmcnt(0)" ::: "memory");
        } else {
            XB_SPIN(xb_ld(&bar[XB_XGEN(b.x)]) == gen, bar);
            __builtin_amdgcn_fence(__ATOMIC_ACQUIRE, "agent");
            asm volatile("s_waitcnt vmcnt(0)" ::: "memory");
        }
    }
    __syncthreads();
}

__device__ __forceinline__ void p0_transpose_item(const float* W, int K, int N, u16* WT, int dest_row, int k0, int n0, LAS float* scr, int lane) {
    {
        const int c4 = lane & 7, kr = lane >> 3; const bool ok = n0 + 4 * c4 + 3 < N;
        const float* wp = W + (size_t)(k0 + kr) * N + n0 + 4 * c4;
        f32x4 v[8];
#pragma unroll
        for (int i = 0; i < 8; ++i) v[i] = ok ? *(const f32x4*)(wp + (size_t)(8 * i) * N) : (f32x4){0.f, 0.f, 0.f, 0.f};
#pragma unroll
        for (int i = 0; i < 8; ++i) { LAS float* d = scr + (kr + 8 * i) * 33 + 4 * c4; d[0] = v[i].x; d[1] = v[i].y; d[2] = v[i].z; d[3] = v[i].w; }
    }
    LDS_WAIT(); asm volatile("" ::: "memory");
    const int c = lane & 7;
#pragma unroll
    for (int j = 0; j < 4; ++j) { const int n = (lane >> 3) + 8 * j; const LAS float* s = scr + (8 * c) * 33 + n;
        v4u o; o.x = pkh(s[0 * 33], s[1 * 33]); o.y = pkh(s[2 * 33], s[3 * 33]); o.z = pkh(s[4 * 33], s[5 * 33]); o.w = pkh(s[6 * 33], s[7 * 33]);
        *(GAS v4u*)(WT + (size_t)(dest_row + n) * K + k0 + 8 * c) = o; }
    LDS_WAIT(); asm volatile("" ::: "memory");
}
__device__ __forceinline__ void p0_ada_item(const float* c, const float* ada_w, float* part, int item, LAS float* scr, int lane) {
    const int kc = item & 7, cc = (item >> 3) % 72, layer = item / (8 * 72);
#pragma unroll
    for (int i = 0; i < 4; ++i) { const int k = lane + 64 * i;
#pragma unroll
        for (int b = 0; b < NB; ++b) { const float v = c[b * DM + kc * 256 + k]; scr[k * 4 + b] = v / (1.0f + __expf(-v)); } }
    LDS_WAIT(); asm volatile("" ::: "memory");
    f32x4 a0 = {0.f, 0.f, 0.f, 0.f}, a1 = a0, a2 = a0, a3 = a0;
    const float* wp = ada_w + ((size_t)layer * DM + kc * 256) * ADAW + cc * 256 + lane * 4;
#pragma unroll 8
    for (int k = 0; k < 256; ++k) {
        const f32x4 w = *(const f32x4*)(wp + (size_t)k * ADAW); const f32x4 cb = *(const LAS f32x4*)(scr + k * 4);
        a0 += w * cb[0]; a1 += w * cb[1]; a2 += w * cb[2]; a3 += w * cb[3];
    }
    float* pp = part + ((size_t)(kc * DEPTH + layer) * NB) * ADAW + cc * 256 + lane * 4;
    *(f32x4*)(pp) = a0; *(f32x4*)(pp + ADAW) = a1; *(f32x4*)(pp + 2 * ADAW) = a2; *(f32x4*)(pp + 3 * ADAW) = a3;
    LDS_WAIT(); asm volatile("" ::: "memory");
}
__device__ __forceinline__ void sincos_d(double ang, float& co, float& si) {
    const double k = __builtin_rint(ang * 0.6366197723675814);
    double r = __builtin_fma(-k, 1.5707963267948966, ang); r = __builtin_fma(-k, 6.123233995736766e-17, r);
    const double r2 = r * r;
    double s = -7.6471637318198164759e-13; s = s * r2 + 1.6059043836821614599e-10; s = s * r2 - 2.5052108385441718775e-08; s = s * r2 + 2.7557319223985890653e-06;
    s = s * r2 - 1.9841269841269841270e-04; s = s * r2 + 8.3333333333333333333e-03; s = s * r2 - 1.6666666666666666667e-01; s = s * r2 * r + r;
    double c = 4.7794773323873852974e-14; c = c * r2 - 1.1470745597729724714e-11; c = c * r2 + 2.0876756987868098979e-09; c = c * r2 - 2.7557319223985890653e-07;
    c = c * r2 + 2.4801587301587301587e-05; c = c * r2 - 1.3888888888888888889e-03; c = c * r2 + 4.1666666666666666667e-02; c = c * r2 - 0.5; c = c * r2 + 1.0;
    const int q = ((int)k) & 3;
    const double cc = (q == 0) ? c : (q == 1) ? -s : (q == 2) ? -c : s;
    const double ss = (q == 0) ? s : (q == 1) ? c : (q == 2) ? -s : -c;
    co = (float)cc; si = (float)ss;
}
__device__ __forceinline__ double powi_d(double base, int e) { double r = 1.0, bb = base;
#pragma unroll
    for (int i = 0; i < 6; ++i) { if (e & (1 << i)) r *= bb; bb *= bb; }
    return r; }

__device__ __forceinline__ void unpack8(const h16x8 h, float (&v)[8]) {
#pragma unroll
    for (int e = 0; e < 8; ++e) v[e] = (float)h[e];
}
__device__ __forceinline__ v4u pack8h(const float (&o)[8]) { v4u w; w.x = pkh(o[0], o[1]); w.y = pkh(o[2], o[3]); w.z = pkh(o[4], o[5]); w.w = pkh(o[6], o[7]); return w; }
__device__ __forceinline__ float sum16(float s) { s += swz_xor<1>(s); s += swz_xor<2>(s); s += swz_xor<4>(s); s += swz_xor<8>(s); return s; }

__device__ __forceinline__ float max_xor16(float v) { auto r = __builtin_amdgcn_permlane16_swap(__float_as_uint(v), __float_as_uint(v), false, false); return fmaxf(__uint_as_float(r[0]), __uint_as_float(r[1])); }
__device__ __forceinline__ float max_xor32(float v) { auto r = __builtin_amdgcn_permlane32_swap(__float_as_uint(v), __float_as_uint(v), false, false); return fmaxf(__uint_as_float(r[0]), __uint_as_float(r[1])); }
__device__ __forceinline__ float wave_max(float v) {
    v = fmaxf(v, swz_xor<1>(v)); v = fmaxf(v, swz_xor<2>(v)); v = fmaxf(v, swz_xor<4>(v)); v = fmaxf(v, swz_xor<8>(v)); v = max_xor16(v);
    return max_xor32(v);
}
__device__ __forceinline__ unsigned pack4_i8(float a, float b, float c, float d) {
    const int ia = (int)__builtin_rintf(a), ib = (int)__builtin_rintf(b), ic = (int)__builtin_rintf(c), id = (int)__builtin_rintf(d);
    return ((unsigned)ia & 255u) | (((unsigned)ib & 255u) << 8) | (((unsigned)ic & 255u) << 16) | ((unsigned)id << 24);
}
template <bool IN32, bool XNOUT = false>
__device__ __forceinline__ void phase_quant(const float* x32, u16* xh, unsigned long long* xq, const float* scale, float* rf, int gw, int NGW, int lane, u16* xn = nullptr, float* ssq0 = nullptr) {
    constexpr int rpw = 16;
    for (int grp = gw; grp < MTOK / rpw; grp += NGW) {
    const int m0 = grp * rpw, b = m0 >> 13;
    f32x4 sc[4][2];
    { const f32x4* sp = (const f32x4*)(scale + (size_t)b * ADAW) + 2 * lane;
#pragma unroll
      for (int j = 0; j < 4; ++j) { sc[j][0] = sp[128 * j] + 1.0f; sc[j][1] = sp[128 * j + 1] + 1.0f; } }
    h16x8 v[4];
#define PQ_LOAD(m_) do { if constexpr (IN32) { const f32x4* xr = (const f32x4*)(x32 + (size_t)(m_) * DM) + 2 * lane; \
            _Pragma("unroll") for (int j = 0; j < 4; ++j) { const f32x4 a = xr[128 * j], c = xr[128 * j + 1]; \
                v[j] = (h16x8){(_Float16)a.x, (_Float16)a.y, (_Float16)a.z, (_Float16)a.w, (_Float16)c.x, (_Float16)c.y, (_Float16)c.z, (_Float16)c.w}; } } \
        else { const h16x8* xr = (const h16x8*)(xh + (size_t)(m_) * DM) + lane; _Pragma("unroll") for (int j = 0; j < 4; ++j) v[j] = xr[64 * j]; } } while (0)
    PQ_LOAD(m0);
    for (int i = 0; i < rpw; ++i) {
        const int m = m0 + i;
        f32x4 y[4][2]; float s = 0.f, am = 0.f;
#pragma unroll
        for (int j = 0; j < 4; ++j) {
            const f32x4 a = (f32x4){(float)v[j][0], (float)v[j][1], (float)v[j][2], (float)v[j][3]}, c = (f32x4){(float)v[j][4], (float)v[j][5], (float)v[j][6], (float)v[j][7]};
            s += (a.x * a.x + a.y * a.y) + (a.z * a.z + a.w * a.w) + (c.x * c.x + c.y * c.y) + (c.z * c.z + c.w * c.w);
            y[j][0] = a * sc[j][0]; y[j][1] = c * sc[j][1];
            am = fmaxf(am, fmaxf(fmaxf(fmaxf(__builtin_fabsf(y[j][0].x), __builtin_fabsf(y[j][0].y)), fmaxf(__builtin_fabsf(y[j][0].z), __builtin_fabsf(y[j][0].w))),
                                 fmaxf(fmaxf(__builtin_fabsf(y[j][1].x), __builtin_fabsf(y[j][1].y)), fmaxf(__builtin_fabsf(y[j][1].z), __builtin_fabsf(y[j][1].w)))));
        }
        if constexpr (IN32) { h16x8* xo = (h16x8*)(xh + (size_t)m * DM) + lane;
#pragma unroll
            for (int j = 0; j < 4; ++j) xo[64 * j] = v[j]; }
        if constexpr (XNOUT) { v4u* xo = (v4u*)(xn + (size_t)m * DM) + lane;
#pragma unroll
            for (int j = 0; j < 4; ++j) { v4u w; w.x = pkh(y[j][0].x, y[j][0].y); w.y = pkh(y[j][0].z, y[j][0].w); w.z = pkh(y[j][1].x, y[j][1].y); w.w = pkh(y[j][1].z, y[j][1].w); xo[64 * j] = w; } }
        if (i + 1 < rpw) PQ_LOAD(m + 1);
        s = wave_sum(s); am = wave_max(am);
        if constexpr (XNOUT) { if (lane == 0) ssq0[m] = s; }
        const float inv = am > 0.f ? 127.0f / am : 0.f;
        if (lane == 0) rf[m] = rsqrtf(s * (1.0f / DM) + NORM_EPS) * (am * (1.0f / 127.0f));
        unsigned long long* o = xq + (size_t)m * (DM / 8) + lane;
#pragma unroll
        for (int j = 0; j < 4; ++j) o[64 * j] = (unsigned long long)pack4_i8(y[j][0].x * inv, y[j][0].y * inv, y[j][0].z * inv, y[j][0].w * inv)
                                              | ((unsigned long long)pack4_i8(y[j][1].x * inv, y[j][1].y * inv, y[j][1].z * inv, y[j][1].w * inv) << 32);
    }
    }
#undef PQ_LOAD
}
__device__ __forceinline__ void phase_prepx(const u16* xh, u16* xn, const float* scale, float* ssq0, int gw, int NGW, int lane) {
    for (int m = gw; m < MTOK; m += NGW) {
        const int b = m >> 13;
        const h16x8* xr = (const h16x8*)(xh + (size_t)m * DM) + lane;
        h16x8 v[4];
#pragma unroll
        for (int j = 0; j < 4; ++j) v[j] = xr[64 * j];
        const f32x4* sp = (const f32x4*)(scale + (size_t)b * ADAW) + 2 * lane;
        v4u* o = (v4u*)(xn + (size_t)m * DM) + lane;
        float s = 0.f;
#pragma unroll
        for (int j = 0; j < 4; ++j) {
            const f32x4 a = (f32x4){(float)v[j][0], (float)v[j][1], (float)v[j][2], (float)v[j][3]}, c = (f32x4){(float)v[j][4], (float)v[j][5], (float)v[j][6], (float)v[j][7]};
            s += (a.x * a.x + a.y * a.y) + (a.z * a.z + a.w * a.w) + (c.x * c.x + c.y * c.y) + (c.z * c.z + c.w * c.w);
            const f32x4 ya = a * (sp[128 * j] + 1.0f), yc = c * (sp[128 * j + 1] + 1.0f);
            v4u w; w.x = pkh(ya.x, ya.y); w.y = pkh(ya.z, ya.w); w.z = pkh(yc.x, yc.y); w.w = pkh(yc.z, yc.w);
            o[64 * j] = w;
        }
        s = wave_sum(s);
        if (lane == 0) ssq0[m] = s;
    }
}
__device__ __forceinline__ void quant_row_dff(const u16* src, unsigned char* dst, float* scale, int lane) {
    h16x8 raw[11]; float am = 0.f;
#pragma unroll
    for (int j = 0; j < 11; ++j) raw[j] = *((const h16x8*)src + lane + 64 * j);
#pragma unroll
    for (int j = 0; j < 11; ++j) { float w[8]; unpack8(raw[j], w);
#pragma unroll
        for (int e = 0; e < 8; ++e) am = fmaxf(am, __builtin_fabsf(w[e])); }
    am = wave_max(am); const float inv = am > 0.f ? 127.0f / am : 0.f;
#pragma unroll
    for (int j = 0; j < 11; ++j) { float w[8]; unpack8(raw[j], w);
        *((unsigned long long*)dst + lane + 64 * j) = (unsigned long long)pack4_i8(w[0] * inv, w[1] * inv, w[2] * inv, w[3] * inv) | ((unsigned long long)pack4_i8(w[4] * inv, w[5] * inv, w[6] * inv, w[7] * inv) << 32); }
    if (lane == 0) *scale = am * (1.0f / 127.0f);
}
template <int K, int NC, bool BIAS, bool F8 = false>
__device__ __forceinline__ void p0w_strip(const float* W, int N, int n0, unsigned char* Wq0, float* tq0, const float* shift, float* bias0, int bstride, LAS unsigned char* L, int tid) {
    constexpr int LPR = NC / 4, RPW = 64 / LPR, RB = 8 * RPW * 4, NG = K / RB, TS = K + 16;
    constexpr int OFF_T = BIAS ? 4 * K * 4 : 0, OFF_RA = OFF_T + NC * TS, OFF_RB = OFF_RA + 8 * NC * 4;
    static_assert(K % RB == 0 && OFF_RB + 8 * 4 * NC * 4 <= RING_BYTES_P0W, "p0w_strip LDS map");
    asm volatile("" : "+v"(tid));
    const int w = __builtin_amdgcn_readfirstlane(tid >> 6), lane = tid & 63, c4 = lane % LPR, kr = lane / LPR;
    f32x4 v[NG][4];
    { const float* wp = W + (size_t)(RPW * 4 * w + 4 * kr) * N + n0 + 4 * c4;
#pragma unroll
      for (int g = 0; g < NG; ++g)
#pragma unroll
          for (int j = 0; j < 4; ++j) v[g][j] = *(const f32x4*)(wp + (size_t)(RB * g + j) * N); }
    if constexpr (BIAS) {
#pragma unroll
        for (int r = 0; r < (4 * K / 4) / 512; ++r) { const int idx = tid + 512 * r, b = idx / (K / 4), kk = idx % (K / 4);
            *(LAS f32x4*)(L + (size_t)(b * K + 4 * kk) * 4) = *(const f32x4*)(shift + (size_t)b * ADAW + 4 * kk); }
    }
    f32x4 am = {0.f, 0.f, 0.f, 0.f};
#pragma unroll
    for (int g = 0; g < NG; ++g)
#pragma unroll
        for (int j = 0; j < 4; ++j) am = __builtin_elementwise_max(am, __builtin_elementwise_abs(v[g][j]));
#pragma unroll
    for (int e = 0; e < 4; ++e) { float x = am[e];
        if constexpr (LPR == 4) x = fmaxf(x, swz_xor<4>(x));
        x = fmaxf(x, swz_xor<8>(x)); x = fmaxf(x, swz_xor<16>(x)); x = max_xor32(x); am[e] = x; }
    if (kr == 0) *(LAS f32x4*)(L + OFF_RA + (w * NC + 4 * c4) * 4) = am;
    __syncthreads();
    f32x4 amx = *(const LAS f32x4*)(L + OFF_RA + (4 * c4) * 4);
#pragma unroll
    for (int ww = 1; ww < 8; ++ww) amx = __builtin_elementwise_max(amx, *(const LAS f32x4*)(L + OFF_RA + (ww * NC + 4 * c4) * 4));
    f32x4 inv;
#pragma unroll
    for (int e = 0; e < 4; ++e) inv[e] = amx[e] > 0.f ? (F8 ? pg8::F8_WMAX : 127.0f) / amx[e] : 0.f;
    if (tid < LPR) *(f32x4*)(tq0 + 4 * c4) = amx * (F8 ? 1.0f / (pg8::F8_WMAX * pg8::HID_S) : 1.0f / 127.0f);
    if constexpr (BIAS) {
        f32x4 acc[4];
#pragma unroll
        for (int b = 0; b < 4; ++b) acc[b] = (f32x4){0.f, 0.f, 0.f, 0.f};
#pragma unroll
        for (int g = 0; g < NG; ++g) { const int k0 = RB * g + RPW * 4 * w + 4 * kr;
#pragma unroll
            for (int b = 0; b < 4; ++b) { const f32x4 sh = *(const LAS f32x4*)(L + (size_t)(b * K + k0) * 4);
                acc[b] += v[g][0] * sh[0] + v[g][1] * sh[1] + v[g][2] * sh[2] + v[g][3] * sh[3]; } }
#pragma unroll
        for (int b = 0; b < 4; ++b) {
#pragma unroll
            for (int e = 0; e < 4; ++e) { float x = acc[b][e];
                if constexpr (LPR == 4) x += swz_xor<4>(x);
                x += swz_xor<8>(x); x += swz_xor<16>(x); x = add_xor32(x); acc[b][e] = x; }
            if (kr == 0) *(LAS f32x4*)(L + OFF_RB + ((w * 4 + b) * NC + 4 * c4) * 4) = acc[b]; }
    }
#pragma unroll
    for (int g = 0; g < NG; ++g) { const int k0 = RB * g + RPW * 4 * w + 4 * kr;
#pragma unroll
        for (int e = 0; e < 4; ++e) *(LAS unsigned*)(L + OFF_T + (4 * c4 + e) * TS + k0) = F8 ? pg8::pack4_f8(v[g][0][e] * inv[e], v[g][1][e] * inv[e], v[g][2][e] * inv[e], v[g][3][e] * inv[e])
                                                                                              : pack4_i8(v[g][0][e] * inv[e], v[g][1][e] * inv[e], v[g][2][e] * inv[e], v[g][3][e] * inv[e]); }
    __syncthreads();
    if constexpr (BIAS) {
        if (tid < 4 * NC) { const int b = tid / NC, col = tid % NC; float sum = 0.f;
#pragma unroll
            for (int ww = 0; ww < 8; ++ww) sum += *(const LAS float*)(L + OFF_RB + ((ww * 4 + b) * NC + col) * 4);
            bias0[(size_t)b * bstride + col] = sum; }
    }
    if (tid < K / 16) {
#pragma unroll 4
        for (int col = 0; col < NC; ++col) *(v4u*)(Wq0 + (size_t)col * K + 16 * tid) = *(const LAS v4u*)(L + OFF_T + col * TS + 16 * tid);
    }
    __syncthreads();
}
__device__ __forceinline__ void phase_bias_bin(const float* mod, const u16* WBIN, float* bias, int gw, int NGW, int lane) {
    for (int r = gw; r < 2 * B_INP; r += NGW) {
        const int mj = r / B_INP, n = r % B_INP, li = 2 * mj + 1, q = 3 * li + 1;
        const u16* wrow = WBIN + ((size_t)mj * B_INP + n) * DM + 8 * lane;
        h16x8 raw[4];
#pragma unroll
        for (int j = 0; j < 4; ++j) raw[j] = *(const h16x8*)(wrow + 512 * j);
        float d[4] = {0.f, 0.f, 0.f, 0.f};
#pragma unroll
        for (int bb = 0; bb < 4; ++bb) { const float* sp = mod + ((size_t)li * NB + bb) * ADAW + 3 * DM + 8 * lane;
#pragma unroll
            for (int j = 0; j < 4; ++j) { float w[8]; unpack8(raw[j], w); const f32x4 a0 = *(const f32x4*)(sp + 512 * j), a1 = *(const f32x4*)(sp + 512 * j + 4);
                d[bb] += (w[0] * a0[0] + w[1] * a0[1]) + (w[2] * a0[2] + w[3] * a0[3]) + (w[4] * a1[0] + w[5] * a1[1]) + (w[6] * a1[2] + w[7] * a1[3]); } }
#pragma unroll
        for (int bb = 0; bb < 4; ++bb) d[bb] = wave_sum(d[bb]);
        if (lane == 0) { float* bp = bias + (size_t)(q * 4) * GU_N + n; bp[0] = d[0]; bp[GU_N] = d[1]; bp[2 * GU_N] = d[2]; bp[3 * GU_N] = d[3]; }
    }
}
__device__ __forceinline__ int bias_nq(int q) { const int li = q / 3, s = q - 3 * li; return (s != 1) ? GU_N : ((li & 1) == 0 ? A_IN : B_INP); }
__device__ __forceinline__ void phase_bias(const float* mod, const u16* WGU, const u16* WAIN, const u16* WBIN, float* bias, unsigned char* WQ, float* TQ, unsigned char* WQA, float* TQA, int gw, int NGW, int lane) {
    constexpr int R = 8 * GU_N + 2 * A_IN + 2 * B_INP;
    const int chunk = (R + NGW - 1) / NGW; int r = gw * chunk; const int rend = (r + chunk < R) ? r + chunk : R;
    if (r >= rend) return;
    int q = 0, base = 0;
    while (r >= base + bias_nq(q)) { base += bias_nq(q); ++q; }
    float sh[4][32]; const u16* wt = nullptr; int nq = 0;
    bool fresh = true;
    for (; r < rend; ++r) {
        if (r >= base + nq && !fresh) { base += nq; ++q; fresh = true; }
        if (fresh) { fresh = false; nq = bias_nq(q); const int li = q / 3, s = q - 3 * li;
            wt = (s != 1) ? WGU + (size_t)(li * 2 + (s >> 1)) * GU_N * DM : (((li & 1) == 0) ? WAIN + (size_t)(li >> 1) * A_IN * DM : WBIN + (size_t)(li >> 1) * B_INP * DM);
#pragma unroll
            for (int bb = 0; bb < 4; ++bb) { const float* sp = mod + ((size_t)li * NB + bb) * ADAW + (3 * s) * DM + 8 * lane;
#pragma unroll
                for (int j = 0; j < 4; ++j) { const f32x4 a0 = *(const f32x4*)(sp + 512 * j), a1 = *(const f32x4*)(sp + 512 * j + 4);
#pragma unroll
                    for (int e = 0; e < 4; ++e) { sh[bb][8 * j + e] = a0[e]; sh[bb][8 * j + 4 + e] = a1[e]; } } } }
        const int n = r - base; const u16* wrow = wt + (size_t)n * DM + 8 * lane;
        float d0 = 0.f, d1 = 0.f, d2 = 0.f, d3 = 0.f;
        h16x8 raw[4];
#pragma unroll
        for (int j = 0; j < 4; ++j) raw[j] = *(const h16x8*)(wrow + 512 * j);
        float am = 0.f;
#pragma unroll
        for (int j = 0; j < 4; ++j) { float w[8]; unpack8(raw[j], w);
#pragma unroll
            for (int e = 0; e < 8; ++e) { d0 += w[e] * sh[0][8 * j + e]; d1 += w[e] * sh[1][8 * j + e]; d2 += w[e] * sh[2][8 * j + e]; d3 += w[e] * sh[3][8 * j + e]; am = fmaxf(am, __builtin_fabsf(w[e])); } }
        d0 = wave_sum(d0); d1 = wave_sum(d1); d2 = wave_sum(d2); d3 = wave_sum(d3);
        { const int li = q / 3, s = q - 3 * li;
          if (s != 1 || (li & 1) == 0) {
              am = wave_max(am); const float inv = am > 0.f ? 127.0f / am : 0.f; const int gi = li * 2 + (s >> 1);
              unsigned char* qrow = ((s != 1) ? WQ + ((size_t)gi * GU_N + n) * DM : WQA + ((size_t)(li >> 1) * A_IN + n) * DM) + 8 * lane;
#pragma unroll
              for (int j = 0; j < 4; ++j) { float w[8]; unpack8(raw[j], w);
                  const unsigned lo = pack4_i8(w[0] * inv, w[1] * inv, w[2] * inv, w[3] * inv), hi = pack4_i8(w[4] * inv, w[5] * inv, w[6] * inv, w[7] * inv);
                  *(unsigned long long*)(qrow + 512 * j) = (unsigned long long)lo | ((unsigned long long)hi << 32); }
              if (lane == 0) { if (s != 1) TQ[(size_t)gi * GU_N + n] = am * (1.0f / 127.0f); else TQA[(size_t)(li >> 1) * A_IN + n] = am * (1.0f / 127.0f); }
          } }
        if (lane == 0) { float* bp = bias + (size_t)(q * 4) * GU_N + n; bp[0] = d0; bp[GU_N] = d1; bp[2 * GU_N] = d2; bp[3 * GU_N] = d3; }
    }
}

__device__ __forceinline__ void phase_normropeA(const u16* P, u16* Qh, u16* Kh, u16* Vh, const float* qg, const float* kg, const float* cost, const float* sint, int gw, int NGW, int lane) {
    const int d0 = 8 * (lane & 15), sub = lane >> 4; const bool hiHalf = (lane & 8) != 0;
    float gq[8], gk[8];
#pragma unroll
    for (int e = 0; e < 8; ++e) { gq[e] = qg[d0 + e]; gk[e] = kg[d0 + e]; }
    for (int m = gw; m < MTOK; m += NGW) {
        const int b = m >> 13, t = m & (SEQ - 1);
        const u16* row = P + (size_t)m * A_IN;
        float cs[8], sn[8];
        { const f32x4 c0 = *(const f32x4*)(cost + t * 64 + (d0 & 63)), c1 = *(const f32x4*)(cost + t * 64 + (d0 & 63) + 4);
          const f32x4 s0 = *(const f32x4*)(sint + t * 64 + (d0 & 63)), s1 = *(const f32x4*)(sint + t * 64 + (d0 & 63) + 4);
#pragma unroll
          for (int e = 0; e < 4; ++e) { cs[e] = c0[e]; cs[4 + e] = c1[e]; sn[e] = s0[e]; sn[4 + e] = s1[e]; } }
#pragma unroll
        for (int j = 0; j < 8; ++j) {
            float v[8]; unpack8(*(const h16x8*)(row + 512 * j + 8 * lane), v);
            float ss = 0.f;
#pragma unroll
            for (int e = 0; e < 8; ++e) ss += v[e] * v[e];
            const float rstd = rsqrtf(sum16(ss) * (1.0f / 128.0f) + NORM_EPS);
            float o[8];
#pragma unroll
            for (int e = 0; e < 8; ++e) { const float y = v[e] * rstd * (j < 4 ? gq[e] : gk[e]); const float p = swz_xor<8>(y);
                o[e] = hiHalf ? (y * cs[e] + p * sn[e]) : (y * cs[e] - p * sn[e]); }
            const int ch = (4 * j + sub) & 15;
            u16* dst = (j < 4 ? Qh : Kh) + (((size_t)(b * 16 + ch) * SEQ + t) * 128 + d0);
            *(v4u*)dst = pack8h(o);
        }
#pragma unroll
        for (int j = 0; j < 4; ++j) {
            const v4u raw = *(const v4u*)(row + 4096 + 512 * j + 8 * lane);
            *(v4u*)(Vh + (((size_t)(b * 16 + 4 * j + sub) * SEQ + t) * 128 + d0)) = raw;
        }
    }
}
__device__ __forceinline__ void phase_combineA(const u16* O, unsigned char* AOQ, float* RFO, const float* lq1, const float* lk1, const float* lq2, const float* lk2, const float* subln, float lam_init, int gw, int NGW, int lane) {
    const float s1 = wave_sum(lq1[lane] * lk1[lane] + lq1[lane + 64] * lk1[lane + 64]);
    const float s2 = wave_sum(lq2[lane] * lk2[lane] + lq2[lane + 64] * lk2[lane + 64]);
    const float lam = __expf(s1) - __expf(s2) + lam_init;
    const int half = lane >> 5, e0 = 8 * (lane & 31), vh = e0 >> 7, d = e0 & 127;
    float sg[8];
#pragma unroll
    for (int e = 0; e < 8; ++e) sg[e] = subln[e0 + e] * (1.0f - lam_init);
    for (int m = gw; m < MTOK; m += NGW) {
        const int b = m >> 13, t = m & (SEQ - 1);
        float av[4][8]; float am = 0.f;
#pragma unroll
        for (int hp = 0; hp < 4; ++hp) {
            const int h = 2 * hp + half;
            const size_t s0i = ((size_t)((b * 8 + h) * 2 + 0) * SEQ + t) * 256 + e0, s1i = ((size_t)((b * 8 + h) * 2 + 1) * SEQ + t) * 256 + e0;
            float a[8], c[8]; unpack8(*(const h16x8*)(O + s0i), a); unpack8(*(const h16x8*)(O + s1i), c);
            float ss = 0.f;
#pragma unroll
            for (int e = 0; e < 8; ++e) { a[e] = a[e] - lam * c[e]; ss += a[e] * a[e]; }
            ss = sum16(ss); ss = add_xor16(ss);
            const float rstd = rsqrtf(ss * (1.0f / 256.0f) + NORM_EPS);
#pragma unroll
            for (int e = 0; e < 8; ++e) { av[hp][e] = a[e] * rstd * sg[e]; am = fmaxf(am, __builtin_fabsf(av[hp][e])); }
        }
        am = wave_max(am); const float inv = am > 0.f ? 127.0f / am : 0.f;
        if (lane == 0) RFO[m] = am * (1.0f / 127.0f);
#pragma unroll
        for (int hp = 0; hp < 4; ++hp) {
            const int h = 2 * hp + half;
            *(unsigned long long*)(AOQ + (size_t)m * DM + h * 256 + e0) = (unsigned long long)pack4_i8(av[hp][0] * inv, av[hp][1] * inv, av[hp][2] * inv, av[hp][3] * inv)
                                                                        | ((unsigned long long)pack4_i8(av[hp][4] * inv, av[hp][5] * inv, av[hp][6] * inv, av[hp][7] * inv) << 32);
        }
    }
}
__device__ __forceinline__ void phase_normropeB(const u16* P, u16* QB, u16* KB, u16* VB, u16* QI, u16* KI, float* WI, const float* qg, const float* kg, const float* kig, const float* kib,
                                                const float* cost, const float* sint, const float* costi, const float* sinti, int gw, int NGW, int lane) {
    const int ll = lane & 15, d0 = 8 * ll, sub = lane >> 4; const bool hiHalf = (lane & 8) != 0;
    float gq[8], g2[8], b2[8];
#pragma unroll
    for (int e = 0; e < 8; ++e) { gq[e] = qg[d0 + e]; g2[e] = (sub == 0) ? kg[d0 + e] : (sub == 2) ? kig[d0 + e] : 1.0f; b2[e] = (sub == 2) ? kib[d0 + e] : 0.0f; }
    for (int m = gw; m < MTOK; m += NGW) {
        const int t = m & (SEQ - 1);
        const u16* row = P + (size_t)m * B_INP;
        float cs[8], sn[8], ci[8], si[8];
        { const f32x4 c0 = *(const f32x4*)(cost + t * 64 + (d0 & 63)), c1 = *(const f32x4*)(cost + t * 64 + (d0 & 63) + 4);
          const f32x4 s0 = *(const f32x4*)(sint + t * 64 + (d0 & 63)), s1 = *(const f32x4*)(sint + t * 64 + (d0 & 63) + 4);
          const f32x4 e0 = *(const f32x4*)(costi + t * 32 + (d0 & 31)), e1 = *(const f32x4*)(costi + t * 32 + (d0 & 31) + 4);
          const f32x4 f0 = *(const f32x4*)(sinti + t * 32 + (d0 & 31)), f1 = *(const f32x4*)(sinti + t * 32 + (d0 & 31) + 4);
#pragma unroll
          for (int e = 0; e < 4; ++e) { cs[e] = c0[e]; cs[4 + e] = c1[e]; sn[e] = s0[e]; sn[4 + e] = s1[e]; ci[e] = e0[e]; ci[4 + e] = e1[e]; si[e] = f0[e]; si[4 + e] = f1[e]; } }
#pragma unroll
        for (int j = 0; j < 4; ++j) {
            float v[8]; unpack8(*(const h16x8*)(row + 512 * j + 8 * lane), v);
            float ss = 0.f;
#pragma unroll
            for (int e = 0; e < 8; ++e) ss += v[e] * v[e];
            const float rstd = rsqrtf(sum16(ss) * (1.0f / 128.0f) + NORM_EPS);
            float o[8];
#pragma unroll
            for (int e = 0; e < 8; ++e) { const float y = v[e] * rstd * gq[e]; const float p = swz_xor<8>(y);
                o[e] = hiHalf ? (y * cs[e] + p * sn[e]) : (y * cs[e] - p * sn[e]); }
            *(v4u*)(QB + (size_t)m * DM + (4 * j + sub) * 128 + d0) = pack8h(o);
        }
#pragma unroll
        for (int j = 0; j < 4; ++j) {
            float v[8]; unpack8(*(const h16x8*)(row + 2304 + 512 * j + 8 * lane), v);
            float o[8];
#pragma unroll
            for (int e = 0; e < 8; ++e) { const float y = v[e]; const float p = swz_xor<4>(y);
                o[e] = (ll < 4) ? (y * ci[e] - p * si[e]) : (ll < 8) ? (y * ci[e] + p * si[e]) : y; }
            *(v4u*)(QI + (size_t)m * DM + (4 * j + sub) * 128 + d0) = pack8h(o);
        }
        {
            const int col = (sub < 2) ? (2048 + 8 * lane) : (4352 + d0);
            float v[8]; unpack8(*(const h16x8*)(row + col), v);
            float s = 0.f;
#pragma unroll
            for (int e = 0; e < 8; ++e) s += v[e];
            const float mean = (sub >= 2) ? sum16(s) * (1.0f / 128.0f) : (sum16(s) * 0.0f);
            float ss = 0.f;
#pragma unroll
            for (int e = 0; e < 8; ++e) { v[e] -= mean; ss += v[e] * v[e]; }
            const float rstd = rsqrtf(sum16(ss) * (1.0f / 128.0f) + NORM_EPS);
            float o[8];
#pragma unroll
            for (int e = 0; e < 8; ++e) { const float y = v[e] * rstd * g2[e] + b2[e]; const float p8 = swz_xor<8>(y), p4 = swz_xor<4>(y);
                const float rk = hiHalf ? (y * cs[e] + p8 * sn[e]) : (y * cs[e] - p8 * sn[e]);
                const float ri = (ll < 4) ? (y * ci[e] - p4 * si[e]) : (ll < 8) ? (y * ci[e] + p4 * si[e]) : y;
                o[e] = (sub == 0) ? rk : (sub == 1) ? v[e] : ri; }
            u16* dst = (sub == 0) ? KB : (sub == 1) ? VB : KI;
            if (sub < 3) *(v4u*)(dst + (size_t)m * 128 + d0) = pack8h(o);
        }
        if (lane < 16) { const _Float16 w = __builtin_bit_cast(_Float16, row[4480 + lane]); WI[(size_t)m * 16 + lane] = (float)w * (0.25f * 0.08838834764831845f); }
    }
}

#ifndef B3_REP_SC
#define B3_REP_SC 1
#define B3_REP_TK 1
#define B3_REP_SP 1
#endif
typedef short s16x8 __attribute__((ext_vector_type(8)));
typedef float f32x16v __attribute__((ext_vector_type(16)));
constexpr int B3_V_OFF = 65536, B3_IDX_OFF = 133120;
typedef short s16x4v __attribute__((ext_vector_type(4)));
__device__ __forceinline__ int kswz(int row, int colB) { return row * 256 + (colB ^ ((row & 7) << 4)); }
__device__ __forceinline__ unsigned f2key(float f) { const unsigned u = __float_as_uint(f); return u ^ ((unsigned)((int)u >> 31) | 0x80000000u); }

__device__ __forceinline__ int count_ge16(int cnt, unsigned c, unsigned k0, unsigned k1, unsigned k2, unsigned k3, unsigned k4, unsigned k5, unsigned k6, unsigned k7, unsigned k8, unsigned k9, unsigned k10, unsigned k11, unsigned k12, unsigned k13, unsigned k14, unsigned k15) {
    unsigned long long m0, m1, m2, m3; int t0, t1;
    asm volatile("v_cmp_ge_u32_e64 %[m0], %[k0], %[c]\n\tv_cmp_ge_u32_e64 %[m1], %[k1], %[c]\n\tv_cmp_ge_u32_e64 %[m2], %[k2], %[c]\n\tv_cmp_ge_u32_e64 %[m3], %[k3], %[c]\n\ts_bcnt1_i32_b64 %[t0], %[m0]\n\tv_cmp_ge_u32_e64 %[m0], %[k4], %[c]\n\ts_add_i32 %[cnt], %[cnt], %[t0]\n\ts_bcnt1_i32_b64 %[t1], %[m1]\n\tv_cmp_ge_u32_e64 %[m1], %[k5], %[c]\n\ts_add_i32 %[cnt], %[cnt], %[t1]\n\ts_bcnt1_i32_b64 %[t0], %[m2]\n\tv_cmp_ge_u32_e64 %[m2], %[k6], %[c]\n\ts_add_i32 %[cnt], %[cnt], %[t0]\n\ts_bcnt1_i32_b64 %[t1], %[m3]\n\tv_cmp_ge_u32_e64 %[m3], %[k7], %[c]\n\ts_add_i32 %[cnt], %[cnt], %[t1]\n\ts_bcnt1_i32_b64 %[t0], %[m0]\n\tv_cmp_ge_u32_e64 %[m0], %[k8], %[c]\n\ts_add_i32 %[cnt], %[cnt], %[t0]\n\ts_bcnt1_i32_b64 %[t1], %[m1]\n\tv_cmp_ge_u32_e64 %[m1], %[k9], %[c]\n\ts_add_i32 %[cnt], %[cnt], %[t1]\n\ts_bcnt1_i32_b64 %[t0], %[m2]\n\tv_cmp_ge_u32_e64 %[m2], %[k10], %[c]\n\ts_add_i32 %[cnt], %[cnt], %[t0]\n\ts_bcnt1_i32_b64 %[t1], %[m3]\n\tv_cmp_ge_u32_e64 %[m3], %[k11], %[c]\n\ts_add_i32 %[cnt], %[cnt], %[t1]\n\ts_bcnt1_i32_b64 %[t0], %[m0]\n\tv_cmp_ge_u32_e64 %[m0], %[k12], %[c]\n\ts_add_i32 %[cnt], %[cnt], %[t0]\n\ts_bcnt1_i32_b64 %[t1], %[m1]\n\tv_cmp_ge_u32_e64 %[m1], %[k13], %[c]\n\ts_add_i32 %[cnt], %[cnt], %[t1]\n\ts_bcnt1_i32_b64 %[t0], %[m2]\n\tv_cmp_ge_u32_e64 %[m2], %[k14], %[c]\n\ts_add_i32 %[cnt], %[cnt], %[t0]\n\ts_bcnt1_i32_b64 %[t1], %[m3]\n\tv_cmp_ge_u32_e64 %[m3], %[k15], %[c]\n\ts_add_i32 %[cnt], %[cnt], %[t1]\n\ts_bcnt1_i32_b64 %[t0], %[m0]\n\ts_add_i32 %[cnt], %[cnt], %[t0]\n\ts_bcnt1_i32_b64 %[t1], %[m1]\n\ts_add_i32 %[cnt], %[cnt], %[t1]\n\ts_bcnt1_i32_b64 %[t0], %[m2]\n\ts_add_i32 %[cnt], %[cnt], %[t0]\n\ts_bcnt1_i32_b64 %[t1], %[m3]\n\ts_add_i32 %[cnt], %[cnt], %[t1]"
        : [cnt] "+s"(cnt), [m0] "=&s"(m0), [m1] "=&s"(m1), [m2] "=&s"(m2), [m3] "=&s"(m3), [t0] "=&s"(t0), [t1] "=&s"(t1)
        : [c] "s"(c), [k0] "v"(k0), [k1] "v"(k1), [k2] "v"(k2), [k3] "v"(k3), [k4] "v"(k4), [k5] "v"(k5), [k6] "v"(k6), [k7] "v"(k7), [k8] "v"(k8), [k9] "v"(k9), [k10] "v"(k10), [k11] "v"(k11), [k12] "v"(k12), [k13] "v"(k13), [k14] "v"(k14), [k15] "v"(k15)
        : "scc");
    return cnt;
}
__device__ __forceinline__ int count_gef16(int cnt, unsigned c, float k0, float k1, float k2, float k3, float k4, float k5, float k6, float k7, float k8, float k9, float k10, float k11, float k12, float k13, float k14, float k15) {
    unsigned long long m0, m1, m2, m3; int t0, t1;
    asm volatile("v_cmp_ge_f32_e64 %[m0], %[k0], %[c]\n\tv_cmp_ge_f32_e64 %[m1], %[k1], %[c]\n\tv_cmp_ge_f32_e64 %[m2], %[k2], %[c]\n\tv_cmp_ge_f32_e64 %[m3], %[k3], %[c]\n\ts_bcnt1_i32_b64 %[t0], %[m0]\n\tv_cmp_ge_f32_e64 %[m0], %[k4], %[c]\n\ts_add_i32 %[cnt], %[cnt], %[t0]\n\ts_bcnt1_i32_b64 %[t1], %[m1]\n\tv_cmp_ge_f32_e64 %[m1], %[k5], %[c]\n\ts_add_i32 %[cnt], %[cnt], %[t1]\n\ts_bcnt1_i32_b64 %[t0], %[m2]\n\tv_cmp_ge_f32_e64 %[m2], %[k6], %[c]\n\ts_add_i32 %[cnt], %[cnt], %[t0]\n\ts_bcnt1_i32_b64 %[t1], %[m3]\n\tv_cmp_ge_f32_e64 %[m3], %[k7], %[c]\n\ts_add_i32 %[cnt], %[cnt], %[t1]\n\ts_bcnt1_i32_b64 %[t0], %[m0]\n\tv_cmp_ge_f32_e64 %[m0], %[k8], %[c]\n\ts_add_i32 %[cnt], %[cnt], %[t0]\n\ts_bcnt1_i32_b64 %[t1], %[m1]\n\tv_cmp_ge_f32_e64 %[m1], %[k9], %[c]\n\ts_add_i32 %[cnt], %[cnt], %[t1]\n\ts_bcnt1_i32_b64 %[t0], %[m2]\n\tv_cmp_ge_f32_e64 %[m2], %[k10], %[c]\n\ts_add_i32 %[cnt], %[cnt], %[t0]\n\ts_bcnt1_i32_b64 %[t1], %[m3]\n\tv_cmp_ge_f32_e64 %[m3], %[k11], %[c]\n\ts_add_i32 %[cnt], %[cnt], %[t1]\n\ts_bcnt1_i32_b64 %[t0], %[m0]\n\tv_cmp_ge_f32_e64 %[m0], %[k12], %[c]\n\ts_add_i32 %[cnt], %[cnt], %[t0]\n\ts_bcnt1_i32_b64 %[t1], %[m1]\n\tv_cmp_ge_f32_e64 %[m1], %[k13], %[c]\n\ts_add_i32 %[cnt], %[cnt], %[t1]\n\ts_bcnt1_i32_b64 %[t0], %[m2]\n\tv_cmp_ge_f32_e64 %[m2], %[k14], %[c]\n\ts_add_i32 %[cnt], %[cnt], %[t0]\n\ts_bcnt1_i32_b64 %[t1], %[m3]\n\tv_cmp_ge_f32_e64 %[m3], %[k15], %[c]\n\ts_add_i32 %[cnt], %[cnt], %[t1]\n\ts_bcnt1_i32_b64 %[t0], %[m0]\n\ts_add_i32 %[cnt], %[cnt], %[t0]\n\ts_bcnt1_i32_b64 %[t1], %[m1]\n\ts_add_i32 %[cnt], %[cnt], %[t1]\n\ts_bcnt1_i32_b64 %[t0], %[m2]\n\ts_add_i32 %[cnt], %[cnt], %[t0]\n\ts_bcnt1_i32_b64 %[t1], %[m3]\n\ts_add_i32 %[cnt], %[cnt], %[t1]"
        : [cnt] "+s"(cnt), [m0] "=&s"(m0), [m1] "=&s"(m1), [m2] "=&s"(m2), [m3] "=&s"(m3), [t0] "=&s"(t0), [t1] "=&s"(t1)
        : [c] "s"(c), [k0] "v"(k0), [k1] "v"(k1), [k2] "v"(k2), [k3] "v"(k3), [k4] "v"(k4), [k5] "v"(k5), [k6] "v"(k6), [k7] "v"(k7), [k8] "v"(k8), [k9] "v"(k9), [k10] "v"(k10), [k11] "v"(k11), [k12] "v"(k12), [k13] "v"(k13), [k14] "v"(k14), [k15] "v"(k15)
        : "scc");
    return cnt;
}
__device__ __forceinline__ unsigned key2f(unsigned k) { return (k & 0x80000000u) ? (k ^ 0x80000000u) : ~k; }
constexpr unsigned B3_KLO = 0x00800000u, B3_KHI = 0xFF800000u;
template <int NBITS> __device__ __forceinline__ int wave_total_u8(unsigned v) {
    int t = 0;
#pragma unroll
    for (int b = 0; b < NBITS; ++b) t += __popcll(__ballot(((v >> b) & 1u) != 0u)) << b;
    return t;
}
template <int NBITS> __device__ __forceinline__ unsigned wave_excl_prefix(unsigned v, int) {
    unsigned s = 0u;
#pragma unroll
    for (int b = 0; b < NBITS; ++b) { const unsigned long long m = __ballot(((v >> b) & 1u) != 0u);
        s += __builtin_amdgcn_mbcnt_hi((unsigned)(m >> 32), __builtin_amdgcn_mbcnt_lo((unsigned)m, 0u)) << b; }
    return s;
}

__device__ __forceinline__ void phase_B3(char* lds, const u16* QB, const u16* KB, const u16* VB, const u16* QI, const u16* KI, const float* WI, float* SCR, unsigned char* AOQ, float* RFO, int vcu, int G) {
    constexpr int r_sc = B3_REP_SC, r_tk = B3_REP_TK, r_sp = B3_REP_SP;
    const int wid = __builtin_amdgcn_readfirstlane(opaque_tid() >> 6);
    float* myscr = SCR + (size_t)((vcu * NWAVES + wid) * 4) * SEQ;
    for (int U = vcu; U < NB * 256; U += G) {
        const int b = U >> 8, tt = U & 255, t = (b & 1) ? 255 - tt : tt, q0 = 32 * t;
        const size_t brow = (size_t)b * SEQ;
        const size_t mrow0 = brow + q0 + 4 * wid;
#pragma unroll 1
        for (int rsc_ = 0; rsc_ < r_sc; ++rsc_) {
            const int tid = opaque_tid(), lane = tid & 63, r32 = lane & 31, hi = lane >> 5;
            const int sr = tid >> 4, sc = (tid & 15) * 8, kws = kswz(sr, sc * 2);
            s16x8 af[2][8]; float wr[2][16];
#pragma unroll
            for (int rb = 0; rb < 2; ++rb) {
#pragma unroll
                for (int ks = 0; ks < 8; ++ks) af[rb][ks] = *(const s16x8*)(QI + (mrow0 + 2 * rb + (r32 >> 4)) * DM + (r32 & 15) * 128 + 16 * ks + 8 * hi);
#pragma unroll
                for (int i = 0; i < 16; ++i) wr[rb][i] = WI[(mrow0 + 2 * rb + (i >> 3)) * 16 + (i & 3) + 8 * ((i >> 2) & 1) + 4 * hi];
            }
            const int nkt = (q0 + 32 + 127) >> 7;
            const u16* kip = KI + (brow + sr) * 128 + sc;
            s16x8 st0 = *(const s16x8*)kip, st1 = *(const s16x8*)(kip + 32 * 128), st2 = *(const s16x8*)(kip + 64 * 128), st3 = *(const s16x8*)(kip + 96 * 128);
            *(s16x8*)(lds + kws) = st0; *(s16x8*)(lds + kws + 32 * 256) = st1; *(s16x8*)(lds + kws + 64 * 256) = st2; *(s16x8*)(lds + kws + 96 * 256) = st3;
            __syncthreads();
            for (int kt = 0; kt < nkt; ++kt) {
                const char* buf = lds + (kt & 1) * 32768;
                if (kt + 1 < nkt) { const u16* kn = kip + (size_t)(kt + 1) * 128 * 128;
                    st0 = *(const s16x8*)kn; st1 = *(const s16x8*)(kn + 32 * 128); st2 = *(const s16x8*)(kn + 64 * 128); st3 = *(const s16x8*)(kn + 96 * 128); }
                s16x8 bf[8];
#pragma unroll
                for (int ks = 0; ks < 8; ++ks) bf[ks] = *(const s16x8*)(buf + kswz(r32, (16 * ks + 8 * hi) * 2));
                f32x16v aA0, aA1, aB0, aB1; float s00 = 0.f, s01 = 0.f, s10 = 0.f, s11 = 0.f;
#define B3_MM(a0_, a1_, ks_) do { a0_ = __builtin_amdgcn_mfma_f32_32x32x16_f16(__builtin_bit_cast(h16x8, af[0][ks_]), __builtin_bit_cast(h16x8, bf[ks_]), a0_, 0, 0, 0); \
                                   a1_ = __builtin_amdgcn_mfma_f32_32x32x16_f16(__builtin_bit_cast(h16x8, af[1][ks_]), __builtin_bit_cast(h16x8, bf[ks_]), a1_, 0, 0, 0); } while (0)
#define B3_RELU(x_) __builtin_amdgcn_fmed3f((x_), 0.f, __builtin_inff())
#define B3_SLICE(a0_, a1_, ks_, kbn_, REFILL, e0_, e1_, DOEPI) do { B3_MM(a0_, a1_, ks_); \
                    if (REFILL) bf[ks_] = *(const s16x8*)(buf + kswz(32 * (kbn_) + r32, (16 * (ks_) + 8 * hi) * 2)); \
                    if (DOEPI) { s00 += wr[0][ks_] * B3_RELU(e0_[ks_]); s01 += wr[0][8 + (ks_)] * B3_RELU(e0_[8 + (ks_)]); s10 += wr[1][ks_] * B3_RELU(e1_[ks_]); s11 += wr[1][8 + (ks_)] * B3_RELU(e1_[8 + (ks_)]); } \
                    __builtin_amdgcn_sched_barrier(0); } while (0)
#define B3_FIN(kb2_) do { const auto x0 = __builtin_amdgcn_permlane32_swap(__float_as_uint(s00), __float_as_uint(s01), false, false); \
                    const auto x1 = __builtin_amdgcn_permlane32_swap(__float_as_uint(s10), __float_as_uint(s11), false, false); \
                    const int kcol = kt * 128 + (kb2_) * 32 + r32; \
                    myscr[(size_t)(0 + hi) * SEQ + kcol] = __uint_as_float(x0[0]) + __uint_as_float(x0[1]);     \
                    myscr[(size_t)(2 + hi) * SEQ + kcol] = __uint_as_float(x1[0]) + __uint_as_float(x1[1]); s00 = 0.f; s01 = 0.f; s10 = 0.f; s11 = 0.f; } while (0)
#define B3_BLOCK(a0_, a1_, kb_, REFILL, e0_, e1_, DOEPI) do { a0_ = (f32x16v){}; a1_ = (f32x16v){}; \
                    B3_SLICE(a0_, a1_, 0, (kb_) + 1, REFILL, e0_, e1_, DOEPI); B3_SLICE(a0_, a1_, 1, (kb_) + 1, REFILL, e0_, e1_, DOEPI); B3_SLICE(a0_, a1_, 2, (kb_) + 1, REFILL, e0_, e1_, DOEPI); B3_SLICE(a0_, a1_, 3, (kb_) + 1, REFILL, e0_, e1_, DOEPI); \
                    B3_SLICE(a0_, a1_, 4, (kb_) + 1, REFILL, e0_, e1_, DOEPI); B3_SLICE(a0_, a1_, 5, (kb_) + 1, REFILL, e0_, e1_, DOEPI); B3_SLICE(a0_, a1_, 6, (kb_) + 1, REFILL, e0_, e1_, DOEPI); B3_SLICE(a0_, a1_, 7, (kb_) + 1, REFILL, e0_, e1_, DOEPI); \
                    if (DOEPI) { B3_FIN((kb_) - 1); __builtin_amdgcn_sched_barrier(0); } } while (0)
                __builtin_amdgcn_sched_barrier(0);
                B3_BLOCK(aA0, aA1, 0, true, aA0, aA1, false);
                B3_BLOCK(aB0, aB1, 1, true, aA0, aA1, true);
                B3_BLOCK(aA0, aA1, 2, true, aB0, aB1, true);
                B3_BLOCK(aB0, aB1, 3, false, aA0, aA1, true);
#pragma unroll
                for (int i = 0; i < 8; ++i) { s00 += wr[0][i] * B3_RELU(aB0[i]); s01 += wr[0][8 + i] * B3_RELU(aB0[8 + i]); s10 += wr[1][i] * B3_RELU(aB1[i]); s11 += wr[1][8 + i] * B3_RELU(aB1[8 + i]); }
                B3_FIN(3);
#undef B3_SLICE
#undef B3_FIN
#undef B3_RELU
#undef B3_MM
#undef B3_EPI
#undef B3_BLOCK
                if (kt + 1 < nkt) { char* nb = lds + ((kt + 1) & 1) * 32768; *(s16x8*)(nb + kws) = st0; *(s16x8*)(nb + kws + 32 * 256) = st1; *(s16x8*)(nb + kws + 64 * 256) = st2; *(s16x8*)(nb + kws + 96 * 256) = st3; }
                __syncthreads();
            }
        }
        VM_WAIT();
        unsigned fprev = 0xBF800000u;
        unsigned tprev = 0xBF800000u;
#pragma unroll 1
        for (int qq = 0; qq < 4; ++qq) {
            const int lane = opaque_tid() & 63, l15 = lane & 15, kq = lane >> 4;
            unsigned* idxl = (unsigned*)(lds + B3_IDX_OFF + wid * 2048);
#pragma unroll
            for (int j = 0; j < 4; ++j) idxl[lane + 64 * j] = 0u;
            asm volatile("" ::: "memory");
            const int qpos = q0 + 4 * wid + qq, n = qpos + 1;
            const size_t token = brow + qpos;
            const float* srow = myscr + (size_t)qq * SEQ;
            h16x8 qb[4];
#define B3_QLOAD() do { int qp_ = qpos; asm volatile("" : "+s"(qp_)); const int ln_ = opaque_lane(); const u16* qa_ = QB + (brow + (size_t)qp_) * DM + (ln_ & 15) * 128 + 8 * (ln_ >> 4);     \
        _Pragma("unroll") for (int ks_ = 0; ks_ < 4; ++ks_) qb[ks_] = *(const h16x8*)(qa_ + 32 * ks_); } while (0)
            int count = 0;
#pragma unroll 1
            for (int rtk_ = 0; rtk_ < r_tk; ++rtk_) {
            if (n <= 256) {
                { const int ln_ = opaque_lane();
#pragma unroll
                for (int j = 0; j < 4; ++j) idxl[ln_ + 64 * j] = (ln_ + 64 * j < n) ? (unsigned)(ln_ + 64 * j) : 0u; }
                count = n; B3_QLOAD();
            } else {
                unsigned lo = 0u, hi = 0u; bool have_lo = false, have_hi = false;
                bool done = false; int C = 0;
                float* ks = (float*)(lds + B3_V_OFF + wid * 8192); unsigned* ps = (unsigned*)(lds + B3_V_OFF + wid * 8192 + 4096);
                if (n > 1024) {
                    float kf[128];
#pragma unroll
                    for (int g = 0; g < 8; ++g) {
                        if (1024 * g < n) {
#pragma unroll
                            for (int i4 = 4 * g; i4 < 4 * g + 4; ++i4) { const f32x4 t = *(const f32x4*)(srow + 256 * i4 + 4 * lane); kf[4 * i4] = t.x; kf[4 * i4 + 1] = t.y; kf[4 * i4 + 2] = t.z; kf[4 * i4 + 3] = t.w; }
                        } else {
#pragma unroll
                            for (int i = 16 * g; i < 16 * g + 16; ++i) kf[i] = -__builtin_inff();
                        }
                    }
                    __builtin_amdgcn_sched_barrier(0);
#pragma unroll
                    for (int g = 0; g < 8; ++g) {
                        if (1024 * g < n && n < 1024 * (g + 1)) {
#pragma unroll
                            for (int i = 16 * g; i < 16 * g + 16; ++i) kf[i] = (256 * (i >> 2) + (i & 3) + 4 * lane < n) ? kf[i] : -__builtin_inff();
                        }
                    }
                    unsigned F = 0u, probe = fprev, step = 1u << 17;
#pragma unroll 1
                    for (;;) {
                        const unsigned cand = __builtin_amdgcn_readfirstlane(probe), cf = key2f(cand); int c = 0;
#pragma unroll
                        for (int g = 0; g < 8; ++g) {
                            if (1024 * g < n) c = count_gef16(c, cf, kf[16 * g + 0], kf[16 * g + 1], kf[16 * g + 2], kf[16 * g + 3], kf[16 * g + 4], kf[16 * g + 5], kf[16 * g + 6], kf[16 * g + 7], kf[16 * g + 8], kf[16 * g + 9], kf[16 * g + 10], kf[16 * g + 11], kf[16 * g + 12], kf[16 * g + 13], kf[16 * g + 14], kf[16 * g + 15]);
                        }
                        if (c >= 256 && c <= 960) { F = cand; C = c; break; }
                        if (c > 960) { lo = cand; have_lo = true; } else { hi = cand; have_hi = true; }
                        if (!have_hi) { if (lo >= B3_KHI - step) { hi = B3_KHI; have_hi = true; } else { probe = lo + step; step = (step < (1u << 29)) ? step << 2 : step; continue; } }
                        if (!have_lo) { if (hi <= B3_KLO + step) { lo = B3_KLO; have_lo = true; } else { probe = hi - step; step = (step < (1u << 29)) ? step << 2 : step; continue; } }
                        if (hi - lo <= 1u) break;
                        probe = lo + ((hi - lo) >> 1);
                    }
                    if (C > 0) {
                        unsigned base = 0u; const float Ff = __uint_as_float(key2f(F));
                        unsigned Fs = __builtin_amdgcn_readfirstlane(__float_as_uint(Ff));
#pragma unroll
                        for (int g = 0; g < 8; ++g) {
                            if (1024 * g < n) {
#pragma unroll
                                for (int i = 16 * g; i < 16 * g + 16; ++i) {
                                    asm volatile("" : "+s"(Fs), "+s"(base));
                                    const bool take = kf[i] >= __uint_as_float(Fs);
                                    const unsigned long long m = __ballot(take);
                                    const unsigned slot = base + __builtin_amdgcn_mbcnt_hi((unsigned)(m >> 32), __builtin_amdgcn_mbcnt_lo((unsigned)m, 0u));
                                    const unsigned a = take ? slot : (960u + (unsigned)lane);
                                    ks[a] = kf[i]; ps[a] = (unsigned)(256 * (i >> 2) + (i & 3) + 4 * lane);
                                    base += (unsigned)__popcll(m);
                                }
                            }
                        }
                        if (C == 256) { have_lo = false; have_hi = false; lo = F; }
                        else { lo = F; have_lo = true; }
                        tprev = F; fprev = F;
                    } else {
                        unsigned base = 0u;
#pragma unroll 1
                        for (int pass = 0; pass < 2; ++pass) {
                            unsigned As = __builtin_amdgcn_readfirstlane(key2f(pass == 0 ? hi : lo)), Bs = __builtin_amdgcn_readfirstlane(pass == 0 ? 0x7F800000u : key2f(lo));
#pragma unroll
                            for (int g = 0; g < 8; ++g) {
                                if (1024 * g < n) {
#pragma unroll
                                    for (int i = 16 * g; i < 16 * g + 16; ++i) {
                                        asm volatile("" : "+s"(As), "+s"(Bs), "+s"(base));
                                        const bool in = kf[i] >= __uint_as_float(As) && kf[i] <= __uint_as_float(Bs);
                                        const unsigned long long m = __ballot(in);
                                        const unsigned slot = base + __builtin_amdgcn_mbcnt_hi((unsigned)(m >> 32), __builtin_amdgcn_mbcnt_lo((unsigned)m, 0u));
                                        idxl[(in && slot < 256u) ? slot : (256u + (unsigned)lane)] = (unsigned)(256 * (i >> 2) + (i & 3) + 4 * lane);
                                        base += (unsigned)__popcll(m);
                                    }
                                }
                            }
                        }
                        tprev = lo; done = true;
                    }
                } else {
#pragma unroll
                    for (int i4 = 0; i4 < 4; ++i4) { const f32x4 t = *(const f32x4*)(srow + 256 * i4 + 4 * lane); const unsigned pos = (unsigned)(256 * i4 + 4 * lane);
                        *(f32x4*)(ks + pos) = t; *(v4u*)(ps + pos) = (v4u){pos, pos + 1u, pos + 2u, pos + 3u}; }
                    C = n;
                }
                B3_QLOAD();
                if (!done) {
                    LDS_WAIT(); asm volatile("" ::: "memory");
                    float ck[16]; unsigned cp[16];
#pragma unroll
                    for (int j = 0; j < 16; ++j) { const bool v = 64 * j + lane < C; ck[j] = v ? ks[64 * j + lane] : -__builtin_inff(); cp[j] = ps[64 * j + lane]; }
                    unsigned T = 0u, probe = tprev, step = 1u << 14;
                    if (have_lo) { if (have_hi) probe = lo + ((hi - lo) >> 1); else probe = lo + step; }
#pragma unroll 1
                    for (;;) {
                        if (have_lo && have_hi && hi - lo <= 1u) { T = lo; break; }
                        const unsigned cand = __builtin_amdgcn_readfirstlane(probe), cf = key2f(cand);
                        const int c = count_gef16(0, cf, ck[0], ck[1], ck[2], ck[3], ck[4], ck[5], ck[6], ck[7], ck[8], ck[9], ck[10], ck[11], ck[12], ck[13], ck[14], ck[15]);
                        if (c == 256) { T = cand; break; }
                        if (c > 256) { lo = cand; have_lo = true; } else { hi = cand; have_hi = true; }
                        if (!have_hi) { if (lo >= B3_KHI - step) { hi = B3_KHI; have_hi = true; } else { probe = lo + step; step = (step < (1u << 29)) ? step << 2 : step; continue; } }
                        if (!have_lo) { if (hi <= B3_KLO + step) { lo = B3_KLO; have_lo = true; } else { probe = hi - step; step = (step < (1u << 29)) ? step << 2 : step; continue; } }
                        probe = lo + ((hi - lo) >> 1);
                    }
                    tprev = T;
                    const float Tf = __uint_as_float(key2f(T));
                    unsigned cg = 0u, ce = 0u;
#pragma unroll
                    for (int j = 0; j < 16; ++j) { cg += (ck[j] > Tf) ? 1u : 0u; ce += (ck[j] == Tf) ? 1u : 0u; }
                    const int need_eq = 256 - wave_total_u8<5>(cg);
                    const int eq_room = need_eq - (int)wave_excl_prefix<5>(ce, lane);
                    unsigned erem = (eq_room <= 0) ? 0u : ((unsigned)eq_room < ce ? (unsigned)eq_room : ce);
                    unsigned off = wave_excl_prefix<5>(cg, lane) + wave_excl_prefix<5>(erem, lane);
                    const unsigned dl_ = 256u + (unsigned)opaque_lane();
#pragma unroll
                    for (int j = 0; j < 16; ++j) {
                        const bool gt = ck[j] > Tf, eqk = (ck[j] == Tf) && (erem > 0u), take = gt || eqk;
                        erem -= eqk ? 1u : 0u;
                        idxl[take ? off : dl_] = cp[j];
                        off += take ? 1u : 0u;
                    }
                }
                count = 256;
            }
            LDS_WAIT(); asm volatile("" ::: "memory");
            }
#pragma unroll 1
            for (int rsp_ = 0; rsp_ < r_sp; ++rsp_) {
            f32x4 St[16];
#define B3_KLOAD(dst, gb_) do { _Pragma("unroll") for (int g4 = 0; g4 < 4; ++g4) { const unsigned krow_ = idxl[16 * (4 * (gb_) + g4) + l15]; const u16* kp_ = KB + (brow + krow_) * 128 + 8 * kq; \
                _Pragma("unroll") for (int ks = 0; ks < 4; ++ks) dst[g4][ks] = *(const h16x8*)(kp_ + 32 * ks); } } while (0)
#define B3_KMMA(src, gb_) do { _Pragma("unroll") for (int g4 = 0; g4 < 4; ++g4) { f32x4 a_ = {0.f, 0.f, 0.f, 0.f}; \
                _Pragma("unroll") for (int ks = 0; ks < 4; ++ks) a_ = __builtin_amdgcn_mfma_f32_16x16x32_f16(src[g4][ks], qb[ks], a_, 0, 0, 0); St[4 * (gb_) + g4] = a_; } } while (0)
            {
                h16x8 kfA[4][4], kfB[4][4];
                B3_KLOAD(kfA, 0); B3_KLOAD(kfB, 1);
                B3_KMMA(kfA, 0); B3_KLOAD(kfA, 2);
                B3_KMMA(kfB, 1); B3_KLOAD(kfB, 3);
                B3_KMMA(kfA, 2); B3_KMMA(kfB, 3);
            }
#undef B3_KLOAD
#undef B3_QLOAD
#undef B3_KMMA
            char* vbuf = lds + B3_V_OFF + wid * 8192;
            h16x8 vsA[8], vsB[8], vsC[8], vsD[8];
#define B3_VLOAD(dst, c) do { _Pragma("unroll") for (int i_ = 0; i_ < 8; ++i_) { const unsigned kr_ = idxl[32 * (c) + 4 * i_ + kq]; dst[i_] = *(const h16x8*)(VB + (brow + kr_) * 128 + 8 * l15); } } while (0)
            B3_VLOAD(vsA, 0); B3_VLOAD(vsB, 1); B3_VLOAD(vsC, 2); B3_VLOAD(vsD, 3);
            float mx = -__builtin_inff();
#pragma unroll
            for (int g = 0; g < 16; ++g)
#pragma unroll
                for (int i = 0; i < 4; ++i) { const float s = (16 * g + 4 * kq + i < count) ? St[g][i] * 0.08838834764831845f : -__builtin_inff(); St[g][i] = s; mx = fmaxf(mx, s); }
            mx = fmaxf(mx, swz_xor<16>(mx));
            { auto r = __builtin_amdgcn_permlane32_swap(__float_as_uint(mx), __float_as_uint(mx), false, false); mx = fmaxf(__uint_as_float(r[0]), __uint_as_float(r[1])); }
            float sm = 0.f;
#pragma unroll
            for (int g = 0; g < 16; ++g)
#pragma unroll
                for (int i = 0; i < 4; ++i) { const float p = __expf(St[g][i] - mx); St[g][i] = p; sm += p; }
            sm += swz_xor<16>(sm); sm = add_xor32(sm);
            const float inv = 1.0f / sm;
            h16x8 pb[8];
#pragma unroll
            for (int c = 0; c < 8; ++c) { h16x8 t;
#pragma unroll
                for (int i = 0; i < 4; ++i) { t[i] = (_Float16)(St[2 * c][i] * inv); t[4 + i] = (_Float16)(St[2 * c + 1][i] * inv); }
                pb[c] = t; }
            f32x4 o[8];
#pragma unroll
            for (int db = 0; db < 8; ++db) o[db] = (f32x4){0.f, 0.f, 0.f, 0.f};
            const int wrow = kq, wf = ((wrow & 3) << 2);
            const int rq = l15 >> 2, rp = l15 & 3, rf = (rq << 2) | kq;
            const int vb0 = (int)(uintptr_t)vbuf;
            int traddr[8];
#pragma unroll
            for (int db = 0; db < 8; ++db) traddr[db] = vb0 + 256 * (4 * kq + rq) + 16 * ((2 * db + (rp >> 1)) ^ rf) + 8 * (rp & 1);
#define B3_VWRITE(src) do { _Pragma("unroll") for (int i_ = 0; i_ < 8; ++i_) *(h16x8*)(vbuf + 256 * (4 * i_ + kq) + 16 * (l15 ^ (wf | (i_ & 3)))) = src[i_]; } while (0)
#define B3_TRRD(dst, addr, off) asm volatile("ds_read_b64_tr_b16 %0, %1 offset:%2" : "=&v"(dst) : "v"(addr), "i"(off) : "memory")
#define B3_PVCHUNK(c) do { _Pragma("unroll") for (int dh = 0; dh < 2; ++dh) { s16x4v a0[4], a1[4]; \
                _Pragma("unroll") for (int d4 = 0; d4 < 4; ++d4) { B3_TRRD(a0[d4], traddr[4 * dh + d4], 0); B3_TRRD(a1[d4], traddr[4 * dh + d4], 4096); } \
                asm volatile("s_waitcnt lgkmcnt(0)" ::: "memory"); __builtin_amdgcn_sched_barrier(0); \
                _Pragma("unroll") for (int d4 = 0; d4 < 4; ++d4) { const s16x8 av = {a0[d4][0], a0[d4][1], a0[d4][2], a0[d4][3], a1[d4][0], a1[d4][1], a1[d4][2], a1[d4][3]}; \
                    o[4 * dh + d4] = __builtin_amdgcn_mfma_f32_16x16x32_f16(__builtin_bit_cast(h16x8, av), pb[c], o[4 * dh + d4], 0, 0, 0); } } } while (0)
            B3_VWRITE(vsA); B3_VLOAD(vsA, 4); B3_PVCHUNK(0);
            B3_VWRITE(vsB); B3_VLOAD(vsB, 5); B3_PVCHUNK(1);
            B3_VWRITE(vsC); B3_VLOAD(vsC, 6); B3_PVCHUNK(2);
            B3_VWRITE(vsD); B3_VLOAD(vsD, 7); B3_PVCHUNK(3);
            B3_VWRITE(vsA); B3_PVCHUNK(4);
            B3_VWRITE(vsB); B3_PVCHUNK(5);
            B3_VWRITE(vsC); B3_PVCHUNK(6);
            B3_VWRITE(vsD); B3_PVCHUNK(7);
#undef B3_VLOAD
#undef B3_VWRITE
#undef B3_TRRD
#undef B3_PVCHUNK
            { float am = 0.f;
#pragma unroll
              for (int db = 0; db < 8; ++db) am = fmaxf(am, fmaxf(fmaxf(__builtin_fabsf(o[db][0]), __builtin_fabsf(o[db][1])), fmaxf(__builtin_fabsf(o[db][2]), __builtin_fabsf(o[db][3]))));
              am = wave_max(am); const float inv = am > 0.f ? 127.0f / am : 0.f;
              if (lane == 0) RFO[token] = am * (1.0f / 127.0f);
#pragma unroll
              for (int db = 0; db < 8; ++db) *(unsigned*)(AOQ + token * DM + l15 * 128 + 16 * db + 4 * kq) = pack4_i8(o[db][0] * inv, o[db][1] * inv, o[db][2] * inv, o[db][3] * inv); }
            }
        }
    }
}

__device__ __forceinline__ att::BlockRef<u16, u16> attA_ref(int stream, int qb, const u16* Qh, const u16* Kh, const u16* Vh, u16* O) {
    const int vh = stream & 1, c = (stream >> 1) & 1, bh = stream >> 2;
    const int qk = (bh * 2 + c), vv = (bh * 2 + vh);
    att::BlockRef<u16, u16> r;
    r.Q = Qh + ((size_t)qk * SEQ + (size_t)qb * 256) * 128; r.K = Kh + (size_t)qk * SEQ * 128; r.V = Vh + (size_t)vv * SEQ * 128;
    r.O = O + ((size_t)stream * SEQ + (size_t)qb * 256) * 128; r.P0 = qb * 256;
    return r;
}
__device__ __forceinline__ void phase_attnA(char* lds, const u16* Qh, const u16* Kh, const u16* Vh, u16* O, int vcu, int G) {
    constexpr int total = NB * 8 * 4 * 16;
    int L = vcu; if (L >= total) return;
    int pass = 0;
    att::BlockRef<u16, u16> cur = attA_ref(L >> 4, (L & 15), Qh, Kh, Vh, O);
    att::Seam<u16> S;
    att::causal_swa_prime<u16, u16>(cur, SEQ, lds, S);
    for (;;) {
        const bool more_pass = pass == 0, more_item = L + G < total, last = !more_pass && !more_item;
        int passn = pass + 1, Ln = L;
        if (!more_pass) { passn = 0; Ln = more_item ? L + G : L; }
        const int xn = Ln & 15;
        const att::BlockRef<u16, u16> nxt = last ? cur : attA_ref(Ln >> 4, passn ? 31 - xn : xn, Qh, Kh, Vh, O);
        att::causal_swa_block<u16, u16>(cur, nxt, SEQ, SEQ, lds, S);
        if (last) break;
        cur = nxt; pass = passn; L = Ln;
    }
}


namespace att {
constexpr int A2_K = 0, A2_V0 = 32768, A2_V1 = 65536, A2_P01 = 114688, A2_X = 132096, A2_P23 = 136192;

__device__ __forceinline__ void pv_tile2(f32x16* o, int vb, bf16x8 pa0, bf16x8 pa1, bf16x8 pa2, bf16x8 pa3) {
#define TRRD2(dst, off) asm volatile("ds_read_b64_tr_b16 %0, %1 offset:%2" : "=&v"(dst) : "v"(vb), "i"(off) : "memory")
#define PV_LD(S, ks) do { TRRD2(S##l0, v_rd_off(0, ks, 0)); TRRD2(S##h0, v_rd_off(0, ks, 1)); TRRD2(S##l1, v_rd_off(1, ks, 0)); TRRD2(S##h1, v_rd_off(1, ks, 1)); \
        TRRD2(S##l2, v_rd_off(2, ks, 0)); TRRD2(S##h2, v_rd_off(2, ks, 1)); TRRD2(S##l3, v_rd_off(3, ks, 0)); TRRD2(S##h3, v_rd_off(3, ks, 1)); } while (0)
#define PV_MM(S, pa) do { \
        o[0] = mfma32h(pa, (bf16x8){S##l0[0], S##l0[1], S##l0[2], S##l0[3], S##h0[0], S##h0[1], S##h0[2], S##h0[3]}, o[0], 0, 0, 0); \
        o[1] = mfma32h(pa, (bf16x8){S##l1[0], S##l1[1], S##l1[2], S##l1[3], S##h1[0], S##h1[1], S##h1[2], S##h1[3]}, o[1], 0, 0, 0); \
        o[2] = mfma32h(pa, (bf16x8){S##l2[0], S##l2[1], S##l2[2], S##l2[3], S##h2[0], S##h2[1], S##h2[2], S##h2[3]}, o[2], 0, 0, 0); \
        o[3] = mfma32h(pa, (bf16x8){S##l3[0], S##l3[1], S##l3[2], S##l3[3], S##h3[0], S##h3[1], S##h3[2], S##h3[3]}, o[3], 0, 0, 0); } while (0)
    s16x4 Al0, Ah0, Al1, Ah1, Al2, Ah2, Al3, Ah3, Bl0, Bh0, Bl1, Bh1, Bl2, Bh2, Bl3, Bh3;
    PV_LD(A, 0); PV_LD(B, 1);
    asm volatile("s_waitcnt lgkmcnt(8)" ::: "memory"); SBAR(); PV_MM(A, pa0); SBAR();
    PV_LD(A, 2);
    asm volatile("s_waitcnt lgkmcnt(8)" ::: "memory"); SBAR(); PV_MM(B, pa1); SBAR();
    PV_LD(B, 3);
    asm volatile("s_waitcnt lgkmcnt(8)" ::: "memory"); SBAR(); PV_MM(A, pa2); SBAR();
    asm volatile("s_waitcnt lgkmcnt(0)" ::: "memory"); SBAR(); PV_MM(B, pa3);
#undef PV_MM
#undef PV_LD
#undef TRRD2
}
__device__ __forceinline__ void qkt2(f32x16& p0, f32x16& p1, const char* Kt, int r32, int hi, const bf16x8* qr) {
    p0 = f32x16{}; p1 = f32x16{};
    const char* kb[4];
#pragma unroll
    for (int dd = 0; dd < 4; ++dd) kb[dd] = Kt + KSWZ(r32, (dd * 16 + hi * 8) * 2);
    bf16x8 c0 = *reinterpret_cast<const bf16x8*>(kb[0]), c1 = *reinterpret_cast<const bf16x8*>(kb[0] + 32 * 256);
#pragma unroll
    for (int d0 = 0; d0 < 8; ++d0) {
        bf16x8 n0 = c0, n1 = c1;
        if (d0 < 7) { const char* a = kb[(d0 + 1) & 3] + ((d0 + 1) >> 2) * 128; n0 = *reinterpret_cast<const bf16x8*>(a); n1 = *reinterpret_cast<const bf16x8*>(a + 32 * 256); }
        SBAR();
        p0 = mfma32h(c0, qr[d0], p0, 0, 0, 0);
        p1 = mfma32h(c1, qr[d0], p1, 0, 0, 0);
        SBAR();
        c0 = n0; c1 = n1;
    }
}
__device__ __forceinline__ void qkt3(f32x16& p0, f32x16& p1, const char* Kt, int r32, int hi, const bf16x8* qr) {
    p0 = f32x16{}; p1 = f32x16{};
    const char* kb[4];
#pragma unroll
    for (int dd = 0; dd < 4; ++dd) kb[dd] = Kt + KSWZ(r32, (dd * 16 + hi * 8) * 2);
#pragma unroll
    for (int d0 = 0; d0 < 8; ++d0) { const char* a = kb[d0 & 3] + (d0 >> 2) * 128;
        const bf16x8 b0 = *reinterpret_cast<const bf16x8*>(a), b1 = *reinterpret_cast<const bf16x8*>(a + 32 * 256);
        p0 = mfma32h(b0, qr[d0], p0, 0, 0, 0);
        p1 = mfma32h(b1, qr[d0], p1, 0, 0, 0); }
}
#define A2_BAR() do { asm volatile("s_waitcnt lgkmcnt(0)" ::: "memory"); __builtin_amdgcn_s_barrier(); asm volatile("" ::: "memory"); } while (0)
__device__ __forceinline__ void attnA2_block(const u16* Q, const u16* K, const u16* V0, const u16* V1, u16* O, int P0, char* lds) {
    const int tid = opaque_tid(), wid = __builtin_amdgcn_readfirstlane(tid >> 6), lane = tid & 63, r32 = lane & 31, hi = lane >> 5;
    const bool heavy = wid < 4; const int w4 = wid & 3;
    const int NT = P0 / KVBLK + 2;
    char* K_lds = lds + A2_K; char* Va = lds + A2_V0; char* Vb = lds + A2_V1;
    char* Pw = lds + (w4 < 2 ? A2_P01 + w4 * 8192 : A2_P23 + (w4 - 2) * 8192);
    float* al = (float*)(lds + A2_X + w4 * 512); unsigned* fl = (unsigned*)(al + 64); float* lf = al + 96;
    const int vb0 = (int)(uintptr_t)(heavy ? Va : Vb) + v_rd_base(lane);
    bf16x8 qr[8];
    if (heavy) {
#pragma unroll
        for (int d0 = 0; d0 < 8; ++d0) qr[d0] = load8<u16>(Q + (size_t)(w4 * QBLK + r32) * D + d0 * 16 + hi * 8);
    }
    const int lt = tid & 255, sc = (lt & 15) * 8;
    bf16x8 sk[4], sa[4], sb[4];
#define A2_LOADK(k0) do { _Pragma("unroll") for (int i_ = 0; i_ < 4; ++i_) sk[i_] = load8<u16>(K + (size_t)((k0) + (lt >> 4) + 16 * i_) * D + sc); } while (0)
#define A2_LOADV(k0) do { _Pragma("unroll") for (int i_ = 0; i_ < 4; ++i_) { const size_t ro_ = (size_t)((k0) + (lt >> 4) + 16 * i_) * D + sc; sa[i_] = load8<u16>(V0 + ro_); sb[i_] = load8<u16>(V1 + ro_); } } while (0)
#define A2_WRITEK(bf) do { _Pragma("unroll") for (int i_ = 0; i_ < 4; ++i_) { const int row_ = (lt >> 4) + 16 * i_; *(bf16x8*)(K_lds + (bf) * SHM_K + KSWZ(row_, sc * 2)) = sk[i_]; } } while (0)
#define A2_WRITEV(bf, bf3) do { _Pragma("unroll") for (int i_ = 0; i_ < 4; ++i_) { const int vs_ = v_st((lt >> 4) + 16 * i_, sc); *(bf16x8*)(Va + (bf) * SHM_V + vs_) = sa[i_]; *(bf16x8*)(Vb + (bf3) * SHM_V + vs_) = sb[i_]; } } while (0)
    if (!heavy) { A2_LOADK(0); A2_LOADV(0); asm volatile("s_waitcnt vmcnt(0)" ::: "memory"); A2_WRITEK(0); A2_WRITEV(0, 0); A2_LOADK(KVBLK); asm volatile("s_waitcnt vmcnt(0)" ::: "memory"); A2_WRITEK(1);
        if (2 < NT) A2_LOADK(2 * KVBLK); A2_LOADV(KVBLK); }
    A2_BAR();
    f32x16 o[4] = {};
    if (heavy) {
        float m_reg = -1e30f, l_reg = 0.f;
        const int qlo = P0 + w4 * QBLK, qm = qlo + r32 - 4 * hi;
        f32x16 pc0, pc1;
        qkt2(pc0, pc1, K_lds, r32, hi, qr);
        A2_BAR();
#pragma unroll 1
        for (int t = 0; t <= NT; ++t) {
            if (t < NT) {
                const int bf = t & 1; f32x16 pn0, pn1; float mn, alpha; bf16x8 pa0, pa1, pa2, pa3;
                { const int kb = t * KVBLK; if (kb + KVBLK - 1 > qlo) mask_tile(pc0, pc1, qm - kb, (unsigned)SEQ); }
                partialSM(pc0, pc1, m_reg, mn, alpha);
                qkt3(pn0, pn1, K_lds + ((t + 1) & 1) * SHM_K, r32, hi, qr);
                finishSM(pc0, pc1, alpha, l_reg, pa0, pa1, pa2, pa3);
#pragma unroll
                for (int g_ = 0; g_ < 16; ++g_) { __builtin_amdgcn_sched_group_barrier(0x100, 1, 0); __builtin_amdgcn_sched_group_barrier(0x008, 1, 0); __builtin_amdgcn_sched_group_barrier(0x002, 8, 0); }
                SBAR();
                const bool rs = __any(alpha < 1.f);
                if (rs) { if (hi == 0) al[bf * 32 + r32] = alpha; asm volatile("s_waitcnt lgkmcnt(0)" ::: "memory");
#pragma unroll
                    for (int d_ = 0; d_ < 4; ++d_)
#pragma unroll
                        for (int r = 0; r < 16; ++r) o[d_][r] *= al[bf * 32 + crow(r, hi)]; }
                if (lane == 0) fl[bf] = rs ? 1u : 0u;
                *(bf16x8*)(Pw + bf * 4096 + lane * 16) = pa0; *(bf16x8*)(Pw + bf * 4096 + 1024 + lane * 16) = pa1; *(bf16x8*)(Pw + bf * 4096 + 2048 + lane * 16) = pa2; *(bf16x8*)(Pw + bf * 4096 + 3072 + lane * 16) = pa3;
                if (t == NT - 1 && hi == 0) lf[r32] = l_reg;
                SBAR();
                pv_tile2(o, vb0 + bf * SHM_V, pa0, pa1, pa2, pa3);
                pc0 = pn0; pc1 = pn1;
            }
            A2_BAR();
        }
    } else {
        A2_BAR();
#pragma unroll 1
        for (int t = 0; t <= NT; ++t) {
            asm volatile("s_waitcnt vmcnt(0)" ::: "memory");
            if (t + 2 < NT) A2_WRITEK(t & 1);
            if (t + 1 < NT) A2_WRITEV((t + 1) & 1, (t + 1) % 3);
            if (t + 3 < NT) A2_LOADK((t + 3) * KVBLK);
            if (t + 2 < NT) A2_LOADV((t + 2) * KVBLK);
            SBAR();
            if (t >= 1) {
                const int bf = (t - 1) & 1, bf3 = (t - 1) % 3;
                const unsigned f = __builtin_amdgcn_readfirstlane(fl[bf]);
                if (f) {
#pragma unroll
                    for (int d_ = 0; d_ < 4; ++d_)
#pragma unroll
                        for (int r = 0; r < 16; ++r) o[d_][r] *= al[bf * 32 + crow(r, hi)]; }
                const bf16x8 pa0 = *(const bf16x8*)(Pw + bf * 4096 + lane * 16), pa1 = *(const bf16x8*)(Pw + bf * 4096 + 1024 + lane * 16), pa2 = *(const bf16x8*)(Pw + bf * 4096 + 2048 + lane * 16), pa3 = *(const bf16x8*)(Pw + bf * 4096 + 3072 + lane * 16);
                asm volatile("s_waitcnt lgkmcnt(0)" ::: "memory"); SBAR();
                pv_tile2(o, vb0 + bf3 * SHM_V, pa0, pa1, pa2, pa3);
            }
            A2_BAR();
        }
    }
#undef A2_LOADK
#undef A2_LOADV
#undef A2_WRITEK
#undef A2_WRITEV
    float rli[16];
#pragma unroll
    for (int r = 0; r < 16; ++r) rli[r] = __builtin_amdgcn_rcpf(lf[crow(r, hi)]);
    u16* Ow = O + (size_t)(w4 * QBLK) * 256 + (heavy ? 0 : 128);
#pragma unroll
    for (int r = 0; r < 16; ++r) { const int orow = crow(r, hi);
#pragma unroll
        for (int d0 = 0; d0 < 4; ++d0) { const float v = o[d0][r] * rli[r]; const float vn = swz_xor<1>(v);
            if ((r32 & 1) == 0) *(unsigned*)(Ow + (size_t)orow * 256 + d0 * 32 + r32) = cvtpk(v, vn); } }
    A2_BAR();
}
#undef A2_BAR
}
__device__ __forceinline__ void phase_attnA2(char* lds, const u16* Qh, const u16* Kh, const u16* Vh, u16* O, int vcu, int G) {
    for (int L = vcu; L < NB * 8 * 2 * 32; L += G) {
        const int s = L >> 5, y = L & 31, bh = s >> 1;
        const u16* Kp = Kh + (size_t)s * SEQ * 128; const u16* V0 = Vh + (size_t)(bh * 2) * SEQ * 128; const u16* V1 = Vh + (size_t)(bh * 2 + 1) * SEQ * 128;
#pragma unroll 1
        for (int pass = 0; pass < 2; ++pass) { const int P0 = (pass ? 63 - y : y) * 128;
            att::attnA2_block(Qh + ((size_t)s * SEQ + P0) * 128, Kp, V0, V1, O + ((size_t)s * SEQ + P0) * 256, P0, lds); }
    }
}
struct Args { const float* in[22]; float* out; unsigned char* ws; int ph_lo, ph_hi; int rep[8]; };
typedef const __attribute__((address_space(4))) unsigned long long* kargp_t;
__device__ __forceinline__ unsigned long long karg_u64(int idx) { asm volatile("" : "+s"(idx)); return ((kargp_t)__builtin_amdgcn_kernarg_segment_ptr())[idx]; }
#define KIN(i) ((const float*)(const __attribute__((address_space(1))) float*)karg_u64(i))
#define KOUT() ((float*)(__attribute__((address_space(1))) float*)karg_u64(22))
#define KREP(i) ((int)(karg_u64(25 + ((i) >> 1)) >> (32 * ((i) & 1))))
#define KWS() ((unsigned char*)(__attribute__((address_space(1))) unsigned char*)karg_u64(23))
#define FRAME() const int tid = opaque_tid(), lane = tid & 63, wave = __builtin_amdgcn_readfirstlane(tid >> 6); const int G = gridDim.x, bx = blockIdx.x; \
    const int vcu = (G % 8 == 0) ? (bx % 8) * (G / 8) + bx / 8 : bx; const int gw = vcu * NWAVES + wave, NGW = G * NWAVES; (void)lane; (void)gw; (void)NGW; (void)vcu; (void)bx
__global__ void __launch_bounds__(NWAVES * 64, 2) fwd_kernel(Args args) {
    extern __shared__ __attribute__((aligned(16))) unsigned char lds[];
    LAS unsigned char* L3 = (LAS unsigned char*)lds;
    volatile LAS unsigned* MISC = (volatile LAS unsigned*)(L3 + MISC_OFF);
    if (threadIdx.x < 32) MISC[threadIdx.x] = 0u;
    if ((threadIdx.x & 63) == 0) ((volatile LAS int*)(L3 + TIDTAB_OFF))[hw_wave_slot()] = (int)(threadIdx.x >> 6);
    __syncthreads();
    { XcdBarrier b0 = xcd_barrier_post((unsigned*)(KWS() + WS_CTL) + CW_BAR, MISC + 8); (void)b0; }
    int ph = 0; const int lo = args.ph_lo, hi = args.ph_hi;
#define IN() (lo <= ph && ph < hi)
#define OPQ_LS() int li = li0, s = s0; asm volatile("" : "+s"(li), "+s"(s)); (void)li; (void)s
#define SEAM() do { if (lo <= ph && ph + 1 < hi) { XcdBarrier b_; b_.bar = (unsigned*)(KWS() + WS_CTL) + CW_BAR; b_.x = xb_xcc_id(); b_.st = MISC + 8; xcd_barrier(b_); } ++ph; } while (0)

    if (IN()) {
        FRAME(); unsigned char* ws = KWS();
        LAS float* scr = (LAS float*)(L3 + wave * 16384);
        { const float* cin = KIN(1); const float* adaw = KIN(2); float* modp = (float*)(ws + WS_MODP);
          for (int it = gw; it < 4 * 72 * 8; it += NGW) p0_ada_item(cin, adaw, modp, it, scr, lane); }
        constexpr int I_BIN = 32 * 144;
        for (int it = gw; it < 2 * I_BIN; it += NGW) { const int mj = it / I_BIN, q = it % I_BIN, kb = q / 144, nb = q % 144;
            p0_transpose_item(KIN(16) + (size_t)mj * DM * B_IN, DM, B_IN, (u16*)(ws + WS_WBIN) + (size_t)mj * B_INP * DM, 32 * nb, 64 * kb, 32 * nb, scr, lane); }
        { float* cost = (float*)(ws + WS_COS); float* sint = (float*)(ws + WS_SIN); float* costi = (float*)(ws + WS_COSI); float* sinti = (float*)(ws + WS_SINI);
          for (int e = gw * 64 + lane; e < SEQ * 64; e += NGW * 64) { float co, si; sincos_d((double)(e >> 6) * powi_d(0.8659643233600653, e & 63), co, si); cost[e] = co; sint[e] = si; }
          for (int e = gw * 64 + lane; e < SEQ * 32; e += NGW * 64) { float co, si; sincos_d((double)(e >> 5) * powi_d(0.7498942093324559, e & 31), co, si); costi[e] = co; sinti[e] = si; } }
    }
    SEAM();
    if (IN()) {
        FRAME(); unsigned char* ws = KWS(); const float* adab = KIN(3); const float* modp = (const float*)(ws + WS_MODP); float* mod = (float*)(ws + WS_MOD);
        for (int e = gw * 64 + lane; e < DEPTH * NB * ADAW; e += NGW * 64) {
            const int layer = e / (NB * ADAW), col = e % ADAW;
            float s = adab[layer * ADAW + col];
#pragma unroll
            for (int kc = 0; kc < 8; ++kc) s += modp[(size_t)kc * DEPTH * NB * ADAW + e];
            const int slot = col / DM; mod[e] = (slot == 2 || slot == 8) ? 0.5f * s : s;
        }
    }
    SEAM();
    if (IN()) {
        FRAME(); unsigned char* ws = KWS(); const float* mod = (const float*)(ws + WS_MOD); float* bias = (float*)(ws + WS_BIAS);
        constexpr int S_GU = 16 * 176, S_AIN = 2 * 192, S_OUT = 4 * 64, S_DN = 8 * 128, S_BQ = 2 * (B_QKV / 32);
        for (int st = bx; st < S_GU + S_AIN + S_OUT + S_DN + S_BQ; st += G) {
            if (st >= S_GU + S_AIN + S_OUT + S_DN) { const int r = st - (S_GU + S_AIN + S_OUT + S_DN), mj = r / (B_QKV / 32), n0 = 32 * (r % (B_QKV / 32));
                p0w_strip<DM, 32, false>(KIN(16) + (size_t)mj * DM * B_IN, B_IN, n0, ws + WS_WQB + ((size_t)mj * B_QKV + n0) * DM, (float*)(ws + WS_TQB) + (size_t)mj * B_QKV + n0, nullptr, nullptr, 0, L3, tid);
            } else if (st < S_GU) { const int mi = st / 176, nb = st % 176, lj = mi >> 1, isup = mi & 1, n0 = 32 * nb, li = lj >> 1, sl = (lj & 1) * 2, q = 3 * li + sl;
                const int drow0 = 256 * (n0 >> 7) + (n0 & 127) + 128 * isup;
                p0w_strip<DM, 32, true>(KIN(4 + isup) + (size_t)lj * DM * DFF, DFF, n0, ws + WS_WQ + ((size_t)lj * GU_N + drow0) * DM, (float*)(ws + WS_TQ) + (size_t)lj * GU_N + drow0,
                                        mod + (size_t)li * NB * ADAW + (3 * sl) * DM, bias + (size_t)(q * 4) * GU_N + drow0, GU_N, L3, tid);
            } else if (st < S_GU + S_AIN) { const int r = st - S_GU, mj = r / 192, nb = r % 192, n0 = 32 * nb, li = 2 * mj, q = 3 * li + 1;
                const int chunk = n0 >> 7, d = n0 & 127, drow0 = (n0 < 4096) ? 256 * (chunk >> 1) + 128 * (d >> 6) + 64 * (chunk & 1) + 32 * ((d >> 5) & 1) : n0;
                p0w_strip<DM, 32, true>(KIN(7) + (size_t)mj * DM * A_IN, A_IN, n0, ws + WS_WQA + ((size_t)mj * A_IN + drow0) * DM, (float*)(ws + WS_TQA) + (size_t)mj * A_IN + drow0,
                                        mod + (size_t)li * NB * ADAW + 3 * DM, bias + (size_t)(q * 4) * GU_N + drow0, GU_N, L3, tid);
            } else if (st < S_GU + S_AIN + S_OUT) { const int r = st - S_GU - S_AIN, mi = r / 64, nb = r % 64, n0 = 32 * nb;
                const float* Wsrc = (mi < 2) ? KIN(8) + (size_t)mi * DM * DM : KIN(17) + (size_t)(mi - 2) * DM * DM;
                p0w_strip<DM, 32, false>(Wsrc, DM, n0, ws + WS_WOQ + ((size_t)mi * DM + n0) * DM, (float*)(ws + WS_TQO) + (size_t)mi * DM + n0, nullptr, nullptr, 0, L3, tid);
            } else { const int r = st - S_GU - S_AIN - S_OUT, gi = r / 128, nb = r % 128, n0 = 16 * nb;
                p0w_strip<DFF, 16, false, true>(KIN(6) + (size_t)gi * DFF * DM, DM, n0, ws + WS_WQD + ((size_t)gi * DM + n0) * DFF, (float*)(ws + WS_TQD) + (size_t)gi * DM + n0, nullptr, nullptr, 0, L3, tid);
            }
        }
        phase_bias_bin(mod, (const u16*)(ws + WS_WBIN), bias, gw, NGW, lane);
    }
    SEAM();

#pragma unroll 1
    for (int li0 = 0; li0 < DEPTH; ++li0) {
#pragma unroll 1
        for (int s0 = 0; s0 < 3; ++s0) {
            if (s0 != 1) {
                if (IN()) { OPQ_LS();
                    FRAME(); unsigned char* ws = KWS(); const float* modl = (const float*)(ws + WS_MOD) + (size_t)li * NB * ADAW;
                    if (li == 0 && s == 0) { phase_quant<true>(KIN(0), (u16*)(ws + WS_XH), (unsigned long long*)(ws + WS_XQ), modl + (3 * s + 1) * DM, (float*)(ws + WS_RF), gw, NGW, lane);
                    }
                    else phase_quant<false>(nullptr, (u16*)(ws + WS_XH), (unsigned long long*)(ws + WS_XQ), modl + (3 * s + 1) * DM, (float*)(ws + WS_RF), gw, NGW, lane);
                }
                SEAM();
                if (IN()) { OPQ_LS();
                    unsigned char* ws = KWS(); const int G = gridDim.x, bx = blockIdx.x; const int gi = li * 2 + (s >> 1);
                    pg8::Gemm g{(const u16*)(ws + WS_XQ), (const u16*)(ws + WS_WQ + (size_t)gi * GU_N * DM), MTOK, GU_N, DM / 2}; pg8::StaticOrder S; S.init(MTOK, GU_N, G, bx);
                    const int q = 3 * li + s; pg8::EpiSwiglu8 E{ws + WS_HQ, DFF, (const float*)(ws + WS_RF), (const float*)(ws + WS_TQ) + (size_t)gi * GU_N, (const float*)(ws + WS_BIAS) + (size_t)q * 4 * GU_N, GU_N};
                    pg8::gemm_phase<pg8::EpiSwiglu8, pg8::StaticOrder, true, true, 1>(L3, g, S, E);
                }
                SEAM();
            } else {
                const bool isA = (li0 & 1) == 0;
                if (IN()) { OPQ_LS();
                    FRAME(); unsigned char* ws = KWS(); const float* modl = (const float*)(ws + WS_MOD) + (size_t)li * NB * ADAW; const int q = 3 * li + s;
                    if ((li & 1) == 0) phase_quant<false>(nullptr, (u16*)(ws + WS_XH), (unsigned long long*)(ws + WS_XQ), modl + (3 * s + 1) * DM, (float*)(ws + WS_RF), gw, NGW, lane);
                    else phase_quant<false, true>(nullptr, (u16*)(ws + WS_XH), (unsigned long long*)(ws + WS_XQ), modl + (3 * s + 1) * DM, (float*)(ws + WS_RF), gw, NGW, lane, (u16*)(ws + WS_XN), (float*)(ws + WS_SSQ) + (q & 1) * MTOK);
                }
                SEAM();
                if (IN()) { OPQ_LS();
                    unsigned char* ws = KWS(); const int G = gridDim.x, bx = blockIdx.x; const int mj = li >> 1; const int q = 3 * li + s;
                    const pg8::RowCol rc{(const float*)(ws + WS_SSQ) + (q & 1) * MTOK, (const float*)(ws + WS_BIAS) + (size_t)q * 4 * GU_N, GU_N};
                    if ((li & 1) == 0) {
                        pg8::Gemm g{(const u16*)(ws + WS_XQ), (const u16*)(ws + WS_WQA + (size_t)mj * A_IN * DM), MTOK, A_IN, DM / 2}; pg8::StaticOrder S; S.init(MTOK, A_IN, G, bx);
                        const pg8::RowCol rcq{(const float*)(ws + WS_RF), rc.bias, rc.bstride};
                        pg8::EpiQkvA E{(u16*)(ws + WS_Q), (u16*)(ws + WS_K), (u16*)(ws + WS_V), rcq, (const float*)(ws + WS_TQA) + (size_t)mj * A_IN, KIN(9) + mj * 128, KIN(10) + mj * 128, (const float*)(ws + WS_COS), (const float*)(ws + WS_SIN), (LAS float*)(L3 + 132096)};
                        pg8::gemm_phase<pg8::EpiQkvA, pg8::StaticOrder, true, true, 1>(L3, g, S, E);
                    } else {
                        { pg8::Gemm g{(const u16*)(ws + WS_XQ), (const u16*)(ws + WS_WQB + (size_t)mj * B_QKV * DM), MTOK, B_QKV, DM / 2}; pg8::StaticOrder S; S.init(MTOK, B_QKV, G, bx);
                          pg8::EpiF16Q E{(u16*)(ws + WS_BIG), B_INP, (const float*)(ws + WS_RF), (const float*)(ws + WS_TQB) + (size_t)mj * B_QKV, rc.bias, rc.bstride};
                          pg8::gemm_phase<pg8::EpiF16Q, pg8::StaticOrder, true, true, 1>(L3, g, S, E); }
                        asm volatile("s_waitcnt vmcnt(0)" ::: "memory"); __syncthreads();
                        { pg8::Gemm g{(const u16*)(ws + WS_XN), (const u16*)(ws + WS_WBIN) + ((size_t)mj * B_INP + B_QKV) * DM, MTOK, B_INP - B_QKV, DM}; pg8::StaticOrder S; S.init(MTOK, B_INP - B_QKV, G, (bx + G / 2) % G);
                          const pg8::RowCol rc2{rc.ssq, rc.bias + B_QKV, rc.bstride};
                          pg8::EpiF16 E{(u16*)(ws + WS_BIG) + B_QKV, B_INP, rc2};
                          pg8::gemm_phase<pg8::EpiF16, pg8::StaticOrder, true, true>(L3, g, S, E); }
                    }
                }
                SEAM();
                if (isA) {
                    if (IN()) { OPQ_LS(); unsigned char* ws = KWS(); const int G = gridDim.x, bx = blockIdx.x; const int vcu = (G % 8 == 0) ? (bx % 8) * (G / 8) + bx / 8 : bx;
                        phase_attnA2((char*)lds, (const u16*)(ws + WS_Q), (const u16*)(ws + WS_K), (const u16*)(ws + WS_V), (u16*)(ws + WS_O), vcu, G); __syncthreads(); }
                    SEAM();
                    if (IN()) { OPQ_LS(); FRAME(); unsigned char* ws = KWS(); const int mj = li >> 1;
                        phase_combineA((const u16*)(ws + WS_O), ws + WS_AO, (float*)(ws + WS_RFO), KIN(11) + mj * 128, KIN(12) + mj * 128, KIN(13) + mj * 128, KIN(14) + mj * 128, KIN(15) + mj * 256,
                                       li == 0 ? 0.2f : 0.47071301834358414f, gw, NGW, lane); }
                    SEAM();
                } else {
                    if (IN()) { OPQ_LS(); FRAME(); unsigned char* ws = KWS(); const int mj = li >> 1;
                        phase_normropeB((const u16*)(ws + WS_BIG), (u16*)(ws + WS_Q), (u16*)(ws + WS_V), (u16*)(ws + WS_V + 8 * MiB), (u16*)(ws + WS_K), (u16*)(ws + WS_V + 16 * MiB), (float*)(ws + WS_V + 24 * MiB),
                                        KIN(18) + mj * 128, KIN(19) + mj * 128, KIN(20) + mj * 128, KIN(21) + mj * 128,
                                        (const float*)(ws + WS_COS), (const float*)(ws + WS_SIN), (const float*)(ws + WS_COSI), (const float*)(ws + WS_SINI), gw, NGW, lane); }
                    SEAM();
                    if (IN()) { OPQ_LS(); unsigned char* ws = KWS(); const int G = gridDim.x, bx = blockIdx.x; const int vcu = (G % 8 == 0) ? (bx % 8) * (G / 8) + bx / 8 : bx;
                        phase_B3((char*)lds, (const u16*)(ws + WS_Q), (const u16*)(ws + WS_V), (const u16*)(ws + WS_V + 8 * MiB), (const u16*)(ws + WS_K), (const u16*)(ws + WS_V + 16 * MiB),
                                 (const float*)(ws + WS_V + 24 * MiB), (float*)(ws + WS_O), ws + WS_AO, (float*)(ws + WS_RFO), vcu, G); __syncthreads(); }
                    SEAM();
                }
            }
            if (IN()) { OPQ_LS();
                unsigned char* ws = KWS(); const int G = gridDim.x, bx = blockIdx.x;
                const float* gate = (const float*)(ws + WS_MOD) + (size_t)li * NB * ADAW + (3 * s + 2) * DM;
                const int mi = (li & 1) * 2 + (li >> 1), gi = li * 2 + (s >> 1);
                pg8::StaticOrder S; S.init(MTOK, DM, G, bx);
                if (s != 1) {
                    pg8::Gemm g{(const u16*)(ws + WS_HQ), (const u16*)(ws + WS_WQD + (size_t)gi * DM * DFF), MTOK, DM, DFF / 2};
                    pg8::EpiResidQ E{(const u16*)(ws + WS_XH), (u16*)(ws + WS_XH), KOUT(), gate, nullptr, (const float*)(ws + WS_TQD) + (size_t)gi * DM, (li == DEPTH - 1 && s == 2) ? 1 : 0};
                    pg8::gemm_phase<pg8::EpiResidQ, pg8::StaticOrder, true, true, 2>(L3, g, S, E);
                } else {
                    pg8::Gemm g{(const u16*)(ws + WS_AO), (const u16*)(ws + WS_WOQ + (size_t)mi * DM * DM), MTOK, DM, DM / 2};
                    pg8::EpiResidQ E{(const u16*)(ws + WS_XH), (u16*)(ws + WS_XH), KOUT(), gate, (const float*)(ws + WS_RFO), (const float*)(ws + WS_TQO) + (size_t)mi * DM, 0};
                    pg8::gemm_phase<pg8::EpiResidQ, pg8::StaticOrder, true, true, 1>(L3, g, S, E);
                }
            }
            SEAM();
        }
    }
#undef IN
#undef SEAM
}

#ifndef MK_PER_PHASE
#define MK_PER_PHASE 0
#endif
extern "C" void kernel_launch(void* const* d_in, const int* in_sizes, int n_in, void* d_out, int out_size, void* d_ws, size_t ws_size, hipStream_t stream) {
    static int grid = 0;
    if (grid == 0) {
        if (n_in != 22 || out_size != MTOK * DM || ws_size < WS_END) { fprintf(stderr, "kernel_launch: unexpected shapes (n_in %d out %d ws %zu)\n", n_in, out_size, ws_size); grid = -1; return; }
        int dev = 0, cus = 0, per_cu = 0;
        if (hipGetDevice(&dev) != hipSuccess || hipDeviceGetAttribute(&cus, hipDeviceAttributeMultiprocessorCount, dev) != hipSuccess) { grid = -1; return; }
        if (hipFuncSetAttribute((const void*)fwd_kernel, hipFuncAttributeMaxDynamicSharedMemorySize, LDS_BYTES) != hipSuccess) { fprintf(stderr, "kernel_launch: hipFuncSetAttribute failed\n"); grid = -1; return; }
        if (hipOccupancyMaxActiveBlocksPerMultiprocessor(&per_cu, (const void*)fwd_kernel, NWAVES * 64, LDS_BYTES) != hipSuccess || per_cu < 1) { fprintf(stderr, "kernel_launch: occupancy query says %d\n", per_cu); grid = -1; (void)hipGetLastError(); return; }
        (void)hipGetLastError();
        grid = cus;
    }
    if (grid < 0) return;
    if (hipMemsetAsync((char*)d_ws + WS_CTL, 0, CTL_ZERO_BYTES, stream) != hipSuccess) return;
    Args a{};
    for (int i = 0; i < 22; ++i) a.in[i] = (const float*)d_in[i];
    a.out = (float*)d_out; a.ws = (unsigned char*)d_ws;
#ifndef PROBE_REP0
#define PROBE_REP0 1
#define PROBE_REP1 1
#define PROBE_REP2 1
#define PROBE_REP3 1
#define PROBE_REP4 1
#define PROBE_REP5 1
#define PROBE_REP6 1
#endif
    a.rep[0] = PROBE_REP0; a.rep[1] = PROBE_REP1; a.rep[2] = PROBE_REP2; a.rep[3] = PROBE_REP3; a.rep[4] = PROBE_REP4; a.rep[5] = PROBE_REP5; a.rep[6] = PROBE_REP6; a.rep[7] = 1;
#if MK_PER_PHASE
    for (int p = 0; p < 40; ++p) { a.ph_lo = p; a.ph_hi = p + 1; hipLaunchKernelGGL(fwd_kernel, dim3(grid), dim3(NWAVES * 64), LDS_BYTES, stream, a); }
#else
    a.ph_lo = 0; a.ph_hi = 1 << 20;
    hipLaunchKernelGGL(fwd_kernel, dim3(grid), dim3(NWAVES * 64), LDS_BYTES, stream, a);
#endif
}
```
